# Optimizing an MI355X kernel written in HIP

```python
import math
import jax
import jax.numpy as jnp
from jax import lax
import numpy as np


D_MODEL = 1024
BATCH = 16
SEQ = 4096
DEPTH = 2

GRID_W = 64
CTX_LEN = 256
N_MOD = 6
NORM_EPS = 1e-6
NEG_INF = -1e30

FNET_GROUPS = 4
FNET_GROUP_DIM = D_MODEL // 8
FNET_WIDTH = FNET_GROUPS * FNET_GROUP_DIM
HY_WIDTH = D_MODEL // 2
HY_EMB_BANDS = 16
HY_EMB_DIM = 1 + 2 * HY_EMB_BANDS
HY_FILTER_HIDDEN = 64
HY_SHORT_CONV = 3
HY_DECAY_TARGET = 1e-2
HY_FAST_DECAY = 0.3
HY_SLOW_DECAY = 1.5
EVEN_IN_WIDTH = FNET_WIDTH + 3 * HY_WIDTH
EVEN_MIX_WIDTH = FNET_WIDTH + HY_WIDTH

HEAD_DIM = 64
N_HEADS = D_MODEL // HEAD_DIM
N_KV_HEADS = 4
GROUP = N_HEADS // N_KV_HEADS
Q_WIDTH = N_HEADS * HEAD_DIM
KV_WIDTH = N_KV_HEADS * HEAD_DIM
WINDOW = 128
BLOCK_Q = 128
ROPE_THETA = 10000.0
AXIS_ROPE_DIM = HEAD_DIM // 2

D_FF = 7 * D_MODEL // 2
N_EXPERTS = 8
TOP_K = 2
EXPERT_BLOCK = 256

kernel_name = 'hybrid_fnet_hyena_swa_moe_dit'


def _rmsnorm(t, g):
    t32 = t.astype(jnp.float32)
    y = t32 * lax.rsqrt(jnp.mean(t32 * t32, axis=-1, keepdims=True) + NORM_EPS)
    return (y * g.astype(jnp.float32)).astype(t.dtype)


def _modulate(h, shift, scale):
    return h * (1 + scale) + shift


def _swiglu(h, wg, wu, wd):
    return (jax.nn.silu(h @ wg) * (h @ wu)) @ wd


def _short_conv(u, w, b):
    up = jnp.pad(u, ((0, 0), (1, 1), (0, 0)))
    return up[:, :-2] * w[0] + up[:, 1:-1] * w[1] + up[:, 2:] * w[2] + b


def _hyena_filter_spectrum(L, fw0, fb0, fw1, fb1, fw2, fb2, fw3, freq):
    f32 = jnp.float32
    pos = jnp.arange(L, dtype=f32)
    t = pos / max(L - 1, 1)
    w = (2.0 * math.pi / L) * pos
    bands = jnp.linspace(1e-4, HY_EMB_BANDS - 1, HY_EMB_BANDS, dtype=f32)
    ang = w[:, None] * bands[None, :]
    z = jnp.concatenate([t[:, None], jnp.cos(ang), -jnp.sin(ang)], axis=-1)
    fr = freq.astype(f32)
    h = jnp.sin(fr * (z @ fw0.astype(f32) + fb0.astype(f32)))
    h = jnp.sin(fr * (h @ fw1.astype(f32) + fb1.astype(f32)))
    h = jnp.sin(fr * (h @ fw2.astype(f32) + fb2.astype(f32)))
    h = (h @ fw3.astype(f32)).reshape(L, 2, HY_WIDTH)
    deltas = jnp.abs(jnp.linspace(math.log(HY_DECAY_TARGET) / HY_SLOW_DECAY,
                                  math.log(HY_DECAY_TARGET) / HY_FAST_DECAY, HY_WIDTH, dtype=f32))
    h = h * jnp.exp(-t[:, None, None] * deltas)
    h_fwd, h_bwd = h[:, 0], h[:, 1]
    k = jnp.concatenate([h_fwd, jnp.zeros((1, HY_WIDTH), f32), h_bwd[1:][::-1]], axis=0)
    k = k * lax.rsqrt(jnp.sum(k * k, axis=0, keepdims=True) + NORM_EPS)
    return jnp.fft.rfft(k, axis=0)


def _fft_long_conv(u, k_spec, bias):
    L = u.shape[1]
    y = jnp.fft.irfft(jnp.fft.rfft(u, n=2 * L, axis=1) * k_spec[None], n=2 * L, axis=1)[:, :L]
    return y + u * bias


def _fourier_mix(u_a):
    b, L, _ = u_a.shape
    ua = u_a.astype(jnp.float32).reshape(b, L, FNET_GROUPS, FNET_GROUP_DIM)
    return jnp.fft.fft2(ua, axes=(1, 3), norm='ortho').real.reshape(b, L, FNET_WIDTH)


def _hyena_mix(u_b, conv_w, conv_b, bias, fw0, fb0, fw1, fb1, fw2, fb2, fw3, freq):
    f32 = jnp.float32
    L = u_b.shape[1]
    z = _short_conv(u_b.astype(f32), conv_w.astype(f32), conv_b.astype(f32))
    v, x1, x0 = jnp.split(z, 3, axis=-1)
    k_spec = _hyena_filter_spectrum(L, fw0, fb0, fw1, fb1, fw2, fb2, fw3, freq)
    return x0 * _fft_long_conv(v * x1, k_spec, bias.astype(f32))


def _even_mixer(h, w_in, w_out, conv_w, conv_b, hy_bias, fw0, fb0, fw1, fb1, fw2, fb2, fw3, freq):
    u = h @ w_in
    a = _fourier_mix(u[..., :FNET_WIDTH])
    b = _hyena_mix(u[..., FNET_WIDTH:], conv_w, conv_b, hy_bias, fw0, fb0, fw1, fb1, fw2, fb2, fw3, freq)
    return jnp.concatenate([a, b], axis=-1).astype(h.dtype) @ w_out


def _axial_rope(t, row, col):
    inv = ROPE_THETA ** (-jnp.arange(0, AXIS_ROPE_DIM, 2, dtype=jnp.float32) / AXIS_ROPE_DIM)

    def rot(seg, p):
        ang = p[:, None] * inv[None, :]
        cos = jnp.cos(ang)[None, :, None, :]
        sin = jnp.sin(ang)[None, :, None, :]
        s1, s2 = jnp.split(seg, 2, axis=-1)
        return jnp.concatenate([s1 * cos - s2 * sin, s1 * sin + s2 * cos], axis=-1)

    return jnp.concatenate([rot(t[..., :AXIS_ROPE_DIM], row), rot(t[..., AXIS_ROPE_DIM:], col)], axis=-1)


def _sink_attend(q, keys, values, masks, sink):
    scale = HEAD_DIM ** -0.5
    scores = []
    for k, m in zip(keys, masks):
        s = jnp.einsum('bqhgd,bkhd->bhgqk', q, k) * scale
        if m is not None:
            s = jnp.where(m, s, NEG_INF)
        scores.append(s)
    b, nq = q.shape[0], q.shape[1]
    sink_col = jnp.broadcast_to(sink.astype(jnp.float32).reshape(1, N_KV_HEADS, GROUP, 1, 1),
                                (b, N_KV_HEADS, GROUP, nq, 1))
    p = jax.nn.softmax(jnp.concatenate(scores + [sink_col], axis=-1), axis=-1)
    off = 0
    out = None
    for v in values:
        n = v.shape[1]
        o = jnp.einsum('bhgqk,bkhd->bqhgd', p[..., off:off + n], v)
        out = o if out is None else out + o
        off += n
    return out


def _window_attention(q, k, v, k_ctx, v_ctx, sink):
    b, L = q.shape[0], q.shape[1]
    nb = L // BLOCK_Q
    qb = jnp.moveaxis(q.reshape(b, nb, BLOCK_Q, N_KV_HEADS, GROUP, HEAD_DIM), 1, 0)

    def band(t):
        tp = jnp.pad(t, ((0, 0), (BLOCK_Q, BLOCK_Q), (0, 0), (0, 0)))
        tp = tp.reshape(b, nb + 2, BLOCK_Q, N_KV_HEADS, HEAD_DIM)
        t3 = jnp.concatenate([tp[:, :-2], tp[:, 1:-1], tp[:, 2:]], axis=2)
        return jnp.moveaxis(t3, 1, 0)

    kb, vb = band(k), band(v)
    offs_q = jnp.arange(BLOCK_Q)
    offs_k = jnp.arange(3 * BLOCK_Q) - BLOCK_Q

    def body(args):
        blk, qi, ki, vi = args
        qpos = blk * BLOCK_Q + offs_q
        kpos = blk * BLOCK_Q + offs_k
        m = ((kpos[None, :] >= 0) & (kpos[None, :] < L)
             & (jnp.abs(qpos[:, None] - kpos[None, :]) <= WINDOW))
        return _sink_attend(qi, [ki, k_ctx], [vi, v_ctx], [m, None], sink)

    o = lax.map(body, (jnp.arange(nb), qb, kb, vb))
    return jnp.moveaxis(o, 0, 1).reshape(b, L, Q_WIDTH)


def _heads(t, n):
    return t.astype(jnp.float32).reshape(t.shape[0], t.shape[1], n, HEAD_DIM)


def _odd_mixer(hx, hc, w_qkv, w_out, q_g, k_g, sink, need_ctx_out):
    dt = hx.dtype
    b, L, _ = hx.shape
    lc = hc.shape[1]
    qkv = hx @ w_qkv
    q = _rmsnorm(_heads(qkv[..., :Q_WIDTH], N_HEADS), q_g)
    k = _rmsnorm(_heads(qkv[..., Q_WIDTH:Q_WIDTH + KV_WIDTH], N_KV_HEADS), k_g)
    v = _heads(qkv[..., Q_WIDTH + KV_WIDTH:], N_KV_HEADS)
    rows = L // GRID_W
    row = jnp.repeat(jnp.arange(rows, dtype=jnp.float32), GRID_W)
    col = jnp.tile(jnp.arange(GRID_W, dtype=jnp.float32), rows)
    q = _axial_rope(q, row, col).reshape(b, L, N_KV_HEADS, GROUP, HEAD_DIM)
    k = _axial_rope(k, row, col)
    c_off = 0 if need_ctx_out else Q_WIDTH
    cp = hc @ w_qkv[:, c_off:]
    kc = _rmsnorm(_heads(cp[..., Q_WIDTH - c_off:Q_WIDTH - c_off + KV_WIDTH], N_KV_HEADS), k_g)
    vc = _heads(cp[..., Q_WIDTH - c_off + KV_WIDTH:], N_KV_HEADS)
    o_lat = _window_attention(q, k, v, kc, vc, sink).astype(dt) @ w_out
    o_ctx = None
    if need_ctx_out:
        qc = _rmsnorm(_heads(cp[..., :Q_WIDTH], N_HEADS), q_g).reshape(b, lc, N_KV_HEADS, GROUP, HEAD_DIM)
        o_ctx = _sink_attend(qc, [kc], [vc], [None], sink).reshape(b, lc, Q_WIDTH).astype(dt) @ w_out
    return o_lat, o_ctx


def _moe_swiglu(h, w_router, w_gate, w_up, w_down):
    dt = h.dtype
    b, L, d = h.shape
    n = b * L
    xf = h.reshape(n, d)
    logits = (xf @ w_router).astype(jnp.float32)
    top_val, top_idx = lax.top_k(logits, TOP_K)
    gates = jax.nn.softmax(top_val, axis=-1)
    e_flat = top_idx.reshape(-1)
    t_flat = jnp.repeat(jnp.arange(n, dtype=jnp.int32), TOP_K)
    g_flat = gates.reshape(-1)
    order = jnp.argsort(e_flat)
    e_sorted = e_flat[order]
    counts = jnp.bincount(e_flat, length=N_EXPERTS)
    padded = (counts + EXPERT_BLOCK - 1) // EXPERT_BLOCK * EXPERT_BLOCK
    start = jnp.cumsum(counts) - counts
    pend = jnp.cumsum(padded)
    pstart = pend - padded
    dest = pstart[e_sorted] + jnp.arange(n * TOP_K) - start[e_sorted]
    n_slots = (n * TOP_K + EXPERT_BLOCK - 1) // EXPERT_BLOCK * EXPERT_BLOCK + N_EXPERTS * EXPERT_BLOCK
    n_blocks = n_slots // EXPERT_BLOCK
    tok_buf = jnp.full((n_slots,), n, dtype=jnp.int32).at[dest].set(t_flat[order])
    gate_buf = jnp.zeros((n_slots,), jnp.float32).at[dest].set(g_flat[order])
    block_e = jnp.minimum(jnp.searchsorted(pend, jnp.arange(n_blocks) * EXPERT_BLOCK, side='right'),
                          N_EXPERTS - 1)
    xpad = jnp.concatenate([xf, jnp.zeros((1, d), dt)], axis=0)

    def block(args):
        tok, e = args
        xb = xpad[tok]
        return _swiglu(xb, w_gate[e], w_up[e], w_down[e])

    yb = lax.map(block, (tok_buf.reshape(n_blocks, EXPERT_BLOCK), block_e))
    y = jnp.zeros((n + 1, d), dt).at[tok_buf].add(yb.reshape(n_slots, d) * gate_buf[:, None].astype(dt))
    return y[:n].reshape(b, L, d)


def setup_inputs(seed: int = 0) -> dict:
    key = jax.random.key(seed)
    ks = iter(jax.random.split(key, 40))
    n_ev = (DEPTH + 1) // 2
    n_od = DEPTH // 2
    D = D_MODEL

    def nrm(shape, scale=1.0):
        return jax.random.normal(next(ks), shape, jnp.float32) * scale

    return {
        'x': nrm((BATCH, SEQ, D)),
        'c': nrm((BATCH, D)),
        'ctx': nrm((BATCH, CTX_LEN, D)),
        'c_ctx': nrm((D,)),
        'ada_w': nrm((DEPTH, D, N_MOD * D), 0.5 * D ** -0.5),
        'ada_b': nrm((DEPTH, N_MOD * D), 0.01),
        'norm1_g': 1.0 + nrm((DEPTH, D), 0.02),
        'norm2_g': 1.0 + nrm((DEPTH, D), 0.02),
        'ev_w_in': nrm((n_ev, D, EVEN_IN_WIDTH), D ** -0.5),
        'ev_w_out': nrm((n_ev, EVEN_MIX_WIDTH, D), EVEN_MIX_WIDTH ** -0.5),
        'hy_conv_w': nrm((n_ev, HY_SHORT_CONV, 3 * HY_WIDTH), HY_SHORT_CONV ** -0.5),
        'hy_conv_b': nrm((n_ev, 3 * HY_WIDTH), 0.02),
        'hy_bias': nrm((n_ev, HY_WIDTH), 0.5),
        'hf_w0': nrm((n_ev, HY_EMB_DIM, HY_FILTER_HIDDEN), HY_EMB_DIM ** -0.5),
        'hf_b0': nrm((n_ev, HY_FILTER_HIDDEN), 0.1),
        'hf_w1': nrm((n_ev, HY_FILTER_HIDDEN, HY_FILTER_HIDDEN), HY_FILTER_HIDDEN ** -0.5),
        'hf_b1': nrm((n_ev, HY_FILTER_HIDDEN), 0.1),
        'hf_w2': nrm((n_ev, HY_FILTER_HIDDEN, HY_FILTER_HIDDEN), HY_FILTER_HIDDEN ** -0.5),
        'hf_b2': nrm((n_ev, HY_FILTER_HIDDEN), 0.1),
        'hf_w3': nrm((n_ev, HY_FILTER_HIDDEN, 2 * HY_WIDTH), HY_FILTER_HIDDEN ** -0.5),
        'hf_freq': 1.0 + nrm((n_ev, HY_FILTER_HIDDEN), 0.1),
        'ffn_w_gate': nrm((n_ev, D, D_FF), D ** -0.5),
        'ffn_w_up': nrm((n_ev, D, D_FF), D ** -0.5),
        'ffn_w_down': nrm((n_ev, D_FF, D), D_FF ** -0.5),
        'od_w_qkv': nrm((n_od, D, Q_WIDTH + 2 * KV_WIDTH), D ** -0.5),
        'od_w_out': nrm((n_od, Q_WIDTH, D), Q_WIDTH ** -0.5),
        'q_norm_g': 1.0 + nrm((n_od, HEAD_DIM), 0.02),
        'k_norm_g': 1.0 + nrm((n_od, HEAD_DIM), 0.02),
        'attn_sink': nrm((n_od, N_HEADS), 0.5),
        'moe_router': nrm((n_od, D, N_EXPERTS), D ** -0.5),
        'moe_w_gate': nrm((n_od, N_EXPERTS, D, D_FF), D ** -0.5),
        'moe_w_up': nrm((n_od, N_EXPERTS, D, D_FF), D ** -0.5),
        'moe_w_down': nrm((n_od, N_EXPERTS, D_FF, D), D_FF ** -0.5),
    }


def reference(x, c, ctx, c_ctx, ada_w, ada_b, norm1_g, norm2_g, ev_w_in, ev_w_out,
              hy_conv_w, hy_conv_b, hy_bias, hf_w0, hf_b0, hf_w1, hf_b1, hf_w2, hf_b2, hf_w3, hf_freq,
              ffn_w_gate, ffn_w_up, ffn_w_down, od_w_qkv, od_w_out, q_norm_g, k_norm_g, attn_sink,
              moe_router, moe_w_gate, moe_w_up, moe_w_down):
    for i in range(DEPTH):
        j = i // 2
        last = i == DEPTH - 1
        ml = jnp.split((jax.nn.silu(c) @ ada_w[i] + ada_b[i])[:, None, :], N_MOD, axis=-1)
        mc = jnp.split((jax.nn.silu(c_ctx) @ ada_w[i] + ada_b[i])[None, None, :], N_MOD, axis=-1)
        hx = _modulate(_rmsnorm(x, norm1_g[i]), ml[0], ml[1])
        hc = _modulate(_rmsnorm(ctx, norm1_g[i]), mc[0], mc[1])
        if i % 2 == 0:
            ev = (ev_w_in[j], ev_w_out[j], hy_conv_w[j], hy_conv_b[j], hy_bias[j],
                  hf_w0[j], hf_b0[j], hf_w1[j], hf_b1[j], hf_w2[j], hf_b2[j], hf_w3[j], hf_freq[j])
            x = x + ml[2] * _even_mixer(hx, *ev)
            if not last:
                ctx = ctx + mc[2] * _even_mixer(hc, *ev)
            hx2 = _modulate(_rmsnorm(x, norm2_g[i]), ml[3], ml[4])
            x = x + ml[5] * _swiglu(hx2, ffn_w_gate[j], ffn_w_up[j], ffn_w_down[j])
            if not last:
                hc2 = _modulate(_rmsnorm(ctx, norm2_g[i]), mc[3], mc[4])
                ctx = ctx + mc[5] * _swiglu(hc2, ffn_w_gate[j], ffn_w_up[j], ffn_w_down[j])
        else:
            o_lat, o_ctx = _odd_mixer(hx, hc, od_w_qkv[j], od_w_out[j], q_norm_g[j], k_norm_g[j],
                                      attn_sink[j], not last)
            x = x + ml[2] * o_lat
            if not last:
                ctx = ctx + mc[2] * o_ctx
            hx2 = _modulate(_rmsnorm(x, norm2_g[i]), ml[3], ml[4])
            x = x + ml[5] * _moe_swiglu(hx2, moe_router[j], moe_w_gate[j], moe_w_up[j], moe_w_down[j])
            if not last:
                hc2 = _modulate(_rmsnorm(ctx, norm2_g[i]), mc[3], mc[4])
                ctx = ctx + mc[5] * _moe_swiglu(hc2, moe_router[j], moe_w_gate[j], moe_w_up[j], moe_w_down[j])
    return x
```

```cpp
#include <hip/hip_runtime.h>
#include <cstdio>
#include <cstdint>

#define LAS __attribute__((address_space(3)))
typedef unsigned short bf16_t;
typedef short bf16x8 __attribute__((ext_vector_type(8)));
typedef float f32x4 __attribute__((ext_vector_type(4)));
typedef float f32x2 __attribute__((ext_vector_type(2)));
typedef unsigned u32x4 __attribute__((ext_vector_type(4)));
typedef unsigned u32x2 __attribute__((ext_vector_type(2)));
typedef __bf16 bf16x2_t __attribute__((ext_vector_type(2)));
typedef float f32x16 __attribute__((ext_vector_type(16)));
typedef int i32x8 __attribute__((ext_vector_type(8)));
typedef unsigned char fp8_t;

constexpr int D = 1024, NB = 16, SEQ = 4096, NTOK = NB * SEQ, LCTX = 256, NCTX = NB * LCTX, MROWS = NTOK + NCTX;
constexpr int DFF = 3584, NE = 8, NMOD = 6 * D;
constexpr int UCH = 2560;
constexpr int MAXSLOT = 133120;
constexpr int MAXTILES = MAXSLOT / 256;
constexpr int NCHUNK = 1;
constexpr float EPS = 1e-6f;

constexpr size_t al4k(size_t x) { return (x + 4095) & ~(size_t)4095; }
constexpr size_t MiB = 1024 * 1024;
constexpr size_t OFF_CTL = 0;
constexpr size_t OFF_MOD = 65536;
constexpr size_t OFF_ROPE = OFF_MOD + al4k((size_t)2 * 17 * NMOD * 4);
constexpr size_t OFF_H3 = OFF_ROPE + al4k(2 * 64 * 16 * 4 + 512);
constexpr size_t OFF_KF = OFF_H3 + al4k((size_t)4352 * 64 * 4);
constexpr size_t OFF_KFC = OFF_KF + (size_t)512 * 8192 * 4;
constexpr size_t OFF_ROUTE = OFF_KFC + (size_t)512 * 512 * 4;
constexpr size_t OFF_HIST = OFF_ROUTE + (size_t)NTOK * 16;
constexpr size_t OFF_TOK = OFF_HIST + al4k(256 * 8 * 4);
constexpr size_t OFF_GW = OFF_TOK + al4k((size_t)MAXSLOT * 4);
constexpr size_t OFF_SLOTOF = OFF_GW + al4k((size_t)MAXSLOT * 4);
constexpr size_t OFF_TILEE = OFF_SLOTOF + (size_t)NTOK * 8;
constexpr size_t OFF_CTXR = OFF_TILEE + 4096;
constexpr size_t OFF_WIN = OFF_CTXR + (size_t)NCTX * D * 4;
constexpr size_t OFF_WOUT = OFF_WIN + (size_t)UCH * D * 2;
constexpr size_t OFF_WGU = OFF_WOUT + (size_t)D * D * 2;
constexpr size_t OFF_WD = OFF_WGU + (size_t)2 * DFF * D * 2;
constexpr size_t OFF_WQKV = OFF_WD + (size_t)D * DFF * 2;
constexpr size_t OFF_WO2 = OFF_WQKV + (size_t)1536 * D * 2;
constexpr size_t OFF_DFTC = OFF_WO2 + (size_t)D * D * 2;
constexpr size_t OFF_A_END = OFF_DFTC + (size_t)256 * 512 * 2;
static_assert(OFF_A_END <= 80 * MiB, "region A");
constexpr size_t OFF_HX = 80 * MiB;
constexpr size_t OFF_UT = 216 * MiB;
constexpr size_t OFF_UTC = 536 * MiB;
constexpr size_t OFF_MIX = 556 * MiB;
constexpr size_t OFF_HT = 692 * MiB;
constexpr size_t OFF_HTC = 756 * MiB;
constexpr size_t OFF_DFT = 760 * MiB;
constexpr size_t OFF_HID = 216 * MiB;
constexpr size_t OFF_Q = 216 * MiB;
constexpr size_t OFF_K = 344 * MiB;
constexpr size_t OFF_V = 378 * MiB;
constexpr size_t OFF_AO = 412 * MiB;
constexpr size_t OFF_HX8 = 80 * MiB;
constexpr size_t OFF_HIDM = 144 * MiB;
constexpr size_t OFF_Y = 600 * MiB;
constexpr size_t OFF_MGU = 860 * MiB;
constexpr size_t OFF_MD = 916 * MiB;
static_assert(OFF_HIDM + (size_t)MAXSLOT * DFF <= OFF_Y && OFF_Y + (size_t)MAXSLOT * D * 2 <= OFF_MGU, "moe map");
constexpr size_t OFF_AT = 760 * MiB;
constexpr size_t OFF_TW = OFF_KF;
constexpr size_t OFF_VXF = OFF_HX;
constexpr size_t OFF_GT = 824 * MiB;
constexpr size_t OFF_RC = 952 * MiB;
constexpr size_t WS_NEED = 988 * MiB;


constexpr int LDS_BYTES = 151552;
constexpr int LDS_MISC = LDS_BYTES - 1024;

__device__ __forceinline__ unsigned cvt_pk_bf16(float lo, float hi) { unsigned r; asm volatile("v_cvt_pk_bf16_f32 %0, %1, %2" : "=v"(r) : "v"(lo), "v"(hi)); return r; }
__device__ __forceinline__ bf16_t f2bf(float f) { unsigned u = __float_as_uint(f); u += 0x7FFFu + ((u >> 16) & 1u); return (bf16_t)(u >> 16); }
__device__ __forceinline__ float bf2f(bf16_t b) { return __uint_as_float(((unsigned)b) << 16); }
__device__ __forceinline__ float bflo(unsigned u) { return __uint_as_float(u << 16); }
__device__ __forceinline__ float bfhi(unsigned u) { return __uint_as_float(u & 0xffff0000u); }
__device__ __forceinline__ float dot2(unsigned a, unsigned b, float acc) { return __builtin_amdgcn_fdot2_f32_bf16(__builtin_bit_cast(bf16x2_t, a), __builtin_bit_cast(bf16x2_t, b), acc, false); }
__device__ __forceinline__ float wave_sum(float v) {
#pragma unroll
    for (int o = 32; o >= 1; o >>= 1) v += __shfl_xor(v, o);
    return v;
}
__device__ __forceinline__ unsigned pk4_fp8(float a, float b, float c, float d) { int w = __builtin_amdgcn_cvt_pk_fp8_f32(a, b, 0, false); w = __builtin_amdgcn_cvt_pk_fp8_f32(c, d, w, true); return (unsigned)w; }
constexpr float F8_ACT = 16.0f, F8_W = 64.0f, F8_HID = 8.0f;
__device__ __forceinline__ int otid() { int t = threadIdx.x; asm volatile("" : "+v"(t)); return t; }
__device__ __forceinline__ float silu_f(float x) { return x / (1.0f + __expf(-x)); }

#define XB_TMO      128
#define XB_XCNT(j)  (256  + 64 * (j))
#define XB_XSUB(j)  (1280 + 64 * (j))
#define XB_XGEN(j)  (2304 + 64 * (j))
#define XB_TOP      3328
#define XB_TOPGEN   3392
#define XCD_BAR_WORDS 3456
#define XB_SPIN_CAP (1u << 22)

__device__ __forceinline__ unsigned xb_ld(unsigned* p)              { return __hip_atomic_load(p, __ATOMIC_RELAXED, __HIP_MEMORY_SCOPE_AGENT); }
__device__ __forceinline__ unsigned xb_add(unsigned* p, unsigned v) { return __hip_atomic_fetch_add(p, v, __ATOMIC_RELAXED, __HIP_MEMORY_SCOPE_AGENT); }
__device__ __forceinline__ unsigned xb_xcc_id() { return (unsigned)__builtin_amdgcn_s_getreg((3 << 11) | 20) & 0xFu; }
#define XB_SPIN(cond, bar) do { unsigned _sp = 0; while (cond) { __builtin_amdgcn_s_sleep(1); \
    if ((++_sp & 255u) == 0u) { if (xb_ld(&(bar)[XB_TMO])) break; if (_sp > XB_SPIN_CAP) { atomicAdd(&(bar)[XB_TMO], 1u); break; } } } } while (0)

struct XcdBarrier { volatile LAS unsigned* st; };

__device__ __forceinline__ XcdBarrier xcd_barrier_post(unsigned* bar, volatile LAS unsigned* st) {
    XcdBarrier b; b.st = st;
    if (threadIdx.x == 0) { const unsigned x = xb_xcc_id(); st[2] = x; (void)xb_add(&bar[XB_XCNT(x)], 1u); }
    return b;
}
__device__ __forceinline__ void xcd_barrier_complete(unsigned* bar, unsigned x, unsigned& nloc, unsigned& nx) {
    const unsigned G = gridDim.x * gridDim.y * gridDim.z;
    unsigned sum, cnt, mine, sp = 0u;
    for (;;) {
        sum = 0u; cnt = 0u;
#pragma unroll
        for (unsigned j = 0; j < 16; ++j) { const unsigned c = xb_ld(&bar[XB_XCNT(j)]); sum += c; cnt += (c > 0u) ? 1u : 0u; }
        mine = xb_ld(&bar[XB_XCNT(x)]);
        if (sum == G) break;
        __builtin_amdgcn_s_sleep(1);
        if ((++sp & 255u) == 0u) { if (xb_ld(&bar[XB_TMO])) break; if (sp > XB_SPIN_CAP) { atomicAdd(&bar[XB_TMO], 1u); break; } }
    }
    nloc = mine > 0u ? mine : 1u; nx = cnt > 0u ? cnt : 1u;
}
__device__ __forceinline__ void xcd_barrier(const XcdBarrier& b, unsigned* bar) {
    asm volatile("s_waitcnt vmcnt(0)" ::: "memory");
    __syncthreads();
    if (threadIdx.x == 0) {
        __builtin_amdgcn_s_waitcnt(0);
        unsigned nloc = b.st[0], nx = b.st[1]; const unsigned bx_ = b.st[2];
        if (nloc == 0u) { xcd_barrier_complete(bar, bx_, nloc, nx); b.st[0] = nloc; b.st[1] = nx; }
        const unsigned old = xb_add(&bar[XB_XSUB(bx_)], 1u);
        const unsigned gen = old / nloc;
        if (old + 1u == (gen + 1u) * nloc) {
            __builtin_amdgcn_fence(__ATOMIC_RELEASE, "agent");
            asm volatile("s_waitcnt vmcnt(0)" ::: "memory");
            const unsigned og = xb_add(&bar[XB_TOP], 1u);
            const unsigned tg = og / nx;
            if (og + 1u == (tg + 1u) * nx) xb_add(&bar[XB_TOPGEN], 1u);
            else XB_SPIN(xb_ld(&bar[XB_TOPGEN]) == tg, bar);
            __builtin_amdgcn_fence(__ATOMIC_ACQUIRE, "agent");
            xb_add(&bar[XB_XGEN(bx_)], 1u);
            asm volatile("s_waitcnt vmcnt(0)" ::: "memory");
        } else {
            XB_SPIN(xb_ld(&bar[XB_XGEN(bx_)]) == gen, bar);
            __builtin_amdgcn_fence(__ATOMIC_ACQUIRE, "agent");
            asm volatile("s_waitcnt vmcnt(0)" ::: "memory");
        }
    }
    __syncthreads();
}

constexpr int BM = 256, BK = 64, HALF = 128, HTB = HALF * BK * 2, NXCD = 8, WGM = 8;
__host__ __device__ __forceinline__ int lds_byte(int r, int c) { const int st = (r >> 4) * 2 + (c >> 5), rr = r & 15, cc = c & 31, ob = rr * 64 + cc * 2; return st * 1024 + (ob ^ (((ob >> 9) & 1) << 5)); }
__host__ __device__ __forceinline__ void stage_rc(int b, int& R, int& C) { const int st = b / 1024, sb = b % 1024, swz = sb ^ (((sb >> 9) & 1) << 5); R = (st >> 1) * 16 + swz / 64; C = (st & 1) * 32 + (swz % 64) / 2; }
__host__ __device__ __forceinline__ int perm32(int rho) { const int n = rho >> 4, i = rho & 15; return 8 * (i >> 2) + 4 * n + (i & 3); }

struct Unit { int pm, pn; };
struct TileOrder {
    int nM, nN, nwg, G, c;
    __device__ __forceinline__ void init(int nM_, int nN_, int G_, int c_) { nM = nM_; nN = nN_; nwg = nM * nN; G = G_; c = c_; }
    __device__ __forceinline__ bool next(int i, Unit& u) const {
        const long L = (long)i * G + c; if (L >= nwg) return false;
        int wgid = (int)L; { const int q = nwg / NXCD, r = nwg % NXCD, xcd = wgid % NXCD, off = wgid / NXCD; wgid = (xcd < r ? xcd * (q + 1) : r * (q + 1) + (xcd - r) * q) + off; }
        const int nig = WGM * nN, gid = wgid / nig, fm = gid * WGM, gsz = (nM - fm) < WGM ? (nM - fm) : WGM;
        u.pm = fm + ((wgid % nig) % gsz); u.pn = (wgid % nig) / gsz; return true;
    }
};

template <int NN> struct LinOrder {
    int nwg, G, c;
    __device__ __forceinline__ void init(int nM_, int, int G_, int c_) { nwg = nM_ * NN; G = G_; c = c_; }
    __device__ __forceinline__ bool next(int i, Unit& u) const { const int L = i * G + c; if (L >= nwg) return false; u.pm = L / NN; u.pn = L % NN; return true; }
};

typedef f32x4 AccT[2][2][4][2];
typedef unsigned u32x8 __attribute__((ext_vector_type(8)));
template <bool F8> struct Frag;
template <> struct Frag<false> { bf16x8 k[2]; };
template <> struct Frag<true> { u32x8 q; };

template <int K, class P>
__device__ __forceinline__ void gemm_phase(LAS unsigned char* lds, const P& p) {
    int tid_ = threadIdx.x; asm volatile("" : "+v"(tid_));
    const int tid = tid_, wid = __builtin_amdgcn_readfirstlane(tid >> 6), lane = tid & 63, wr = wid >> 2, wc = wid & 3, fr = lane & 15, fq = lane >> 4;
    constexpr int RB = P::FP8 ? K : K * 2;
    constexpr int nt = RB / 128;
    constexpr unsigned hstep = (unsigned)HALF * RB;
    unsigned vA[2], vB[2], vG[2][2], vGn[2][2];
#pragma unroll
    for (int i = 0; i < 2; ++i) { int R, C; stage_rc(tid * 16 + i * 8192, R, C); const int Rb = P::PERM ? ((R & ~31) + perm32(R & 31)) : R;
        vA[i] = (unsigned)(R * RB + C * 2); vB[i] = (unsigned)(Rb * RB + C * 2); }
    constexpr size_t kstep = (size_t)(BK * 2);
    const unsigned ldsw = (unsigned)wid * 1024u;
    const int aoff = P::FP8 ? lds_byte(wr * 64 + fr, fq * 16) : lds_byte(wr * 64 + fr, fq * 8), boff = P::FP8 ? lds_byte(wc * 32 + fr, fq * 16) : lds_byte(wc * 32 + fr, fq * 8);
#define PG8_SA(b, h) (((b) * 2 + (h)) * HTB)
#define PG8_SB(b, h) ((4 + (b) * 2 + (h)) * HTB)
#define PG8_STAGE(bufoff, gbase, v0, v1) do { \
        __builtin_amdgcn_global_load_lds((const unsigned*)((const char*)(gbase) + (v0)), (LAS unsigned*)(lds + (bufoff) + ldsw), 16, 0, 0); \
        __builtin_amdgcn_global_load_lds((const unsigned*)((const char*)(gbase) + (v1)), (LAS unsigned*)(lds + (bufoff) + ldsw + 8192), 16, 0, 0); } while (0)
#define PG8_STB(bufoff, gbase, h) PG8_STAGE(bufoff, (gbase) + (h) * hstep, vB[0], vB[1])
#define PG8_STAX(bufoff, gbase, h, nx) do { if constexpr (P::GATHER) { PG8_STAGE(bufoff, gbase, ((nx) ? vGn[h][0] : vG[h][0]), ((nx) ? vGn[h][1] : vG[h][1])); } \
        else { PG8_STAGE(bufoff, (gbase) + (h) * hstep, vA[0], vA[1]); } } while (0)
#define PG8_STA(bufoff, gbase, h) PG8_STAX(bufoff, gbase, h, false)
#define PG8_LD8(addr) __builtin_shufflevector(*(const LAS u32x4*)(addr), *(const LAS u32x4*)((addr) + 16), 0, 1, 2, 3, 4, 5, 6, 7)
#define PG8_LDA(dst, b, h) do { if constexpr (P::FP8) { _Pragma("unroll") for (int m = 0; m < 4; ++m) dst[m].q = PG8_LD8(lds + PG8_SA(b, h) + aoff + m * 2048); } \
        else { _Pragma("unroll") for (int m = 0; m < 4; ++m) _Pragma("unroll") for (int k = 0; k < 2; ++k) dst[m].k[k] = *(const LAS bf16x8*)(lds + PG8_SA(b, h) + aoff + m * 2048 + k * 1024); } } while (0)
#define PG8_LDB(dst, b, h) do { if constexpr (P::FP8) { _Pragma("unroll") for (int n = 0; n < 2; ++n) dst[n].q = PG8_LD8(lds + PG8_SB(b, h) + boff + n * 2048); } \
        else { _Pragma("unroll") for (int n = 0; n < 2; ++n) _Pragma("unroll") for (int k = 0; k < 2; ++k) dst[n].k[k] = *(const LAS bf16x8*)(lds + PG8_SB(b, h) + boff + n * 2048 + k * 1024); } } while (0)
#define PG8_MMA(ai, bj, At, Bt) do { __builtin_amdgcn_s_setprio(1); if constexpr (P::FP8) { _Pragma("unroll") for (int m = 0; m < 4; ++m) _Pragma("unroll") for (int n = 0; n < 2; ++n) \
            asm volatile("v_mfma_scale_f32_16x16x128_f8f6f4 %0, %1, %2, %0, %3, %3 op_sel_hi:[0,0,0]" : "+v"(acc[ai][bj][m][n]) : "v"(Bt[n].q), "v"(At[m].q), "v"(f8scale)); } \
        else { _Pragma("unroll") for (int m = 0; m < 4; ++m) _Pragma("unroll") for (int n = 0; n < 2; ++n) _Pragma("unroll") for (int k = 0; k < 2; ++k) \
            acc[ai][bj][m][n] = __builtin_amdgcn_mfma_f32_16x16x32_bf16(Bt[n].k[k], At[m].k[k], acc[ai][bj][m][n], 0, 0, 0); } __builtin_amdgcn_s_setprio(0); } while (0)
#define PG8_WAIT_V(n) asm volatile("s_waitcnt vmcnt(" #n ")" ::: "memory")
#define PG8_WAIT_L(n) asm volatile("s_waitcnt lgkmcnt(" #n ")" ::: "memory")
#define PG8_BAR __builtin_amdgcn_s_barrier()
#define PG8_SCHED __builtin_amdgcn_sched_barrier(0)
#define PG8_GROWS(dst, u) do { if constexpr (P::GATHER) { _Pragma("unroll") for (int i = 0; i < 2; ++i) { int R, C; stage_rc(tid * 16 + i * 8192, R, C); \
        _Pragma("unroll") for (int h = 0; h < 2; ++h) dst[h][i] = (unsigned)(p.arow(u, h * HALF + R) * RB + C * 2); } } } while (0)
    Unit cur, nxt; int ui = 0;
    if (!p.next(0, cur)) return;
    AccT acc;
#pragma unroll
    for (int a = 0; a < 2; ++a)
#pragma unroll
        for (int b = 0; b < 2; ++b)
#pragma unroll
            for (int m = 0; m < 4; ++m)
#pragma unroll
                for (int n = 0; n < 2; ++n) acc[a][b][m][n] = (f32x4){0.f, 0.f, 0.f, 0.f};
    Frag<P::FP8> At[4], B0[2], B1[2];
    unsigned f8scale = 0x7f7f7f7fu; asm volatile("" : "+v"(f8scale));
    const char* cA = p.abase(cur); const char* cB = p.bbase(cur);
    PG8_GROWS(vG, cur);
    PG8_GROWS(vGn, cur);
    PG8_STB(PG8_SB(0, 0), cB, 0); PG8_STB(PG8_SB(0, 1), cB, 1); PG8_STA(PG8_SA(0, 0), cA, 0); PG8_STA(PG8_SA(0, 1), cA, 1);
    if (wr == 1) PG8_BAR;
    PG8_WAIT_V(2); PG8_BAR;
    PG8_STB(PG8_SB(1, 0), cB + kstep, 0); PG8_STA(PG8_SA(1, 0), cA + kstep, 0); PG8_STB(PG8_SB(1, 1), cB + kstep, 1);
    PG8_WAIT_V(6); PG8_BAR;
    for (;;) {
        const bool has_next = p.next(ui + 1, nxt);
        const char* nA = cA; const char* nB = cB;
        if (has_next) { nA = p.abase(nxt); nB = p.bbase(nxt); PG8_GROWS(vGn, nxt); }
#pragma unroll 1
        for (int t = 0; t < nt; t += 2) {
            const bool last = (t == nt - 2);
            const char* a1 = cA + (size_t)(t + 1) * kstep;
            const char* a2 = last ? nA : cA + (size_t)(t + 2) * kstep; const char* b2 = last ? nB : cB + (size_t)(t + 2) * kstep;
            const char* a3 = a2 + kstep; const char* b3 = b2 + kstep;
            PG8_LDB(B0, 0, 0); PG8_LDB(B1, 0, 1); PG8_SCHED; PG8_LDA(At, 0, 0); PG8_STA(PG8_SA(1, 1), a1, 1);
            PG8_WAIT_V(8); PG8_WAIT_L(0); PG8_BAR; PG8_MMA(0, 0, At, B0); PG8_MMA(0, 1, At, B1); PG8_BAR; PG8_SCHED;
            PG8_LDA(At, 0, 1); PG8_STB(PG8_SB(0, 0), b2, 0); PG8_STB(PG8_SB(0, 1), b2, 1); PG8_STAX(PG8_SA(0, 0), a2, 0, last);
            PG8_WAIT_V(8); PG8_WAIT_L(0); PG8_BAR; PG8_MMA(1, 0, At, B0); PG8_MMA(1, 1, At, B1); PG8_BAR; PG8_SCHED;
            PG8_LDB(B0, 1, 0); PG8_LDB(B1, 1, 1); PG8_SCHED; PG8_LDA(At, 1, 0); PG8_STAX(PG8_SA(0, 1), a2, 1, last);
            PG8_WAIT_V(8); PG8_WAIT_L(0); PG8_BAR; PG8_MMA(0, 0, At, B0); PG8_MMA(0, 1, At, B1); PG8_BAR; PG8_SCHED;
            PG8_LDA(At, 1, 1); PG8_STB(PG8_SB(1, 0), b3, 0); PG8_STB(PG8_SB(1, 1), b3, 1); PG8_STAX(PG8_SA(1, 0), a3, 0, last);
            PG8_WAIT_V(8); PG8_WAIT_L(0); PG8_BAR; PG8_MMA(1, 0, At, B0); PG8_MMA(1, 1, At, B1); PG8_BAR; PG8_SCHED;
        }
        if (wr == 0) PG8_BAR;
        if constexpr (P::FP8) asm volatile("s_nop 15\n\ts_nop 15" ::: "memory");
        p.epi(acc, cur, wr, wc, fr, fq);
        if (!has_next) break;
#pragma unroll
        for (int a = 0; a < 2; ++a)
#pragma unroll
            for (int b = 0; b < 2; ++b)
#pragma unroll
                for (int m = 0; m < 4; ++m)
#pragma unroll
                    for (int n = 0; n < 2; ++n) acc[a][b][m][n] = (f32x4){0.f, 0.f, 0.f, 0.f};
        cur = nxt; cA = nA; cB = nB; ++ui;
        if constexpr (P::GATHER) {
#pragma unroll
            for (int h = 0; h < 2; ++h)
#pragma unroll
                for (int i = 0; i < 2; ++i) vG[h][i] = vGn[h][i];
        }
        if (wr == 1) PG8_BAR;
    }
    PG8_WAIT_V(0);
    PG8_BAR;
#undef PG8_SA
#undef PG8_SB
#undef PG8_STAGE
#undef PG8_STB
#undef PG8_STA
#undef PG8_STAX
#undef PG8_LDA
#undef PG8_LDB
#undef PG8_MMA
#undef PG8_WAIT_V
#undef PG8_WAIT_L
#undef PG8_BAR
#undef PG8_SCHED
#undef PG8_GROWS
#undef PG8_LD8
}


struct PolU {
    static constexpr bool PERM = true, GATHER = false, FP8 = false;
    TileOrder S; const bf16_t* A; const bf16_t* B; bf16_t* UT; bf16_t* UTc;
    __device__ __forceinline__ bool next(int i, Unit& u) const { return S.next(i, u); }
    __device__ __forceinline__ const char* abase(const Unit& u) const { return (const char*)A + (unsigned)u.pm * (unsigned)(BM * D * 2); }
    __device__ __forceinline__ const char* bbase(const Unit& u) const { return (const char*)B + (unsigned)u.pn * (unsigned)(BM * D * 2); }
    __device__ __forceinline__ int arow(const Unit&, int) const { return 0; }
    __device__ __forceinline__ void epi(const AccT& acc, const Unit& u, int wr, int wc, int fr, int fq) const {
        bf16_t* base; int Lrow;
        if (u.pn < 256) { const int b = u.pn >> 4; base = UT + (size_t)b * UCH * SEQ + (u.pn & 15) * 256; Lrow = SEQ; }
        else { const int b = u.pn - 256; base = UTc + (size_t)b * UCH * LCTX; Lrow = LCTX; }
        const int ch0 = u.pm * BM + wr * 64 + fr, c0 = wc * 32 + 8 * fq;
#pragma unroll
        for (int ai = 0; ai < 2; ++ai)
#pragma unroll
            for (int m = 0; m < 4; ++m) { bf16_t* rowp = base + (size_t)(ch0 + ai * HALF + m * 16) * Lrow + c0;
#pragma unroll
                for (int bj = 0; bj < 2; ++bj) { const f32x4 v0 = acc[ai][bj][m][0], v1 = acc[ai][bj][m][1];
                    u32x4 w; w.x = cvt_pk_bf16(v0[0], v0[1]); w.y = cvt_pk_bf16(v0[2], v0[3]); w.z = cvt_pk_bf16(v1[0], v1[1]); w.w = cvt_pk_bf16(v1[2], v1[3]);
                    *(u32x4*)(rowp + bj * HALF) = w; } }
    }
};

struct PolF {
    static constexpr bool PERM = true, GATHER = false, FP8 = false;
    TileOrder S; const bf16_t* DFT; const bf16_t* ZT; bf16_t* MIX; int K, L, tpb  , rowbase; unsigned zstride  ; float scale;
    __device__ __forceinline__ bool next(int i, Unit& u) const { return S.next(i, u); }
    __device__ __forceinline__ const char* abase(const Unit& u) const { return (const char*)DFT + (unsigned)(u.pm % tpb) * (unsigned)(BM * K * 2); }
    __device__ __forceinline__ const char* bbase(const Unit& u) const { return (const char*)ZT + ((unsigned)(u.pm / tpb) * zstride + (unsigned)u.pn * (unsigned)(BM * K)) * 2u; }
    __device__ __forceinline__ int arow(const Unit&, int) const { return 0; }
    __device__ __forceinline__ void epi(const AccT& acc, const Unit& u, int wr, int wc, int fr, int fq) const {
        const int b = u.pm / tpb, kt = u.pm % tpb;
        const int row0 = rowbase + b * L + kt * BM + wr * 64 + fr, c0 = u.pn * BM + wc * 32 + 8 * fq;
#pragma unroll
        for (int ai = 0; ai < 2; ++ai)
#pragma unroll
            for (int m = 0; m < 4; ++m) { bf16_t* rowp = MIX + (size_t)(row0 + ai * HALF + m * 16) * D + c0;
#pragma unroll
                for (int bj = 0; bj < 2; ++bj) { const f32x4 v0 = acc[ai][bj][m][0] * scale, v1 = acc[ai][bj][m][1] * scale;
                    u32x4 w; w.x = cvt_pk_bf16(v0[0], v0[1]); w.y = cvt_pk_bf16(v0[2], v0[3]); w.z = cvt_pk_bf16(v1[0], v1[1]); w.w = cvt_pk_bf16(v1[2], v1[3]);
                    *(u32x4*)(rowp + bj * HALF) = w; } }
    }
};

template <bool F8>
struct PolR {
    static constexpr bool PERM = false, GATHER = false, FP8 = F8;
    static constexpr int ES = F8 ? 1 : 2;
    TileOrder S; const void* A; const void* B; int K; const float* srcL; float* dstL; const float* srcC; float* dstC; const float* gate  ;
    __device__ __forceinline__ bool next(int i, Unit& u) const { return S.next(i, u); }
    __device__ __forceinline__ const char* abase(const Unit& u) const { return (const char*)A + (size_t)((unsigned)u.pm * (unsigned)(BM * ES)) * (unsigned)K; }
    __device__ __forceinline__ const char* bbase(const Unit& u) const { return (const char*)B + (unsigned)u.pn * (unsigned)(BM * K * ES); }
    __device__ __forceinline__ int arow(const Unit&, int) const { return 0; }
    __device__ __forceinline__ void epi(const AccT& acc, const Unit& u, int wr, int wc, int fr, int fq) const {
        const bool lat = u.pm < 256;
        const float* src = lat ? srcL + (size_t)u.pm * BM * D : srcC + (size_t)(u.pm - 256) * BM * D;
        float* dst = lat ? dstL + (size_t)u.pm * BM * D : dstC + (size_t)(u.pm - 256) * BM * D;
        const float* gp = gate + (size_t)(lat ? (u.pm >> 4) : 16) * NMOD;
        const int row0 = wr * 64 + fr, col0 = u.pn * BM + wc * 32 + 4 * fq;
        f32x4 gv[2][2];
#pragma unroll
        for (int bj = 0; bj < 2; ++bj)
#pragma unroll
            for (int n = 0; n < 2; ++n) gv[bj][n] = *(const f32x4*)(gp + col0 + bj * HALF + n * 16) * (F8 ? 1.0f / (F8_HID * F8_W) : 1.0f);
#pragma unroll
        for (int ai = 0; ai < 2; ++ai)
#pragma unroll
            for (int m = 0; m < 4; ++m) { const size_t ro = (size_t)(row0 + ai * HALF + m * 16) * D + col0;
#pragma unroll
                for (int bj = 0; bj < 2; ++bj)
#pragma unroll
                    for (int n = 0; n < 2; ++n) { const f32x4 x = *(const f32x4*)(src + ro + bj * HALF + n * 16);
                        *(f32x4*)(dst + ro + bj * HALF + n * 16) = x + gv[bj][n] * acc[ai][bj][m][n]; } }
    }
};

template <bool GATH, class ORD, bool F8>
struct PolG {
    static constexpr bool PERM = true, GATHER = GATH, FP8 = F8;
    static constexpr int ES = F8 ? 1 : 2;
    ORD S; const void* A; const void* B; void* H; const int* tok; const int* tile_e; int tile0;
    __device__ __forceinline__ bool next(int i, Unit& u) const { return S.next(i, u); }
    __device__ __forceinline__ const char* abase(const Unit& u) const { return GATH ? (const char*)A : (const char*)A + (unsigned)u.pm * (unsigned)(BM * D * ES); }
    __device__ __forceinline__ const char* bbase(const Unit& u) const { const unsigned e = GATH ? (unsigned)tile_e[tile0 + u.pm] : 0u; return (const char*)B + (e * (unsigned)(2 * DFF) + (unsigned)u.pn * BM) * (unsigned)(D * ES); }
    __device__ __forceinline__ int arow(const Unit& u, int r) const { return tok[(tile0 + u.pm) * BM + r]; }
    __device__ __forceinline__ void epi(const AccT& acc, const Unit& u, int wr, int wc, int fr, int fq) const {
        const int row0 = u.pm * BM + wr * 64 + fr, c0 = u.pn * HALF + wc * 32 + 8 * fq;
        constexpr float isc = F8 ? 1.0f / (F8_ACT * F8_W) : 1.0f;
#pragma unroll
        for (int ai = 0; ai < 2; ++ai)
#pragma unroll
            for (int m = 0; m < 4; ++m) {
                float h[8];
#pragma unroll
                for (int n = 0; n < 2; ++n)
#pragma unroll
                    for (int j = 0; j < 4; ++j) { const float g = acc[ai][0][m][n][j] * isc, up = acc[ai][1][m][n][j] * isc; h[n * 4 + j] = silu_f(g) * up; }
                const size_t ro = (size_t)(row0 + ai * HALF + m * 16) * DFF + c0;
                if constexpr (F8) { u32x2 w; w.x = pk4_fp8(h[0] * F8_HID, h[1] * F8_HID, h[2] * F8_HID, h[3] * F8_HID); w.y = pk4_fp8(h[4] * F8_HID, h[5] * F8_HID, h[6] * F8_HID, h[7] * F8_HID);
                    *(u32x2*)((fp8_t*)H + ro) = w; }
                else { u32x4 w; w.x = cvt_pk_bf16(h[0], h[1]); w.y = cvt_pk_bf16(h[2], h[3]); w.z = cvt_pk_bf16(h[4], h[5]); w.w = cvt_pk_bf16(h[6], h[7]);
                    *(u32x4*)((bf16_t*)H + ro) = w; } }
    }
};

constexpr int NQK_UNITS = (MROWS / BM) * 5;
constexpr float QSCALE = 0.18033688011112042f;
struct PolQKV {
    static constexpr bool PERM = false, GATHER = false, FP8 = false;
    TileOrder S; const bf16_t* HX; const bf16_t* W; unsigned char* ws; const float* qkg  ; const float* ropec; const float* ropes;
    __device__ __forceinline__ bool next(int i, Unit& u) const {
        const int L = i * S.G + S.c;
        if (L < NQK_UNITS) return S.next(i, u);
        if (L < NQK_UNITS + MROWS / BM) { u.pm = L - NQK_UNITS; u.pn = 5; return true; }
        return false;
    }
    __device__ __forceinline__ const char* abase(const Unit& u) const { return u.pn == 5 ? (const char*)W + (unsigned)(1280 * D * 2) : (const char*)HX + (unsigned)u.pm * (unsigned)(BM * D * 2); }
    __device__ __forceinline__ const char* bbase(const Unit& u) const { return u.pn == 5 ? (const char*)HX + (unsigned)u.pm * (unsigned)(BM * D * 2) : (const char*)W + (unsigned)u.pn * (unsigned)(BM * D * 2); }
    __device__ __forceinline__ int arow(const Unit&, int) const { return 0; }
    __device__ __forceinline__ void epi(const AccT& acc, const Unit& u, int wr, int wc, int fr, int fq) const {
        if (u.pn == 5) {
            const bool lat = u.pm < 256;
            bf16_t* base = (bf16_t*)(ws + OFF_V) + (lat ? (size_t)(u.pm >> 4) * 256 * SEQ + (u.pm & 15) * 256 : (size_t)NB * 256 * SEQ + (size_t)(u.pm - 256) * 256 * LCTX);
            const int Lrow = lat ? SEQ : LCTX;
            const int f0 = wr * 64 + fr, p0 = wc * 32 + 8 * (fq & 1) + 4 * (fq >> 1);
#pragma unroll
            for (int ai = 0; ai < 2; ++ai)
#pragma unroll
                for (int m = 0; m < 4; ++m) { bf16_t* rowp = base + (size_t)(f0 + ai * HALF + m * 16) * Lrow + p0;
#pragma unroll
                    for (int bj = 0; bj < 2; ++bj)
#pragma unroll
                        for (int n = 0; n < 2; ++n) { const f32x4 v = acc[ai][bj][m][n]; u32x2 w; w.x = cvt_pk_bf16(v[0], v[1]); w.y = cvt_pk_bf16(v[2], v[3]);
                            *(u32x2*)(rowp + bj * HALF + n * 16) = w; } }
            return;
        }
        const int tile = u.pn; const bool ctxrow = u.pm >= 256;
        if (tile < 4 && ctxrow) return;
        const float* gsrc = qkg + (tile < 4 ? 0 : 64);
        const float osc = tile < 4 ? QSCALE : 1.0f;
        f32x4 gv[2][2];
#pragma unroll
        for (int bj = 0; bj < 2; ++bj)
#pragma unroll
            for (int n = 0; n < 2; ++n) gv[bj][n] = *(const f32x4*)(gsrc + 32 * bj + 16 * n + 4 * fq);
#pragma unroll
        for (int ai = 0; ai < 2; ++ai)
#pragma unroll
            for (int m = 0; m < 4; ++m) {
                const int r = u.pm * BM + ai * HALF + wr * 64 + m * 16 + fr;
                f32x4 v[2][2];
#pragma unroll
                for (int bj = 0; bj < 2; ++bj)
#pragma unroll
                    for (int n = 0; n < 2; ++n) v[bj][n] = acc[ai][bj][m][n];
                float ss = 0.f;
#pragma unroll
                for (int bj = 0; bj < 2; ++bj)
#pragma unroll
                    for (int n = 0; n < 2; ++n) ss += v[bj][n][0] * v[bj][n][0] + v[bj][n][1] * v[bj][n][1] + v[bj][n][2] * v[bj][n][2] + v[bj][n][3] * v[bj][n][3];
                ss += __shfl_xor(ss, 16); ss += __shfl_xor(ss, 32);
                const float rs = rsqrtf(ss * (1.0f / 64.0f) + EPS) * osc;
#pragma unroll
                for (int bj = 0; bj < 2; ++bj)
#pragma unroll
                    for (int n = 0; n < 2; ++n) v[bj][n] = v[bj][n] * rs * gv[bj][n];
                if (!ctxrow) {
                    const int l = r & (SEQ - 1), prow = l >> 6, pcol = l & 63;
#pragma unroll
                    for (int bj = 0; bj < 2; ++bj) { const int pp = bj ? pcol : prow;
                        const f32x4 cs = *(const f32x4*)(ropec + pp * 16 + 4 * fq), sn = *(const f32x4*)(ropes + pp * 16 + 4 * fq);
                        const f32x4 s1 = v[bj][0], s2 = v[bj][1];
                        v[bj][0] = s1 * cs - s2 * sn; v[bj][1] = s1 * sn + s2 * cs; }
                }
                const size_t doff = tile < 4 ? OFF_Q + ((size_t)r * D + (tile * 4 + wc) * 64) * 2 : OFF_K + ((size_t)r * 256 + wc * 64) * 2;
                bf16_t* dst = (bf16_t*)(ws + doff);
#pragma unroll
                for (int bj = 0; bj < 2; ++bj)
#pragma unroll
                    for (int n = 0; n < 2; ++n) { u32x2 w; w.x = cvt_pk_bf16(v[bj][n][0], v[bj][n][1]); w.y = cvt_pk_bf16(v[bj][n][2], v[bj][n][3]);
                        *(u32x2*)(dst + 32 * bj + 16 * n + 4 * fq) = w; }
            }
    }
};

struct PolD {
    static constexpr bool PERM = true, GATHER = false, FP8 = true;
    LinOrder<4> S; const fp8_t* A; const fp8_t* B; bf16_t* Y; const float* gw; const int* tile_e; int tile0;
    __device__ __forceinline__ bool next(int i, Unit& u) const { return S.next(i, u); }
    __device__ __forceinline__ const char* abase(const Unit& u) const { return (const char*)A + (size_t)(unsigned)u.pm * (size_t)(BM * DFF); }
    __device__ __forceinline__ const char* bbase(const Unit& u) const { const unsigned e = (unsigned)tile_e[tile0 + u.pm]; return (const char*)B + (e * (unsigned)D + (unsigned)u.pn * BM) * (unsigned)DFF; }
    __device__ __forceinline__ int arow(const Unit&, int) const { return 0; }
    __device__ __forceinline__ void epi(const AccT& acc, const Unit& u, int wr, int wc, int fr, int fq) const {
        const int slot0 = (tile0 + u.pm) * BM + wr * 64 + fr, c0 = u.pn * BM + wc * 32 + 8 * fq;
#pragma unroll
        for (int ai = 0; ai < 2; ++ai)
#pragma unroll
            for (int m = 0; m < 4; ++m) { const int slot = slot0 + ai * HALF + m * 16; const float g = gw[slot] * (1.0f / (F8_HID * F8_W)); bf16_t* rowp = Y + (size_t)slot * D + c0;
#pragma unroll
                for (int bj = 0; bj < 2; ++bj) { const f32x4 v0 = acc[ai][bj][m][0] * g, v1 = acc[ai][bj][m][1] * g;
                    u32x4 w; w.x = cvt_pk_bf16(v0[0], v0[1]); w.y = cvt_pk_bf16(v0[2], v0[3]); w.z = cvt_pk_bf16(v1[0], v1[1]); w.w = cvt_pk_bf16(v1[2], v1[3]);
                    *(u32x4*)(rowp + bj * HALF) = w; } }
    }
};

enum { RM_OFF = 0, RM_GU_G = 1, RM_GU_U = 2, RM_QKV = 3 };
template <int RM> __device__ __forceinline__ int rowmap(int n, int off) {
    if (RM == RM_GU_G) return (n >> 7) * 256 + (n & 127);
    if (RM == RM_GU_U) return (n >> 7) * 256 + 128 + (n & 127);
    if (RM == RM_QKV) { const int tile = n >> 8, f = n & 255, hh = f >> 6, d = f & 63, bj = d >> 5, q = d & 31; return tile * 256 + 128 * bj + 32 * hh + q; }
    return n + off;
}
template <int RM>
__device__ __forceinline__ void tconv(const float* __restrict__ src, int Ks, int ldn, int c0, int ncols, bf16_t* __restrict__ dst, int off, LAS unsigned char* lds, int start, int stride) {
    LAS bf16_t* T = (LAS bf16_t*)lds;
    const int tid = otid(), nkt = Ks >> 6, ntile = nkt * (ncols >> 6);
    for (int t = start; t < ntile; t += stride) {
        const int kt = t % nkt, ntl = t / nkt, k0 = kt * 64, n0 = ntl * 64;
        const int kk = tid >> 4, n4 = (tid & 15) * 4;
#pragma unroll
        for (int i = 0; i < 2; ++i) { const int k = kk + 32 * i;
            const f32x4 v = *(const f32x4*)(src + (size_t)(k0 + k) * ldn + c0 + n0 + n4);
#pragma unroll
            for (int j = 0; j < 4; ++j) T[(n4 + j) * 72 + k] = f2bf(v[j]); }
        __syncthreads();
        { const int n = tid >> 3, k8 = (tid & 7) * 8;
          const u32x4 w = *(const LAS u32x4*)(T + n * 72 + k8);
          *(u32x4*)(dst + (size_t)rowmap<RM>(n0 + n, off) * Ks + k0 + k8) = w; }
        __syncthreads();
    }
}

template <int RM>
__device__ __forceinline__ void tconv8(const float* __restrict__ src, int Ks, int ldn, int c0, int ncols, fp8_t* __restrict__ dst, int off, LAS unsigned char* lds, int start, int stride) {
    LAS fp8_t* T = (LAS fp8_t*)lds;
    const int tid = otid(), nkt = Ks >> 6, ntile = nkt * (ncols >> 6);
    for (int t = start; t < ntile; t += stride) {
        const int kt = t % nkt, ntl = t / nkt, k0 = kt * 64, n0 = ntl * 64;
        const int kk = tid >> 4, n4 = (tid & 15) * 4;
#pragma unroll
        for (int i = 0; i < 2; ++i) { const int k = kk + 32 * i;
            const f32x4 v = *(const f32x4*)(src + (size_t)(k0 + k) * ldn + c0 + n0 + n4);
            const unsigned w = pk4_fp8(v[0] * F8_W, v[1] * F8_W, v[2] * F8_W, v[3] * F8_W);
#pragma unroll
            for (int j = 0; j < 4; ++j) T[(n4 + j) * 80 + k] = (fp8_t)(w >> (8 * j)); }
        __syncthreads();
        if (tid < 256) { const int n = tid >> 2, k16 = (tid & 3) * 16;
          const u32x4 w = *(const LAS u32x4*)(T + n * 80 + k16);
          *(u32x4*)(dst + (size_t)rowmap<RM>(n0 + n, off) * Ks + k0 + k16) = w; }
        __syncthreads();
    }
}

__device__ __forceinline__ void fold_job(const float* __restrict__ w_in, bf16_t* __restrict__ WinT, LAS unsigned char* lds) {
    LAS float* W = (LAS float*)lds;
    LAS float* cs = W + 1024; LAS float* sn = cs + 128;
    const int tid = otid();
    if (tid < 128) { cs[tid] = cospif((float)tid / 64.0f); sn[tid] = sinpif((float)tid / 64.0f); }
    for (int it = blockIdx.x; it < 512; it += gridDim.x) {
        const int kb = it >> 2, g = it & 3;
        __syncthreads();
        { const int r = tid >> 6, c2 = (tid & 63) * 2; const f32x2 v = *(const f32x2*)(w_in + (size_t)(kb * 8 + r) * 2048 + g * 128 + c2); W[r * 128 + c2] = v.x; W[r * 128 + c2 + 1] = v.y; }
        __syncthreads();
        const int m = tid & 127, part = (tid >> 7) & 1, rh = tid >> 8;
        float a0 = 0.f, a1 = 0.f, a2 = 0.f, a3 = 0.f;
        for (int d = 0; d < 128; ++d) { const int idx = (m * d) & 127; const float tw = part ? sn[idx] : cs[idx];
            a0 += W[(rh * 4 + 0) * 128 + d] * tw; a1 += W[(rh * 4 + 1) * 128 + d] * tw; a2 += W[(rh * 4 + 2) * 128 + d] * tw; a3 += W[(rh * 4 + 3) * 128 + d] * tw; }
        u32x2 w; w.x = cvt_pk_bf16(a0, a1); w.y = cvt_pk_bf16(a2, a3);
        *(u32x2*)(WinT + (size_t)(2 * (g * 128 + m) + part) * D + kb * 8 + rh * 4) = w;
    }
    __syncthreads();
}

__device__ __forceinline__ void dft_job(bf16_t* __restrict__ DFTc, float* __restrict__ TW, LAS unsigned char* lds) {
    const int tid = otid();
    for (int idx = blockIdx.x * 512 + tid; idx < 256 * 512; idx += gridDim.x * 512) {
        const int k = idx >> 9, lp = idx & 511, kl = (k * (lp & 255)) & 255;
        const float v = lp < 256 ? cospif((float)kl / 128.0f) : -sinpif((float)kl / 128.0f);
        DFTc[idx] = f2bf(v);
    }
    for (int idx = blockIdx.x * 512 + tid; idx < 4096; idx += gridDim.x * 512) {
        const int l2 = idx >> 6, k1 = idx & 63; const float a = (float)(k1 * l2) / 2048.0f;
        TW[idx] = cospif(a); TW[4096 + idx] = sinpif(a);
    }
}

__device__ __forceinline__ void ada_job(const float* __restrict__ c, const float* __restrict__ c_ctx, const float* __restrict__ ada_w, const float* __restrict__ ada_b, float* __restrict__ MOD, LAS unsigned char* lds) {
    LAS float* sc = (LAS float*)lds;
    LAS float* red = sc + 17 * 1024;
    const int tid = otid();
    for (int i = tid; i < 17 * 1024; i += 512) { const float x = i < 16 * 1024 ? c[i] : c_ctx[i - 16 * 1024]; sc[i] = silu_f(x); }
    __syncthreads();
    for (int chunk = blockIdx.x; chunk < 256; chunk += gridDim.x) {
        const int layer = chunk >> 7, n0 = (chunk & 127) * 48;
        const float* wp = ada_w + (size_t)layer * D * NMOD + n0;
        const int col = tid % 48, kg = tid / 48;
        if (kg < 10) {
            float a[17];
#pragma unroll
            for (int r = 0; r < 17; ++r) a[r] = 0.f;
            for (int k = kg; k < D; k += 10) { const float w = wp[(size_t)k * NMOD + col];
#pragma unroll
                for (int r = 0; r < 17; ++r) a[r] += sc[r * 1024 + k] * w; }
#pragma unroll
            for (int r = 0; r < 17; ++r) red[(kg * 17 + r) * 48 + col] = a[r];
        }
        __syncthreads();
        for (int o = tid; o < 17 * 48; o += 512) { const int r = o / 48, cc = o % 48; float s = ada_b[layer * NMOD + n0 + cc];
#pragma unroll
            for (int g = 0; g < 10; ++g) s += red[(g * 17 + r) * 48 + cc];
            MOD[((size_t)layer * 17 + r) * NMOD + n0 + cc] = s; }
        __syncthreads();
    }
}

__device__ __forceinline__ void h3_job(const float* __restrict__ w0, const float* __restrict__ b0, const float* __restrict__ w1, const float* __restrict__ b1,
                                       const float* __restrict__ w2, const float* __restrict__ b2, const float* __restrict__ freq, float* __restrict__ H3) {
    const int tid = otid(), lane = tid & 63, wv = blockIdx.x * 8 + (tid >> 6), nw = gridDim.x * 8;
    const float fr = freq[lane];
    for (int p = wv; p < 4352; p += nw) {
        const int L = p < 4096 ? 4096 : 256, pos = p < 4096 ? p : p - 4096;
        const float t = (float)pos / (float)(L - 1);
        const float w = (float)(2.0 * 3.14159265358979323846 / (double)L) * (float)pos;
        const float band = 1e-4f + (float)(lane & 15) * ((15.0f - 1e-4f) / 15.0f);
        const float ang = w * band;
        const float cz = cosf(ang), sz = -sinf(ang);
        float a = t * w0[lane] + b0[lane];
#pragma unroll
        for (int b = 0; b < 16; ++b) a += __shfl(cz, b) * w0[(1 + b) * 64 + lane] + __shfl(sz, b) * w0[(17 + b) * 64 + lane];
        const float h1 = sinf(fr * a);
        float a2 = b1[lane];
#pragma unroll 8
        for (int i = 0; i < 64; ++i) a2 += __shfl(h1, i) * w1[i * 64 + lane];
        const float h2 = sinf(fr * a2);
        float a3 = b2[lane];
#pragma unroll 8
        for (int i = 0; i < 64; ++i) a3 += __shfl(h2, i) * w2[i * 64 + lane];
        H3[(size_t)p * 64 + lane] = sinf(fr * a3);
    }
}

template <int L>
__device__ __forceinline__ void filt_fin(const float* __restrict__ H3, const float* __restrict__ w3, float* __restrict__ KFo, int cp, LAS unsigned char* lds) {
    LAS float* F = (LAS float*)lds;
    LAS float* Bk = F + 2 * L;
    LAS float* w3c = Bk + 2 * L;
    LAS float* red = w3c + 256;
    const int tid = otid(), lane = tid & 63, wid = tid >> 6;
    const int c0 = cp * 2;
    __syncthreads();
    if (tid < 256) { const int which = tid & 3, j = tid >> 2; w3c[tid] = w3[(size_t)j * 1024 + (which >> 1) * 512 + c0 + (which & 1)]; }
    __syncthreads();
    const float la = -3.0701134573253945f, lb = -15.350567286626973f;
    float dl[2];
#pragma unroll
    for (int cc = 0; cc < 2; ++cc) dl[cc] = fabsf(la + (float)(c0 + cc) * ((lb - la) / 511.0f));
    float ss0 = 0.f, ss1 = 0.f;
    for (int pos = tid; pos < L; pos += 512) {
        const float* hp = H3 + (size_t)pos * 64;
        asm volatile("" ::: "memory");
        f32x4 sv = (f32x4){0.f, 0.f, 0.f, 0.f};
#pragma unroll 4
        for (int j4 = 0; j4 < 16; ++j4) { const f32x4 h = *(const f32x4*)(hp + j4 * 4);
#pragma unroll
            for (int e = 0; e < 4; ++e) sv += h[e] * *(const LAS f32x4*)(w3c + (j4 * 4 + e) * 4); }
        const float s[4] = {sv[0], sv[1], sv[2], sv[3]};
        const float t = (float)pos / (float)(L - 1);
        const float d0 = __expf(-t * dl[0]), d1 = __expf(-t * dl[1]);
        const float f0 = s[0] * d0, f1 = s[1] * d1, g0 = s[2] * d0, g1 = s[3] * d1;
        F[pos] = f0; F[L + pos] = f1; Bk[pos] = g0; Bk[L + pos] = g1;
        ss0 += f0 * f0 + (pos >= 1 ? g0 * g0 : 0.f); ss1 += f1 * f1 + (pos >= 1 ? g1 * g1 : 0.f);
    }
    ss0 = wave_sum(ss0); ss1 = wave_sum(ss1);
    if (lane == 0) { red[wid] = ss0; red[8 + wid] = ss1; }
    __syncthreads();
    float n0 = 0.f, n1 = 0.f;
#pragma unroll
    for (int i = 0; i < 8; ++i) { n0 += red[i]; n1 += red[8 + i]; }
    const float nr[2] = {rsqrtf(n0 + EPS), rsqrtf(n1 + EPS)};
    if constexpr (L == SEQ) {
        bf16_t* RC = (bf16_t*)KFo;
#pragma unroll
        for (int cc = 0; cc < 2; ++cc)
            for (int i2 = tid; i2 < 4 * 4096; i2 += 512) { const int m = i2 >> 12, idx = (i2 & 4095) * 2; float v[2];
#pragma unroll
                for (int e = 0; e < 2; ++e) { const int d = L + m - (idx + e);
                    v[e] = (d >= L || d <= -L) ? 0.f : (d >= 0 ? F[cc * L + d] : Bk[cc * L - d]) * nr[cc]; }
                *(unsigned*)(RC + ((size_t)(c0 + cc) * 4 + m) * 8192 + idx) = cvt_pk_bf16(v[0], v[1]); }
    } else {
#pragma unroll
        for (int cc = 0; cc < 2; ++cc)
            for (int idx = tid; idx < 2 * L; idx += 512) { const int d = idx - L;
                const float v = d >= 0 ? F[cc * L + d] : (d > -L ? Bk[cc * L - d] : 0.f);
                KFo[(size_t)(c0 + cc) * (2 * L) + idx] = v * nr[cc]; }
    }
    __syncthreads();
}

template <bool ROUTE, bool OUT8 = ROUTE>
__device__ __forceinline__ void norm_phase(const float* __restrict__ srcL, const float* __restrict__ srcC, int nrows, const float* __restrict__ g, const float* __restrict__ modl  ,
                                           int shift_idx, bf16_t* __restrict__ HX, const float* __restrict__ wrt, unsigned* __restrict__ route, int* __restrict__ hist, LAS unsigned char* lds) {
    const int tid = otid(), lane = tid & 63, wid = tid >> 6;
    LAS int* lh = (LAS int*)lds;
    if (ROUTE) { if (tid < 8) lh[tid] = 0; __syncthreads(); }
    f32x4 gv[4];
#pragma unroll
    for (int i = 0; i < 2; ++i) { gv[2 * i] = *(const f32x4*)(g + i * 512 + lane * 8); gv[2 * i + 1] = *(const f32x4*)(g + i * 512 + lane * 8 + 4); }
    const int rows_per_blk = ROUTE ? 256 : 0;
    const int nw = gridDim.x * 8;
    for (int it = 0;; ++it) {
        int r;
        if (ROUTE) { if (it >= 32) break; r = blockIdx.x * rows_per_blk + wid * 32 + it; if (r >= nrows) break; }
        else { r = blockIdx.x * 8 + wid + it * nw; if (r >= nrows) break; }
        const float* xp = r < NTOK ? srcL + (size_t)r * D : srcC + (size_t)(r - NTOK) * D;
        const float* mp = modl + (size_t)(r < NTOK ? (r >> 12) : 16) * NMOD + shift_idx * D;
        f32x4 x[4];
#pragma unroll
        for (int i = 0; i < 2; ++i) { x[2 * i] = *(const f32x4*)(xp + i * 512 + lane * 8); x[2 * i + 1] = *(const f32x4*)(xp + i * 512 + lane * 8 + 4); }
        float ss = 0.f;
#pragma unroll
        for (int i = 0; i < 4; ++i) ss += x[i][0] * x[i][0] + x[i][1] * x[i][1] + x[i][2] * x[i][2] + x[i][3] * x[i][3];
        ss = wave_sum(ss);
        const float rs = rsqrtf(ss * (1.0f / 1024.0f) + EPS);
        f32x4 h[4];
#pragma unroll
        for (int i = 0; i < 2; ++i)
#pragma unroll
            for (int q = 0; q < 2; ++q) { const int o = i * 512 + lane * 8 + q * 4;
                const f32x4 sh = *(const f32x4*)(mp + o), sc = *(const f32x4*)(mp + D + o);
                h[2 * i + q] = (x[2 * i + q] * rs * gv[2 * i + q]) * (1.0f + sc) + sh; }
        if constexpr (OUT8) {
#pragma unroll
            for (int i = 0; i < 2; ++i) { u32x2 w; w.x = pk4_fp8(h[2 * i][0] * F8_ACT, h[2 * i][1] * F8_ACT, h[2 * i][2] * F8_ACT, h[2 * i][3] * F8_ACT);
                w.y = pk4_fp8(h[2 * i + 1][0] * F8_ACT, h[2 * i + 1][1] * F8_ACT, h[2 * i + 1][2] * F8_ACT, h[2 * i + 1][3] * F8_ACT);
                *(u32x2*)((fp8_t*)HX + (size_t)r * D + i * 512 + lane * 8) = w; }
        } else {
#pragma unroll
        for (int i = 0; i < 2; ++i) { u32x4 w; w.x = cvt_pk_bf16(h[2 * i][0], h[2 * i][1]); w.y = cvt_pk_bf16(h[2 * i][2], h[2 * i][3]); w.z = cvt_pk_bf16(h[2 * i + 1][0], h[2 * i + 1][1]); w.w = cvt_pk_bf16(h[2 * i + 1][2], h[2 * i + 1][3]);
            *(u32x4*)(HX + (size_t)r * D + i * 512 + lane * 8) = w; }
        }
        if (ROUTE) {
            float lg[8];
#pragma unroll
            for (int e = 0; e < 8; ++e) lg[e] = 0.f;
#pragma unroll
            for (int i = 0; i < 2; ++i)
#pragma unroll
                for (int q = 0; q < 2; ++q)
#pragma unroll
                    for (int j = 0; j < 4; ++j) { const int k = i * 512 + lane * 8 + q * 4 + j; const float hv = h[2 * i + q][j];
                        const f32x4 wa = *(const f32x4*)(wrt + (size_t)k * 8), wb = *(const f32x4*)(wrt + (size_t)k * 8 + 4);
                        lg[0] += hv * wa[0]; lg[1] += hv * wa[1]; lg[2] += hv * wa[2]; lg[3] += hv * wa[3]; lg[4] += hv * wb[0]; lg[5] += hv * wb[1]; lg[6] += hv * wb[2]; lg[7] += hv * wb[3]; }
#pragma unroll
            for (int e = 0; e < 8; ++e) lg[e] = wave_sum(lg[e]);
            int e1 = 0; float v1 = lg[0];
#pragma unroll
            for (int e = 1; e < 8; ++e) if (lg[e] > v1) { v1 = lg[e]; e1 = e; }
            int e2 = -1; float v2 = -3.0e38f;
#pragma unroll
            for (int e = 0; e < 8; ++e) if (e != e1 && lg[e] > v2) { v2 = lg[e]; e2 = e; }
            const float g1 = 1.0f / (1.0f + __expf(v2 - v1)), g2 = 1.0f - g1;
            if (lane == 0) { u32x4 w; w.x = (unsigned)e1; w.y = (unsigned)e2; w.z = __float_as_uint(g1); w.w = __float_as_uint(g2); *(u32x4*)(route + (size_t)r * 4) = w;
                atomicAdd((int*)&lh[e1], 1); atomicAdd((int*)&lh[e2], 1); }
        }
    }
    if (ROUTE) { __syncthreads(); if (tid < 8) hist[blockIdx.x * 8 + tid] = lh[tid]; }
}

template <int L, int NBP>
__device__ __forceinline__ void hyena_pass(const bf16_t* __restrict__ UTb, bf16_t* __restrict__ HTb, int c, const float (&cw)[3][3], const float (&cb)[3], float bias,
                                           const LAS float* kf, LAS float* raw, LAS float* vx, LAS float* x0s) {
    const int tid = otid(), e0 = tid * 8, bb = e0 / L, t0 = e0 % L;
    constexpr int RS = L + 8;
#pragma unroll
    for (int j = 0; j < 3; ++j) {
        const u32x4 w = *(const u32x4*)(UTb + ((size_t)bb * UCH + 1024 + j * 512 + c) * L + t0);
        LAS float* rp = raw + (j * NBP + bb) * RS + 4 + t0;
        *(LAS f32x4*)rp = (f32x4){bflo(w.x), bfhi(w.x), bflo(w.y), bfhi(w.y)};
        *(LAS f32x4*)(rp + 4) = (f32x4){bflo(w.z), bfhi(w.z), bflo(w.w), bfhi(w.w)};
        if (t0 == 0) rp[-1] = 0.f;
        if (t0 == L - 8) rp[8] = 0.f;
    }
    __syncthreads();
    {
        float z[3][8];
#pragma unroll
        for (int j = 0; j < 3; ++j) { const LAS float* rp = raw + (j * NBP + bb) * RS + 4 + t0;
            float r[10];
#pragma unroll
            for (int i = 0; i < 10; ++i) r[i] = rp[i - 1];
#pragma unroll
            for (int i = 0; i < 8; ++i) z[j][i] = r[i] * cw[j][0] + r[i + 1] * cw[j][1] + r[i + 2] * cw[j][2] + cb[j]; }
#pragma unroll
        for (int i = 0; i < 8; ++i) { vx[bb * L + t0 + i] = z[0][i] * z[1][i]; x0s[bb * L + t0 + i] = z[2][i]; }
    }
    __syncthreads();
    float acc[8];
#pragma unroll
    for (int i = 0; i < 8; ++i) acc[i] = 0.f;
    for (int s0 = 0; s0 < L; s0 += 8) {
        const f32x4 va = *(const LAS f32x4*)(vx + bb * L + s0), vb = *(const LAS f32x4*)(vx + bb * L + s0 + 4);
        const float v[8] = {va[0], va[1], va[2], va[3], vb[0], vb[1], vb[2], vb[3]};
        const LAS float* kp = kf + (L + t0 - s0 - 8);
        float w[16];
#pragma unroll
        for (int q4 = 0; q4 < 4; ++q4) { const f32x4 t = *(const LAS f32x4*)(kp + q4 * 4); w[q4 * 4] = t[0]; w[q4 * 4 + 1] = t[1]; w[q4 * 4 + 2] = t[2]; w[q4 * 4 + 3] = t[3]; }
#pragma unroll
        for (int j = 0; j < 8; ++j)
#pragma unroll
            for (int i = 0; i < 8; ++i) acc[i] += w[8 + i - j] * v[j];
    }
    {
        float o[8];
#pragma unroll
        for (int i = 0; i < 8; ++i) o[i] = x0s[bb * L + t0 + i] * (acc[i] + bias * vx[bb * L + t0 + i]);
        u32x4 w; w.x = cvt_pk_bf16(o[0], o[1]); w.y = cvt_pk_bf16(o[2], o[3]); w.z = cvt_pk_bf16(o[4], o[5]); w.w = cvt_pk_bf16(o[6], o[7]);
        *(u32x4*)(HTb + ((size_t)bb * 512 + c) * L + t0) = w;
    }
    __syncthreads();
}

__device__ __forceinline__ unsigned f2_cs_byte(int r, int c) { return (unsigned)(r * 128 + ((((c >> 3) ^ ((r >> 1) & 7))) << 4) + (c & 7) * 2); }
__device__ __forceinline__ void f2_tr8(u32x2 (&o)[8], unsigned a0, unsigned a1, unsigned a2, unsigned a3, unsigned a4, unsigned a5, unsigned a6, unsigned a7) {
    asm volatile("ds_read_b64_tr_b16 %0, %8\n\tds_read_b64_tr_b16 %1, %9\n\tds_read_b64_tr_b16 %2, %10\n\tds_read_b64_tr_b16 %3, %11\n\t"
                 "ds_read_b64_tr_b16 %4, %12\n\tds_read_b64_tr_b16 %5, %13\n\tds_read_b64_tr_b16 %6, %14\n\tds_read_b64_tr_b16 %7, %15\n\ts_waitcnt lgkmcnt(0)"
                 : "=&v"(o[0]), "=&v"(o[1]), "=&v"(o[2]), "=&v"(o[3]), "=&v"(o[4]), "=&v"(o[5]), "=&v"(o[6]), "=&v"(o[7])
                 : "v"(a0), "v"(a1), "v"(a2), "v"(a3), "v"(a4), "v"(a5), "v"(a6), "v"(a7) : "memory");
}
__device__ __forceinline__ bf16x8 f2_frag(const u32x2& lo, const u32x2& hi) { return __builtin_bit_cast(bf16x8, (u32x4){lo.x, lo.y, hi.x, hi.y}); }
__device__ __forceinline__ bf16x8 f2_neg(const bf16x8& v) { u32x4 u = __builtin_bit_cast(u32x4, v); u.x ^= 0x80008000u; u.y ^= 0x80008000u; u.z ^= 0x80008000u; u.w ^= 0x80008000u; return __builtin_bit_cast(bf16x8, u); }

__device__ __forceinline__ void fourier2_phase(const bf16_t* __restrict__ UT, bf16_t* __restrict__ AT, const float* __restrict__ TW, LAS unsigned char* lds) {
    const int tid = otid(), lane = tid & 63, w = __builtin_amdgcn_readfirstlane(tid >> 6), r = lane & 31, h = lane >> 5;
    __syncthreads();
    for (int i = tid; i < 4096; i += 512) { const int rr = i >> 6, cc = i & 63; const float a = (float)((rr * cc) & 63) / 32.0f;
        *(LAS bf16_t*)(lds + f2_cs_byte(rr, cc)) = f2bf(cospif(a)); *(LAS bf16_t*)(lds + 8192 + f2_cs_byte(rr, cc)) = f2bf(sinpif(a)); }
    __syncthreads();
    LAS unsigned char* xr = lds + 16384 + w * 16384;
    const unsigned xb = (unsigned)(unsigned long)xr;
    const int q = (lane & 15) >> 2, pp = lane & 3, blk = (lane >> 4) & 1, qb = (q >> 1) & 1;
    const unsigned L0 = (unsigned)((8 * h + q) * 128 + (16 * blk + 4 * pp) * 2);
    const unsigned tb0 = xb + L0 + qb * 64, tb1 = xb + L0 + (1 - qb) * 64;
    const int nwv = gridDim.x * 8;
    for (int it = blockIdx.x * 8 + w; it < NB * 512; it += nwv) {
        const int b = it >> 9, m = it & 511;
        { const char* src = (const char*)(UT + ((size_t)b * UCH + 2 * m) * SEQ);
#pragma unroll
          for (int i = 0; i < 16; ++i) { const int row = (i & 7) * 8 + (lane >> 3), s2 = (lane & 7) ^ (4 * ((row >> 1) & 1));
              __builtin_amdgcn_global_load_lds((const unsigned*)(src + (i >> 3) * 8192 + (row * 64 + s2 * 8) * 2), (LAS unsigned*)(xr + i * 1024), 16, 0, 0); } }
        asm volatile("s_waitcnt vmcnt(0)" ::: "memory");
        f32x16 Yr[2][2], Yi[2][2];
#pragma unroll
        for (int a = 0; a < 2; ++a)
#pragma unroll
            for (int c = 0; c < 2; ++c)
#pragma unroll
                for (int e = 0; e < 16; ++e) { Yr[a][c][e] = 0.f; Yi[a][c][e] = 0.f; }
#pragma unroll
        for (int ks = 0; ks < 4; ++ks) {
            bf16x8 Cf[2], Sf[2];
#pragma unroll
            for (int kt = 0; kt < 2; ++kt) { const unsigned o = f2_cs_byte(32 * kt + r, 16 * ks + 8 * h); Cf[kt] = *(const LAS bf16x8*)(lds + o); Sf[kt] = *(const LAS bf16x8*)(lds + 8192 + o); }
            u32x2 t[8]; const unsigned ko = ks * 2048;
            f2_tr8(t, tb0 + ko, tb0 + ko + 512, tb1 + ko, tb1 + ko + 512, tb0 + ko + 8192, tb0 + ko + 8192 + 512, tb1 + ko + 8192, tb1 + ko + 8192 + 512);
            const bf16x8 Pf[2] = {f2_frag(t[0], t[1]), f2_frag(t[2], t[3])}, Qf[2] = {f2_frag(t[4], t[5]), f2_frag(t[6], t[7])};
            const bf16x8 Qn[2] = {f2_neg(Qf[0]), f2_neg(Qf[1])};
#pragma unroll
            for (int kt = 0; kt < 2; ++kt)
#pragma unroll
                for (int nt = 0; nt < 2; ++nt) {
                    Yr[kt][nt] = __builtin_amdgcn_mfma_f32_32x32x16_bf16(Cf[kt], Pf[nt], Yr[kt][nt], 0, 0, 0);
                    Yr[kt][nt] = __builtin_amdgcn_mfma_f32_32x32x16_bf16(Sf[kt], Qn[nt], Yr[kt][nt], 0, 0, 0);
                    Yi[kt][nt] = __builtin_amdgcn_mfma_f32_32x32x16_bf16(Sf[kt], Pf[nt], Yi[kt][nt], 0, 0, 0);
                    Yi[kt][nt] = __builtin_amdgcn_mfma_f32_32x32x16_bf16(Cf[kt], Qf[nt], Yi[kt][nt], 0, 0, 0);
                }
        }
#pragma unroll
        for (int nt = 0; nt < 2; ++nt) { const int l2 = 32 * nt + r;
#pragma unroll
            for (int kt = 0; kt < 2; ++kt)
#pragma unroll
                for (int eg = 0; eg < 4; ++eg) { const int k1 = 32 * kt + 8 * eg + 4 * h;
                    const f32x4 tc = *(const f32x4*)(TW + l2 * 64 + k1), ts = *(const f32x4*)(TW + 4096 + l2 * 64 + k1);
                    float yr[4], yi[4];
#pragma unroll
                    for (int j = 0; j < 4; ++j) { const float a = Yr[kt][nt][4 * eg + j], bneg = Yi[kt][nt][4 * eg + j];
                        yr[j] = a * tc[j] - bneg * ts[j]; yi[j] = -(a * ts[j] + bneg * tc[j]); }
                    const unsigned o = (unsigned)(l2 * 128 + ((kt ^ ((l2 >> 1) & 1)) * 64) + (8 * eg + 4 * h) * 2);
                    u32x2 wr_; wr_.x = cvt_pk_bf16(yr[0], yr[1]); wr_.y = cvt_pk_bf16(yr[2], yr[3]); *(LAS u32x2*)(xr + o) = wr_;
                    u32x2 wi_; wi_.x = cvt_pk_bf16(yi[0], yi[1]); wi_.y = cvt_pk_bf16(yi[2], yi[3]); *(LAS u32x2*)(xr + 8192 + o) = wi_; } }
        asm volatile("s_waitcnt lgkmcnt(0)" ::: "memory");
        f32x16 O[2][2];
#pragma unroll
        for (int a = 0; a < 2; ++a)
#pragma unroll
            for (int c = 0; c < 2; ++c)
#pragma unroll
                for (int e = 0; e < 16; ++e) O[a][c][e] = 0.f;
#pragma unroll
        for (int ks = 0; ks < 4; ++ks) {
            bf16x8 Cf[2], Sf[2];
#pragma unroll
            for (int kt = 0; kt < 2; ++kt) { const unsigned o = f2_cs_byte(32 * kt + r, 16 * ks + 8 * h); Cf[kt] = *(const LAS bf16x8*)(lds + o); Sf[kt] = *(const LAS bf16x8*)(lds + 8192 + o); }
            u32x2 t[8]; const unsigned ko = ks * 2048;
            f2_tr8(t, tb0 + ko, tb0 + ko + 512, tb1 + ko, tb1 + ko + 512, tb0 + ko + 8192, tb0 + ko + 8192 + 512, tb1 + ko + 8192, tb1 + ko + 8192 + 512);
            const bf16x8 Rf[2] = {f2_frag(t[0], t[1]), f2_frag(t[2], t[3])}, If[2] = {f2_frag(t[4], t[5]), f2_frag(t[6], t[7])};
#pragma unroll
            for (int kt = 0; kt < 2; ++kt)
#pragma unroll
                for (int nt = 0; nt < 2; ++nt) {
                    O[kt][nt] = __builtin_amdgcn_mfma_f32_32x32x16_bf16(Cf[kt], Rf[nt], O[kt][nt], 0, 0, 0);
                    O[kt][nt] = __builtin_amdgcn_mfma_f32_32x32x16_bf16(Sf[kt], If[nt], O[kt][nt], 0, 0, 0);
                }
        }
        { bf16_t* dst = AT + ((size_t)b * 512 + m) * SEQ;
          const float sc = 0.001381067932004974f;
#pragma unroll
          for (int kt = 0; kt < 2; ++kt)
#pragma unroll
              for (int nt = 0; nt < 2; ++nt)
#pragma unroll
                  for (int e = 0; e < 16; ++e) { const int k2 = 32 * kt + (e & 3) + 8 * (e >> 2) + 4 * h, k1 = 32 * nt + r;
                      dst[64 * k2 + k1] = f2bf(O[kt][nt][e] * sc); } }
    }
    __syncthreads();
}

__device__ __forceinline__ void hyena_prep_phase(const bf16_t* __restrict__ UT, const bf16_t* __restrict__ UTc, bf16_t* __restrict__ VXF, unsigned* __restrict__ GT, bf16_t* __restrict__ HTc,
                                                 const float* __restrict__ KFc, const float* __restrict__ conv_w, const float* __restrict__ conv_b, const float* __restrict__ hbias,
                                                 LAS unsigned char* lds) {
    LAS float* kf = (LAS float*)lds;
    LAS float* raw = kf + 8192;
    LAS float* vx = raw + 3 * 4224;
    LAS float* x0s = vx + 4096;
    const int tid = otid();
    for (int cp = blockIdx.x; cp < 256; cp += gridDim.x)
        for (int cc = 0; cc < 2; ++cc) {
            const int c = cp * 2 + cc;
            float cw[3][3], cb[3];
#pragma unroll
            for (int j = 0; j < 3; ++j) { cb[j] = conv_b[j * 512 + c];
#pragma unroll
                for (int tp = 0; tp < 3; ++tp) cw[j][tp] = conv_w[tp * 1536 + j * 512 + c]; }
            const float bias = hbias[c];
            for (int b = 0; b < NB; ++b) {
                const bf16_t* UTb = UT + (size_t)b * UCH * SEQ;
                const int t0 = tid * 8;
                __syncthreads();
#pragma unroll
                for (int j = 0; j < 3; ++j) {
                    const u32x4 w = *(const u32x4*)(UTb + ((size_t)1024 + j * 512 + c) * SEQ + t0);
                    LAS float* rp = raw + j * (SEQ + 8) + 4 + t0;
                    *(LAS f32x4*)rp = (f32x4){bflo(w.x), bfhi(w.x), bflo(w.y), bfhi(w.y)};
                    *(LAS f32x4*)(rp + 4) = (f32x4){bflo(w.z), bfhi(w.z), bflo(w.w), bfhi(w.w)};
                    if (t0 == 0) rp[-1] = 0.f;
                    if (t0 == SEQ - 8) rp[8] = 0.f;
                }
                __syncthreads();
                float z[3][8];
#pragma unroll
                for (int j = 0; j < 3; ++j) { const LAS float* rp = raw + j * (SEQ + 8) + 4 + t0;
                    float r[10];
#pragma unroll
                    for (int i = 0; i < 10; ++i) r[i] = rp[i - 1];
#pragma unroll
                    for (int i = 0; i < 8; ++i) z[j][i] = r[i] * cw[j][0] + r[i + 1] * cw[j][1] + r[i + 2] * cw[j][2] + cb[j]; }
                float pv[8];
#pragma unroll
                for (int i = 0; i < 8; ++i) pv[i] = z[0][i] * z[1][i];
                u32x4 v8; v8.x = cvt_pk_bf16(pv[0], pv[1]); v8.y = cvt_pk_bf16(pv[2], pv[3]); v8.z = cvt_pk_bf16(pv[4], pv[5]); v8.w = cvt_pk_bf16(pv[6], pv[7]);
                { unsigned g[8];
#pragma unroll
                  for (int i = 0; i < 8; ++i) g[i] = cvt_pk_bf16(z[2][i], pv[i]);
                  u32x4* gp = (u32x4*)(GT + ((size_t)b * 512 + c) * SEQ + t0);
                  gp[0] = (u32x4){g[0], g[1], g[2], g[3]}; gp[1] = (u32x4){g[4], g[5], g[6], g[7]}; }
                { bf16_t* img = VXF + (size_t)c * 272 * 512;
                  const int h = tid & 1, sth = tid >> 1;
                  *(u32x4*)(img + ((size_t)(sth + 16) * 64 + b + 32 * h) * 8) = v8;
                  *(u32x4*)(img + ((size_t)sth * 64 + b + 16 + 32 * h) * 8) = v8;
                  if (tid < 32) { const u32x4 zz = (u32x4){0u, 0u, 0u, 0u};
                      *(u32x4*)(img + ((size_t)sth * 64 + b + 32 * h) * 8) = zz;
                      *(u32x4*)(img + ((size_t)(256 + sth) * 64 + b + 16 + 32 * h) * 8) = zz; }
                }
            }
            __syncthreads();
            if (tid < 128) *(LAS f32x4*)(kf + tid * 4) = *(const f32x4*)(KFc + (size_t)c * 512 + tid * 4);
            __syncthreads();
            hyena_pass<LCTX, 16>(UTc, HTc, c, cw, cb, bias, kf, raw, vx, x0s);
        }
}

__device__ __forceinline__ void toep_phase(const bf16_t* __restrict__ RC, const bf16_t* __restrict__ VXF, const unsigned* __restrict__ GT, const float* __restrict__ hbias, bf16_t* __restrict__ HT,
                                           LAS unsigned char* lds) {
    int tid_ = threadIdx.x; asm volatile("" : "+v"(tid_));
    const int tid = tid_, lane = tid & 63, w = __builtin_amdgcn_readfirstlane(tid >> 6), r = lane & 31, h = lane >> 5;
    constexpr int RING = 65536, NST = 272;
    const int cbase = (4096 - 512 * w + 8 * (h - r) - 256) * 2;
    for (int cp = blockIdx.x; cp < 256; cp += gridDim.x)
        for (int cc = 0; cc < 2; ++cc) {
            const int c = cp * 2 + cc;
            const char* rc = (const char*)(RC + (size_t)c * 4 * 8192);
            const char* img = (const char*)(VXF + (size_t)c * NST * 512);
            __syncthreads();
#pragma unroll
            for (int i = 0; i < 8; ++i)
                __builtin_amdgcn_global_load_lds((const unsigned*)(rc + (w * 8 + i) * 1024 + lane * 16), (LAS unsigned*)(lds + (w * 8 + i) * 1024), 16, 0, 0);
            __builtin_amdgcn_global_load_lds((const unsigned*)(img + (size_t)w * 1024 + lane * 16), (LAS unsigned*)(lds + RING + w * 1024), 16, 0, 0);
            __builtin_amdgcn_global_load_lds((const unsigned*)(img + (size_t)(8 + w) * 1024 + lane * 16), (LAS unsigned*)(lds + RING + (8 + w) * 1024), 16, 0, 0);
            f32x16 acc[8];
#pragma unroll
            for (int j = 0; j < 8; ++j)
#pragma unroll
                for (int e = 0; e < 16; ++e) acc[j][e] = 0.f;
            for (int k = 0; k < NST / 8; ++k) {
                { int stn = 8 * (k + 2) + w; stn = stn < NST ? stn : NST - 1;
                  __builtin_amdgcn_global_load_lds((const unsigned*)(img + (size_t)stn * 1024 + lane * 16), (LAS unsigned*)(lds + RING + ((8 * (k + 2) + w) & 31) * 1024), 16, 0, 0); }
                asm volatile("s_waitcnt vmcnt(2)" ::: "memory");
                __builtin_amdgcn_s_barrier();
                asm volatile("" ::: "memory");
                const LAS unsigned char* ab = lds + cbase + 256 * k;
#pragma unroll
                for (int i = 0; i < 8; ++i) {
                    const bf16x8 bf = *(const LAS bf16x8*)(lds + RING + ((8 * k + i) & 31) * 1024 + lane * 16);
#pragma unroll
                    for (int m = 0; m < 4; ++m) {
                        const u32x4 w0 = *(const LAS u32x4*)(ab + m * 16384 + 32 * i - 16), w1 = *(const LAS u32x4*)(ab + m * 16384 + 32 * i);
                        const u32x4 mid = (u32x4){w0.z, w0.w, w1.x, w1.y};
                        acc[m] = __builtin_amdgcn_mfma_f32_32x32x16_bf16(__builtin_bit_cast(bf16x8, w1), bf, acc[m], 0, 0, 0);
                        acc[4 + m] = __builtin_amdgcn_mfma_f32_32x32x16_bf16(__builtin_bit_cast(bf16x8, mid), bf, acc[4 + m], 0, 0, 0);
                    }
                }
            }
            asm volatile("s_waitcnt vmcnt(0)" ::: "memory");
            __builtin_amdgcn_s_barrier();
            asm volatile("" ::: "memory");
            LAS unsigned char* wt = lds + w * 16640;
            { const int col = lane & 31, b = col & 15, a = col >> 4;
#pragma unroll
              for (int u = 0; u < 2; ++u)
#pragma unroll
                  for (int mp = 0; mp < 2; ++mp)
#pragma unroll
                      for (int e = 0; e < 16; ++e) { const int row = (e & 3) + 8 * (e >> 2) + 4 * h, tl = 4 * u + 2 * mp + 8 * row + 256 * a;
                          *(LAS unsigned*)(wt + (b * 520 + tl) * 2) = cvt_pk_bf16(acc[4 * u + 2 * mp][e], acc[4 * u + 2 * mp + 1][e]); } }
            asm volatile("s_waitcnt lgkmcnt(0)" ::: "memory");
            const float bias = hbias[c];
#pragma unroll 4
            for (int b = 0; b < 16; ++b) {
                const u32x4 y8 = *(const LAS u32x4*)(wt + (b * 520 + 8 * lane) * 2);
                const size_t go = ((size_t)b * 512 + c) * SEQ + 512 * w + 8 * lane;
                const u32x4 g0 = *(const u32x4*)(GT + go), g1 = *(const u32x4*)(GT + go + 4);
                const unsigned gg[8] = {g0.x, g0.y, g0.z, g0.w, g1.x, g1.y, g1.z, g1.w};
                const float yy[8] = {bflo(y8.x), bfhi(y8.x), bflo(y8.y), bfhi(y8.y), bflo(y8.z), bfhi(y8.z), bflo(y8.w), bfhi(y8.w)};
                float o[8];
#pragma unroll
                for (int i = 0; i < 8; ++i) o[i] = bflo(gg[i]) * (yy[i] + bias * bfhi(gg[i]));
                u32x4 ww; ww.x = cvt_pk_bf16(o[0], o[1]); ww.y = cvt_pk_bf16(o[2], o[3]); ww.z = cvt_pk_bf16(o[4], o[5]); ww.w = cvt_pk_bf16(o[6], o[7]);
                *(u32x4*)(HT + go) = ww;
            }
        }
    __syncthreads();
}

__device__ __forceinline__ void mix_transpose_phase(const bf16_t* __restrict__ AT, const bf16_t* __restrict__ HT, const bf16_t* __restrict__ HTc, bf16_t* __restrict__ MIX, LAS unsigned char* lds) {
    LAS bf16_t* T = (LAS bf16_t*)lds;
    const int tid = otid();
    for (int t = blockIdx.x; t < 16896; t += gridDim.x) {
        const bf16_t* src; int sld, row0, cb, coff;
        if (t < 16384) { const int t1 = t & 8191, b = t1 >> 9, tb = t1 & 63; cb = (t1 >> 6) & 7; src = (t < 8192 ? AT : HT) + ((size_t)(b * 512 + cb * 64)) * SEQ + tb * 64; sld = SEQ; row0 = b * SEQ + tb * 64; coff = t < 8192 ? 0 : 512; }
        else { const int t2 = t - 16384, b = t2 >> 5, tb = t2 & 3; cb = (t2 >> 2) & 7; src = HTc + ((size_t)(b * 512 + cb * 64)) * LCTX + tb * 64; sld = LCTX; row0 = NTOK + b * LCTX + tb * 64; coff = 512; }
        { const int r = tid >> 3, p = tid & 7; *(LAS u32x4*)(T + r * 72 + p * 8) = *(const u32x4*)(src + (size_t)r * sld + p * 8); }
        __syncthreads();
        { const int tt = tid >> 3, c8 = (tid & 7) * 8; unsigned w[4];
#pragma unroll
          for (int j = 0; j < 4; ++j) w[j] = (unsigned)T[(c8 + 2 * j) * 72 + tt] | ((unsigned)T[(c8 + 2 * j + 1) * 72 + tt] << 16);
          *(u32x4*)(MIX + (size_t)(row0 + tt) * D + coff + cb * 64 + c8) = (u32x4){w[0], w[1], w[2], w[3]}; }
        __syncthreads();
    }
}

__device__ __forceinline__ void attn_issue(LAS unsigned char* lds, int gc, const bf16_t* __restrict__ Kb, const bf16_t* __restrict__ VT, int item, int ci, int w, int lane) {
    LAS unsigned char* sl = lds + (gc & 3) * 32768;
    const int b = item >> 7, hkv = (item >> 5) & 3, qb = item & 31;
    const bool win = ci < 3;
    int kp0 = qb * 128 - 128 + 128 * ci; kp0 = kp0 < 0 ? 0 : (kp0 > SEQ - 128 ? SEQ - 128 : kp0);
    const char* kub = (const char*)Kb + ((size_t)(win ? b * SEQ + kp0 : NTOK + b * LCTX + 128 * (ci - 3)) * 256 + hkv * 64) * 2;
    const char* vub = (const char*)VT + (win ? ((size_t)(b * 256 + hkv * 64) * SEQ + kp0) * 2 : ((size_t)NB * 256 * SEQ + (size_t)(b * 256 + hkv * 64) * LCTX + 128 * (ci - 3)) * 2);
    const unsigned vrow = win ? SEQ * 2u : LCTX * 2u;
#pragma unroll
    for (int i = 0; i < 2; ++i) { const int q = 2 * w + i, key = 8 * q + (lane >> 3), ds = (lane & 7) ^ ((key >> 1) & 7);
        const unsigned lo = (unsigned)(key * 256 + ds * 8) * 2u;
        __builtin_amdgcn_global_load_lds((const unsigned*)(kub + lo), (LAS unsigned*)(sl + q * 1024), 16, 0, 0); }
#pragma unroll
    for (int i = 0; i < 2; ++i) { const int q = 2 * w + i, d = 4 * q + (lane >> 4), ss = (lane & 15) ^ (d & 15);
        const unsigned lo = (unsigned)d * vrow + (unsigned)ss * 16u;
        __builtin_amdgcn_global_load_lds((const unsigned*)(vub + lo), (LAS unsigned*)(sl + 16384 + q * 1024), 16, 0, 0); }
}

__device__ __forceinline__ void attn_chunk(const bool WIN, const int ktlo, const int kthi, const LAS unsigned char* sl, const bf16x8 (&Qf)[2][4], f32x16 (&O)[2][2], float (&mrun)[2], float (&lrun)[2], int kpc, int q0w, int lane) {
    const int r = lane & 31, h = lane >> 5;
#pragma unroll 1
    for (int kt = ktlo; kt < kthi; ++kt) {
        const int kp0 = kpc + 32 * kt;
        bf16x8 P[2][2];
#pragma unroll
        for (int qt = 0; qt < 2; ++qt) {
            bf16x8 kf[4];
            { const int key = 32 * kt + r, sw = (key >> 1) & 7;
#pragma unroll
              for (int ks = 0; ks < 4; ++ks) kf[ks] = *(const LAS bf16x8*)(sl + key * 128 + (((2 * ks + h) ^ sw) << 4)); }
            f32x16 S;
#pragma unroll
            for (int e = 0; e < 16; ++e) S[e] = 0.f;
#pragma unroll
            for (int ks = 0; ks < 4; ++ks) S = __builtin_amdgcn_mfma_f32_32x32x16_bf16(kf[ks], Qf[qt][ks], S, 0, 0, 0);
            { const int qp = q0w + 32 * qt + r;
#pragma unroll
                for (int e = 0; e < 16; ++e) { const int kp = kp0 + (e & 3) + 8 * (e >> 2) + 4 * h; const bool ok = !WIN || (unsigned)(qp - kp + 128) <= 256u;
                    S[e] = ok ? S[e] : -1.0e30f; } }
            float mx = S[0];
#pragma unroll
            for (int e = 1; e < 16; ++e) mx = fmaxf(mx, S[e]);
            mx = fmaxf(mx, __shfl_xor(mx, 32));
            const float mn = fmaxf(mrun[qt], mx), alpha = __builtin_amdgcn_exp2f(mrun[qt] - mn);
            mrun[qt] = mn;
            float ps = 0.f;
#pragma unroll
            for (int e = 0; e < 16; ++e) { S[e] = __builtin_amdgcn_exp2f(S[e] - mn); ps += S[e]; }
            lrun[qt] = lrun[qt] * alpha + ps;
#pragma unroll
            for (int dt = 0; dt < 2; ++dt)
#pragma unroll
                for (int e = 0; e < 16; ++e) O[dt][qt][e] *= alpha;
#pragma unroll
            for (int s2 = 0; s2 < 2; ++s2) { u32x4 pk;
                pk.x = cvt_pk_bf16(S[8 * s2 + 0], S[8 * s2 + 1]); pk.y = cvt_pk_bf16(S[8 * s2 + 2], S[8 * s2 + 3]);
                pk.z = cvt_pk_bf16(S[8 * s2 + 4], S[8 * s2 + 5]); pk.w = cvt_pk_bf16(S[8 * s2 + 6], S[8 * s2 + 7]);
                P[qt][s2] = __builtin_bit_cast(bf16x8, pk); }
            asm volatile("" ::: "memory");
        }
#pragma unroll
        for (int dt = 0; dt < 2; ++dt)
#pragma unroll
            for (int s2 = 0; s2 < 2; ++s2) { const int d = 32 * dt + r;
                const bf16x8 vf = *(const LAS bf16x8*)(sl + 16384 + d * 256 + (((4 * kt + 2 * s2 + h) ^ (d & 15)) << 4));
#pragma unroll
                for (int qt = 0; qt < 2; ++qt) O[dt][qt] = __builtin_amdgcn_mfma_f32_32x32x16_bf16(vf, P[qt][s2], O[dt][qt], 0, 0, 0); }
    }
}

__device__ __forceinline__ void attn_phase(const bf16_t* __restrict__ Q, const bf16_t* __restrict__ Kb, const bf16_t* __restrict__ VT, bf16_t* __restrict__ AO, const float* __restrict__ sink, LAS unsigned char* lds) {
    int tid_ = threadIdx.x; asm volatile("" : "+v"(tid_));
    const int tid = tid_, lane = tid & 63, w = __builtin_amdgcn_readfirstlane(tid >> 6), r = lane & 31, h = lane >> 5;
    const int G = gridDim.x;
    int nitems = 0; for (int it = blockIdx.x; it < 2048; it += G) ++nitems;
    const int nch = nitems * 5;
    __syncthreads();
    if (nch > 0) { attn_issue(lds, 0, Kb, VT, blockIdx.x, 0, w, lane); attn_issue(lds, 1, Kb, VT, blockIdx.x, 1, w, lane); }
    int gc = 0;
    for (int item = blockIdx.x; item < 2048; item += G) {
        const int b = item >> 7, hkv = (item >> 5) & 3, qb = item & 31, head = hkv * 4 + (w >> 1), q0w = qb * 128 + (w & 1) * 64;
        bf16x8 Qf[2][4];
#pragma unroll
        for (int qt = 0; qt < 2; ++qt)
#pragma unroll
            for (int ks = 0; ks < 4; ++ks) Qf[qt][ks] = *(const bf16x8*)((const char*)Q + ((size_t)(b * SEQ + q0w) * D + head * 64) * 2 + (unsigned)((32 * qt + r) * D + 16 * ks + 8 * h) * 2u);
        f32x16 O[2][2];
#pragma unroll
        for (int dt = 0; dt < 2; ++dt)
#pragma unroll
            for (int qt = 0; qt < 2; ++qt)
#pragma unroll
                for (int e = 0; e < 16; ++e) O[dt][qt][e] = 0.f;
        const float sk = sink[head] * 1.4426950408889634f;
        float mrun[2] = {sk, sk}, lrun[2] = {h == 0 ? 1.0f : 0.0f, h == 0 ? 1.0f : 0.0f};
#pragma unroll 1
        for (int ci = 0; ci < 5; ++ci, ++gc) {
            { int g2 = gc + 2, it2 = item, c2 = ci + 2;
              if (c2 >= 5) { c2 -= 5; it2 += G; }
              if (g2 >= nch) { it2 = item; c2 = 0; }
              attn_issue(lds, g2, Kb, VT, it2, c2, w, lane); }
            asm volatile("s_waitcnt vmcnt(8)" ::: "memory");
            __builtin_amdgcn_s_barrier();
            asm volatile("" ::: "memory");
            const LAS unsigned char* sl = lds + (gc & 3) * 32768;
            { const bool win = ci < 3; const int kpc = qb * 128 - 128 + 128 * ci;
              int ktlo = 0, kthi = 4;
              if (win) { ktlo = (q0w - 128 - kpc) >> 5; ktlo = ktlo < 0 ? 0 : ktlo; kthi = ((q0w + 191 - kpc) >> 5) + 1; kthi = kthi > 4 ? 4 : kthi; if (kpc < 0 || kpc >= SEQ) kthi = 0; }
              attn_chunk(win, ktlo, kthi, sl, Qf, O, mrun, lrun, kpc, q0w, lane); }
        }
#pragma unroll
        for (int qt = 0; qt < 2; ++qt) {
            const float lt = lrun[qt] + __shfl_xor(lrun[qt], 32), inv = __builtin_amdgcn_rcpf(lt);
            bf16_t* op = (bf16_t*)((char*)AO + ((size_t)(b * SEQ + q0w) * D + head * 64) * 2 + (unsigned)((32 * qt + r) * D + 4 * h) * 2u);
#pragma unroll
            for (int dt = 0; dt < 2; ++dt)
#pragma unroll
                for (int eg = 0; eg < 4; ++eg) { u32x2 wv; wv.x = cvt_pk_bf16(O[dt][qt][4 * eg] * inv, O[dt][qt][4 * eg + 1] * inv); wv.y = cvt_pk_bf16(O[dt][qt][4 * eg + 2] * inv, O[dt][qt][4 * eg + 3] * inv);
                    *(u32x2*)(op + 32 * dt + 8 * eg) = wv; }
        }
    }
    asm volatile("s_waitcnt vmcnt(0)" ::: "memory");
    __syncthreads();
}

__device__ __forceinline__ void slots_phase(const unsigned* __restrict__ route, const int* __restrict__ hist, int* __restrict__ tok, float* __restrict__ gw, int* __restrict__ slotof, int* __restrict__ tile_e, LAS unsigned char* lds) {
    LAS int* hl = (LAS int*)lds;
    LAS int* cnt = hl + 2048;
    LAS int* base = cnt + 8;
    LAS int* pst = base + 8;
    LAS int* wcnt = pst + 16;
    const int tid = otid(), lane = tid & 63, wid = tid >> 6;
    __syncthreads();
    if (tid < 256) { const u32x4 a = *(const u32x4*)(hist + tid * 8), b = *(const u32x4*)(hist + tid * 8 + 4);
        *(LAS u32x4*)(hl + tid * 8) = a; *(LAS u32x4*)(hl + tid * 8 + 4) = b; }
    __syncthreads();
    if (tid < 8) { int tot = 0, bs = 0; for (int k = 0; k < 256; ++k) { const int h = hl[k * 8 + tid]; if (k < (int)blockIdx.x) bs += h; tot += h; } cnt[tid] = tot; base[tid] = bs; }
    __syncthreads();
    if (tid == 0) { int p = 0; for (int e = 0; e < 8; ++e) { pst[e] = p; p += (cnt[e] + 255) & ~255; } pst[8] = p; }
    __syncthreads();
    const int token = blockIdx.x * 256 + (tid >> 1), k = tid & 1;
    const int mye = (int)route[(size_t)token * 4 + k]; const float myg = __uint_as_float(route[(size_t)token * 4 + 2 + k]);
    int rk = 0;
#pragma unroll
    for (int e = 0; e < 8; ++e) { const unsigned long long mask = __ballot(mye == e);
        if (lane == 0) wcnt[e * 8 + wid] = __popcll(mask);
        if (mye == e) rk = __popcll(mask & ((1ull << lane) - 1ull)); }
    __syncthreads();
    int pre = 0;
    for (int w = 0; w < wid; ++w) pre += wcnt[mye * 8 + w];
    const int slot = pst[mye] + base[mye] + pre + rk;
    tok[slot] = token; gw[slot] = myg; slotof[token * 2 + k] = slot;
    if (blockIdx.x == 0) {
        for (int e = 0; e < 8; ++e) for (int s = pst[e] + cnt[e] + tid; s < pst[e + 1]; s += 512) { tok[s] = 0; gw[s] = 0.f; }
        for (int t = tid; t < MAXTILES; t += 512) { int e = 0;
#pragma unroll
            for (int q = 1; q < 8; ++q) if (t * 256 >= pst[q]) e = q;
            tile_e[t] = e; }
        if (tid == 0) tile_e[1023] = pst[8] >> 8;
    }
}

__device__ __forceinline__ void combine_phase(float* __restrict__ out, const bf16_t* __restrict__ Y, const int* __restrict__ slotof, const float* __restrict__ gate  ) {
    const int tid = otid(), lane = tid & 63, wid = tid >> 6, nw = gridDim.x * 8;
    for (int t = blockIdx.x * 8 + wid; t < NTOK; t += nw) {
        const int s1 = slotof[t * 2], s2 = slotof[t * 2 + 1];
        const float* gp = gate + (size_t)(t >> 12) * NMOD;
#pragma unroll
        for (int i = 0; i < 2; ++i) { const int o = i * 512 + lane * 8;
            const u32x4 y1 = *(const u32x4*)(Y + (size_t)s1 * D + o), y2 = *(const u32x4*)(Y + (size_t)s2 * D + o);
            float* xp = out + (size_t)t * D + o;
            f32x4 xa = *(const f32x4*)xp, xb = *(const f32x4*)(xp + 4);
            const f32x4 ga = *(const f32x4*)(gp + o), gb = *(const f32x4*)(gp + o + 4);
            xa[0] += ga[0] * (bflo(y1.x) + bflo(y2.x)); xa[1] += ga[1] * (bfhi(y1.x) + bfhi(y2.x)); xa[2] += ga[2] * (bflo(y1.y) + bflo(y2.y)); xa[3] += ga[3] * (bfhi(y1.y) + bfhi(y2.y));
            xb[0] += gb[0] * (bflo(y1.z) + bflo(y2.z)); xb[1] += gb[1] * (bfhi(y1.z) + bfhi(y2.z)); xb[2] += gb[2] * (bflo(y1.w) + bflo(y2.w)); xb[3] += gb[3] * (bfhi(y1.w) + bfhi(y2.w));
            *(f32x4*)xp = xa; *(f32x4*)(xp + 4) = xb; }
    }
}

#ifndef FFN_FP8
#define FFN_FP8 0
#endif
#ifndef PHMASK
#define PHMASK 0xffffffffu
#endif
struct Args { const float* in[33]; float* out; unsigned char* ws; };

__device__ __forceinline__ unsigned long long ldq(volatile LAS unsigned* tab, int i) {
    unsigned lo = tab[2 * i], hi = tab[2 * i + 1];
    lo = __builtin_amdgcn_readfirstlane(lo); hi = __builtin_amdgcn_readfirstlane(hi);
    return ((unsigned long long)hi << 32) | (unsigned long long)lo;
}
#define GAS __attribute__((address_space(1)))
#define INP(i) ((const float*)(const GAS float*)ldq(tab, (i)))
#define OUTP() ((float*)(GAS float*)ldq(tab, 33))
#define WSP() ((unsigned char*)(GAS unsigned char*)ldq(tab, 34))
#define WSF(off) ((float*)(ws + (off)))
#define WSB(off) ((bf16_t*)(ws + (off)))
#define WSI(off) ((int*)(ws + (off)))

__global__ void __launch_bounds__(512, 2) fwd_kernel(Args a_unused) {
    extern __shared__ __attribute__((aligned(16))) unsigned char lds_raw[];
    LAS unsigned char* lds = (LAS unsigned char*)lds_raw;
    volatile LAS unsigned* misc = (volatile LAS unsigned*)(lds + LDS_MISC);
    volatile LAS unsigned* tab = misc + 16;
    const int tid = otid(), G = gridDim.x, bx = blockIdx.x;
    if (tid < 4) misc[tid] = 0u;
    if (tid < 70) { const unsigned* ka = (const unsigned*)__builtin_amdgcn_kernarg_segment_ptr(); tab[tid] = ka[tid]; }
    __syncthreads();
    XcdBarrier bar = xcd_barrier_post((unsigned*)WSP(), misc);

    if (PHMASK & (1u << 0)) {
    { unsigned char* ws = WSP();
      tconv<RM_OFF>(INP(8), 1024, 2048, 512, 1536, WSB(OFF_WIN), 1024, lds, bx, G);
      tconv<RM_OFF>(INP(9), 1024, 1024, 0, 1024, WSB(OFF_WOUT), 0, lds, bx, G);
#if FFN_FP8
      tconv8<RM_GU_G>(INP(21), 1024, DFF, 0, DFF, (fp8_t*)(ws + OFF_WGU), 0, lds, bx, G);
      tconv8<RM_GU_U>(INP(22), 1024, DFF, 0, DFF, (fp8_t*)(ws + OFF_WGU), 0, lds, bx, G);
      tconv8<RM_OFF>(INP(23), DFF, 1024, 0, 1024, (fp8_t*)(ws + OFF_WD), 0, lds, bx, G);
#else
      tconv<RM_GU_G>(INP(21), 1024, DFF, 0, DFF, WSB(OFF_WGU), 0, lds, bx, G);
      tconv<RM_GU_U>(INP(22), 1024, DFF, 0, DFF, WSB(OFF_WGU), 0, lds, bx, G);
      tconv<RM_OFF>(INP(23), DFF, 1024, 0, 1024, WSB(OFF_WD), 0, lds, bx, G);
#endif
      tconv<RM_QKV>(INP(24), 1024, 1536, 0, 1280, WSB(OFF_WQKV), 0, lds, bx, G);
      tconv<RM_OFF>(INP(24), 1024, 1536, 1280, 256, WSB(OFF_WQKV), 1280, lds, bx, G);
      tconv<RM_OFF>(INP(25), 1024, 1024, 0, 1024, WSB(OFF_WO2), 0, lds, bx, G);
      fold_job(INP(8), WSB(OFF_WIN), lds);
      dft_job(WSB(OFF_DFTC), WSF(OFF_TW), lds);
      ada_job(INP(1), INP(3), INP(4), INP(5), WSF(OFF_MOD), lds);
      h3_job(INP(13), INP(14), INP(15), INP(16), INP(17), INP(18), INP(20), WSF(OFF_H3));
      float* ROPEC = WSF(OFF_ROPE); float* ROPES = ROPEC + 1024;
      for (int idx = bx * 512 + tid; idx < 1024; idx += G * 512) { const int pp = idx >> 4, i = idx & 15; const float inv = powf(10000.0f, -(float)i / 16.0f), ang = (float)pp * inv; ROPEC[idx] = cosf(ang); ROPES[idx] = sinf(ang); }
      if (bx == 0 && tid < 128) ROPEC[2048 + tid] = tid < 64 ? INP(26)[tid] : INP(27)[tid - 64];
    }
    }
    xcd_barrier(bar, (unsigned*)WSP());

    if (PHMASK & (1u << 1)) {
    { unsigned char* ws = WSP();
      for (int cp = bx; cp < 256; cp += G) { filt_fin<SEQ>(WSF(OFF_H3), INP(19), WSF(OFF_RC), cp, lds); filt_fin<LCTX>(WSF(OFF_H3) + (size_t)SEQ * 64, INP(19), WSF(OFF_KFC), cp, lds); }
      norm_phase<false>(INP(0), INP(2), MROWS, INP(6), WSF(OFF_MOD), 0, WSB(OFF_HX), nullptr, nullptr, nullptr, lds);
    }
    }
    xcd_barrier(bar, (unsigned*)WSP());

    if (PHMASK & (1u << 2)) {
    { unsigned char* ws = WSP();
      PolU p; p.S.init(UCH / BM, MROWS / BM, G, bx); p.A = WSB(OFF_WIN); p.B = WSB(OFF_HX); p.UT = WSB(OFF_UT); p.UTc = WSB(OFF_UTC); gemm_phase<D>(lds, p); }
    }
    xcd_barrier(bar, (unsigned*)WSP());

    if (PHMASK & (1u << 3)) {
    { unsigned char* ws = WSP();
      fourier2_phase(WSB(OFF_UT), WSB(OFF_AT), WSF(OFF_TW), lds); }
    { unsigned char* ws = WSP();
      PolF p; p.S.init(NB, 2, G, bx); p.DFT = WSB(OFF_DFTC); p.ZT = WSB(OFF_UTC); p.MIX = WSB(OFF_MIX); p.K = 512; p.L = LCTX; p.tpb = 1; p.rowbase = NTOK; p.zstride = (unsigned)UCH * LCTX; p.scale = 0.005524271728019903f; gemm_phase<512>(lds, p); }
    { unsigned char* ws = WSP();
      hyena_prep_phase(WSB(OFF_UT), WSB(OFF_UTC), WSB(OFF_VXF), (unsigned*)(ws + OFF_GT), WSB(OFF_HTC), WSF(OFF_KFC), INP(10), INP(11), INP(12), lds); }
    xcd_barrier(bar, (unsigned*)WSP());
    { unsigned char* ws = WSP();
      toep_phase(WSB(OFF_RC), WSB(OFF_VXF), (const unsigned*)(ws + OFF_GT), INP(12), WSB(OFF_HT), lds); }
    }
    xcd_barrier(bar, (unsigned*)WSP());

    if (PHMASK & (1u << 4)) {
    { unsigned char* ws = WSP(); mix_transpose_phase(WSB(OFF_AT), WSB(OFF_HT), WSB(OFF_HTC), WSB(OFF_MIX), lds); }
    }
    xcd_barrier(bar, (unsigned*)WSP());

    if (PHMASK & (1u << 5)) {
    { unsigned char* ws = WSP();
      PolR<false> p; p.S.init(MROWS / BM, 4, G, bx); p.A = WSB(OFF_MIX); p.B = WSB(OFF_WOUT); p.K = D; p.srcL = INP(0); p.dstL = OUTP(); p.srcC = INP(2); p.dstC = WSF(OFF_CTXR); p.gate = WSF(OFF_MOD) + 2 * D; gemm_phase<D>(lds, p); }
    }
    xcd_barrier(bar, (unsigned*)WSP());

    if (PHMASK & (1u << 6)) {
    { unsigned char* ws = WSP(); norm_phase<false, FFN_FP8 != 0>(OUTP(), WSF(OFF_CTXR), MROWS, INP(7), WSF(OFF_MOD), 3, WSB(OFF_HX), nullptr, nullptr, nullptr, lds); }
    }
    xcd_barrier(bar, (unsigned*)WSP());

    if (PHMASK & (1u << 7)) {
    { unsigned char* ws = WSP();
      PolG<false, TileOrder, FFN_FP8 != 0> p; p.S.init(MROWS / BM, DFF / HALF, G, bx); p.A = WSB(OFF_HX); p.B = WSB(OFF_WGU); p.H = WSB(OFF_HID); p.tok = nullptr; p.tile_e = nullptr; p.tile0 = 0; gemm_phase<D>(lds, p); }
    }
    xcd_barrier(bar, (unsigned*)WSP());

    if (PHMASK & (1u << 8)) {
    { unsigned char* ws = WSP();
      PolR<FFN_FP8 != 0> p; p.S.init(MROWS / BM, 4, G, bx); p.A = WSB(OFF_HID); p.B = WSB(OFF_WD); p.K = DFF; p.srcL = OUTP(); p.dstL = OUTP(); p.srcC = WSF(OFF_CTXR); p.dstC = WSF(OFF_CTXR); p.gate = WSF(OFF_MOD) + 5 * D; gemm_phase<DFF>(lds, p); }
    }
    xcd_barrier(bar, (unsigned*)WSP());

    if (PHMASK & (1u << 9)) {
    { unsigned char* ws = WSP();
      norm_phase<false>(OUTP(), WSF(OFF_CTXR), MROWS, INP(6) + D, WSF(OFF_MOD) + 17 * NMOD, 0, WSB(OFF_HX), nullptr, nullptr, nullptr, lds);
      for (int e = 0; e < NE; ++e) {
          tconv8<RM_GU_G>(INP(30) + (size_t)e * D * DFF, 1024, DFF, 0, DFF, (fp8_t*)(ws + OFF_MGU) + (size_t)e * 2 * DFF * D, 0, lds, bx, G);
          tconv8<RM_GU_U>(INP(31) + (size_t)e * D * DFF, 1024, DFF, 0, DFF, (fp8_t*)(ws + OFF_MGU) + (size_t)e * 2 * DFF * D, 0, lds, bx, G);
          tconv8<RM_OFF>(INP(32) + (size_t)e * DFF * D, DFF, 1024, 0, 1024, (fp8_t*)(ws + OFF_MD) + (size_t)e * D * DFF, 0, lds, bx, G);
      }
    }
    }
    xcd_barrier(bar, (unsigned*)WSP());

    if (PHMASK & (1u << 10)) {
    { unsigned char* ws = WSP();
      PolQKV p; p.S.init(MROWS / BM, 5, G, bx); p.HX = WSB(OFF_HX); p.W = WSB(OFF_WQKV); p.ws = ws; p.qkg = WSF(OFF_ROPE) + 2048; p.ropec = WSF(OFF_ROPE); p.ropes = WSF(OFF_ROPE) + 1024; gemm_phase<D>(lds, p); }
    }
    xcd_barrier(bar, (unsigned*)WSP());

    if (PHMASK & (1u << 11)) {
    { unsigned char* ws = WSP(); attn_phase(WSB(OFF_Q), WSB(OFF_K), WSB(OFF_V), WSB(OFF_AO), INP(28), lds); }
    }
    xcd_barrier(bar, (unsigned*)WSP());

    if (PHMASK & (1u << 12)) {
    { unsigned char* ws = WSP();
      PolR<false> p; p.S.init(NTOK / BM, 4, G, bx); p.A = WSB(OFF_AO); p.B = WSB(OFF_WO2); p.K = D; p.srcL = OUTP(); p.dstL = OUTP(); p.srcC = WSF(OFF_CTXR); p.dstC = WSF(OFF_CTXR); p.gate = WSF(OFF_MOD) + 17 * NMOD + 2 * D; gemm_phase<D>(lds, p); }
    }
    xcd_barrier(bar, (unsigned*)WSP());

    if (PHMASK & (1u << 13)) {
    { unsigned char* ws = WSP();
      norm_phase<true>(OUTP(), nullptr, NTOK, INP(7) + D, WSF(OFF_MOD) + 17 * NMOD, 3, WSB(OFF_HX8), INP(29), (unsigned*)(ws + OFF_ROUTE), WSI(OFF_HIST), lds); }
    }
    xcd_barrier(bar, (unsigned*)WSP());

    if (PHMASK & (1u << 14)) {
    { unsigned char* ws = WSP(); slots_phase((const unsigned*)(ws + OFF_ROUTE), WSI(OFF_HIST), WSI(OFF_TOK), WSF(OFF_GW), WSI(OFF_SLOTOF), WSI(OFF_TILEE), lds); }
    }
    xcd_barrier(bar, (unsigned*)WSP());

    if (PHMASK & (1u << 15)) {
#pragma unroll
    for (int ch = 0; ch < NCHUNK; ++ch) {
        { unsigned char* ws = WSP();
          const int ntiles = WSI(OFF_TILEE)[1023], per = (ntiles + NCHUNK - 1) / NCHUNK, t0 = ch * per; int ntc = ntiles - t0; ntc = ntc > per ? per : ntc; if (ntc < 0) ntc = 0;
          PolG<true, LinOrder<DFF / HALF>, true> p; p.S.init(ntc, DFF / HALF, G, bx); p.A = ws + OFF_HX8; p.B = ws + OFF_MGU; p.H = ws + OFF_HIDM; p.tok = WSI(OFF_TOK); p.tile_e = WSI(OFF_TILEE); p.tile0 = t0; gemm_phase<D>(lds, p); }
        xcd_barrier(bar, (unsigned*)WSP());
        { unsigned char* ws = WSP();
          const int ntiles = WSI(OFF_TILEE)[1023], per = (ntiles + NCHUNK - 1) / NCHUNK, t0 = ch * per; int ntc = ntiles - t0; ntc = ntc > per ? per : ntc; if (ntc < 0) ntc = 0;
          PolD p; p.S.init(ntc, 4, G, bx); p.A = (const fp8_t*)(ws + OFF_HIDM); p.B = (const fp8_t*)(ws + OFF_MD); p.Y = WSB(OFF_Y); p.gw = WSF(OFF_GW); p.tile_e = WSI(OFF_TILEE); p.tile0 = t0; gemm_phase<DFF>(lds, p); }
        xcd_barrier(bar, (unsigned*)WSP());
    }
    }

    if (PHMASK & (1u << 16)) {
    { unsigned char* ws = WSP(); combine_phase(OUTP(), WSB(OFF_Y), WSI(OFF_SLOTOF), WSF(OFF_MOD) + 17 * NMOD + 5 * D); }
    }
}

extern "C" void kernel_launch(void* const* d_in, const int* in_sizes, int n_in, void* d_out, int out_size, void* d_ws, size_t ws_size, hipStream_t stream) {
    static int grid = 0;
    if (grid == 0) {
        if (n_in != 33 || in_sizes[0] != NTOK * D || out_size != NTOK * D || ws_size < WS_NEED) {
            fprintf(stderr, "kernel_launch: unexpected shapes: n_in %d in0 %d out %d ws %zu (need %zu)\n", n_in, n_in > 0 ? in_sizes[0] : -1, out_size, ws_size, (size_t)WS_NEED); grid = -1; return; }
        int dev = 0, cus = 0;
        if (hipGetDevice(&dev) != hipSuccess || hipDeviceGetAttribute(&cus, hipDeviceAttributeMultiprocessorCount, dev) != hipSuccess) { grid = -1; return; }
        if (hipFuncSetAttribute((const void*)fwd_kernel, hipFuncAttributeMaxDynamicSharedMemorySize, LDS_BYTES) != hipSuccess) { fprintf(stderr, "kernel_launch: hipFuncSetAttribute failed\n"); grid = -1; return; }
        int per_cu = 0;
        if (hipOccupancyMaxActiveBlocksPerMultiprocessor(&per_cu, (const void*)fwd_kernel, 512, LDS_BYTES) != hipSuccess || per_cu < 1) { fprintf(stderr, "kernel_launch: occupancy query says %d\n", per_cu); }
        (void)hipGetLastError();
        if (cus != 256) { fprintf(stderr, "kernel_launch: built for 256 CUs, device has %d\n", cus); grid = -1; return; }
        grid = 256;
    }
    if (grid < 0) return;
    if (hipMemsetAsync((char*)d_ws + OFF_CTL, 0, 65536, stream) != hipSuccess) return;
    Args a{};
    for (int i = 0; i < 33; ++i) a.in[i] = (const float*)d_in[i];
    a.out = (float*)d_out; a.ws = (unsigned char*)d_ws;
    hipLaunchKernelGGL(fwd_kernel, dim3(grid), dim3(512), LDS_BYTES, stream, a);
}
```

```cpp
#include <hip/hip_runtime.h>
#include <cstdio>
#include <cstdint>

#define LAS __attribute__((address_space(3)))
typedef unsigned short bf16_t;
typedef short bf16x8 __attribute__((ext_vector_type(8)));
typedef float f32x4 __attribute__((ext_vector_type(4)));
typedef float f32x2 __attribute__((ext_vector_type(2)));
typedef unsigned u32x4 __attribute__((ext_vector_type(4)));
typedef unsigned u32x2 __attribute__((ext_vector_type(2)));
typedef __bf16 bf16x2_t __attribute__((ext_vector_type(2)));
typedef float f32x16 __attribute__((ext_vector_type(16)));
typedef int i32x8 __attribute__((ext_vector_type(8)));
typedef unsigned char fp8_t;

#ifndef KREP_G1
#define KREP_G1 1
#endif
#ifndef KREP_FFN
#define KREP_FFN 1
#endif
#ifndef KREP_MOE
#define KREP_MOE 1
#endif
#ifndef KLOOP_REP
#define KLOOP_REP 1
#endif
#ifndef EREP_U
#define EREP_U 1
#endif
#ifndef EREP_G
#define EREP_G 1
#endif
#ifndef EREP_GM
#define EREP_GM 1
#endif
#ifndef EREP_QKV
#define EREP_QKV 1
#endif
#ifndef EREP_D
#define EREP_D 1
#endif
#ifndef GEMM_ALIGN
#define GEMM_ALIGN 1
#endif
constexpr int D = 1024, NB = 16, SEQ = 4096, NTOK = NB * SEQ, LCTX = 256, NCTX = NB * LCTX, MROWS = NTOK + NCTX;
constexpr int DFF = 3584, NE = 8, NMOD = 6 * D;
constexpr int UCH = 2560;
constexpr int MAXSLOT = 133120;
constexpr int MAXTILES = MAXSLOT / 256;
constexpr int NCHUNK = 1;
constexpr float EPS = 1e-6f;

constexpr size_t al4k(size_t x) { return (x + 4095) & ~(size_t)4095; }
constexpr size_t MiB = 1024 * 1024;
constexpr size_t OFF_CTL = 0;
constexpr size_t OFF_MOD = 65536;
constexpr size_t OFF_ROPE = OFF_MOD + al4k((size_t)2 * 17 * NMOD * 4);
constexpr size_t OFF_H3 = OFF_ROPE + al4k(2 * 64 * 16 * 4 + 512);
constexpr size_t OFF_KF = OFF_H3 + al4k((size_t)4352 * 64 * 4);
constexpr size_t OFF_KFC = OFF_KF + (size_t)512 * 8192 * 4;
constexpr size_t OFF_ROUTE = OFF_KFC + (size_t)512 * 512 * 4;
constexpr size_t OFF_HIST = OFF_ROUTE + (size_t)NTOK * 16;
constexpr size_t OFF_TOK = OFF_HIST + al4k(256 * 8 * 4);
constexpr size_t OFF_GW = OFF_TOK + al4k((size_t)MAXSLOT * 4);
constexpr size_t OFF_SLOTOF = OFF_GW + al4k((size_t)MAXSLOT * 4);
constexpr size_t OFF_TILEE = OFF_SLOTOF + (size_t)NTOK * 8;
constexpr size_t OFF_CTXR = OFF_TILEE + 4096;
constexpr size_t OFF_WIN = OFF_CTXR + (size_t)NCTX * D * 4;
constexpr size_t OFF_WOUT = OFF_WIN + (size_t)UCH * D * 2;
constexpr size_t OFF_WGU = OFF_WOUT + (size_t)D * D * 2;
constexpr size_t OFF_WD = OFF_WGU + (size_t)2 * DFF * D * 2;
constexpr size_t OFF_WQKV = OFF_WD + (size_t)D * DFF * 2;
constexpr size_t OFF_WO2 = OFF_WQKV + (size_t)1536 * D * 2;
constexpr size_t OFF_DFTC = OFF_WO2 + (size_t)D * D * 2;
constexpr size_t OFF_A_END = OFF_DFTC + (size_t)256 * 512 * 2;
static_assert(OFF_A_END <= 80 * MiB, "region A");
constexpr size_t OFF_HX = 80 * MiB;
constexpr size_t OFF_UT = 216 * MiB;
constexpr size_t OFF_UTC = 536 * MiB;
constexpr size_t OFF_MIX = 556 * MiB;
constexpr size_t OFF_HT = 692 * MiB;
constexpr size_t OFF_HTC = 756 * MiB;
constexpr size_t OFF_DFT = 760 * MiB;
constexpr size_t OFF_HID = 216 * MiB;
constexpr size_t OFF_Q = 216 * MiB;
constexpr size_t OFF_K = 344 * MiB;
constexpr size_t OFF_V = 378 * MiB;
constexpr size_t OFF_AO = 412 * MiB;
constexpr size_t OFF_HIDM = 144 * MiB;
constexpr size_t OFF_Y = 600 * MiB;
constexpr size_t OFF_XB = 896 * MiB;
static_assert(OFF_HIDM + (size_t)MAXSLOT * DFF <= OFF_Y && OFF_Y + (size_t)MAXSLOT * D * 2 <= OFF_XB, "moe map");
constexpr size_t DO_MGU = 0;
constexpr size_t DO_MD = 56 * MiB;
constexpr size_t DO_HX8 = 96 * MiB;
constexpr size_t OFF_AT = 760 * MiB;
constexpr size_t OFF_TW = OFF_KF;
constexpr size_t OFF_VXT = 824 * MiB;
constexpr size_t OFF_X0T = 888 * MiB;
constexpr size_t OFF_ZERO16 = 32768;
constexpr size_t OFF_RC = 952 * MiB;
constexpr size_t WS_NEED = 1024 * MiB;


constexpr int LDS_BYTES = 151552;
constexpr int LDS_MISC = LDS_BYTES - 1024;

__device__ __forceinline__ unsigned cvt_pk_bf16(float lo, float hi) { unsigned r; asm volatile("v_cvt_pk_bf16_f32 %0, %1, %2" : "=v"(r) : "v"(lo), "v"(hi)); return r; }
__device__ __forceinline__ bf16_t f2bf(float f) { unsigned u = __float_as_uint(f); u += 0x7FFFu + ((u >> 16) & 1u); return (bf16_t)(u >> 16); }
__device__ __forceinline__ float bf2f(bf16_t b) { return __uint_as_float(((unsigned)b) << 16); }
__device__ __forceinline__ float bflo(unsigned u) { return __uint_as_float(u << 16); }
__device__ __forceinline__ float bfhi(unsigned u) { return __uint_as_float(u & 0xffff0000u); }
__device__ __forceinline__ float dot2(unsigned a, unsigned b, float acc) { return __builtin_amdgcn_fdot2_f32_bf16(__builtin_bit_cast(bf16x2_t, a), __builtin_bit_cast(bf16x2_t, b), acc, false); }
__device__ __forceinline__ float wave_sum(float v) {
#pragma unroll
    for (int o = 32; o >= 1; o >>= 1) v += __shfl_xor(v, o);
    return v;
}
__device__ __forceinline__ unsigned pk4_fp8(float a, float b, float c, float d) { int w = __builtin_amdgcn_cvt_pk_fp8_f32(a, b, 0, false); w = __builtin_amdgcn_cvt_pk_fp8_f32(c, d, w, true); return (unsigned)w; }
constexpr float F8_ACT = 8.0f, F8_W = 64.0f, F8_HID = 4.0f;
__device__ __forceinline__ int otid() { int t = threadIdx.x; asm volatile("" : "+v"(t)); return t; }
__device__ __forceinline__ float silu_f(float x) { return x * __builtin_amdgcn_rcpf(1.0f + __builtin_amdgcn_exp2f(-1.4426950408889634f * x)); }

#ifndef SW_ID
#define SW_ID 0
#endif
#ifndef SW_AMP
#define SW_AMP 8
#endif
#ifndef SW_BLOCK
#define SW_BLOCK 0
#endif
#ifndef SW_PHASE
#define SW_PHASE 0
#endif
__device__ __forceinline__ void sw_start(LAS unsigned char* lds, int id, bool on) {
    if (SW_ID != 0 && SW_ID == id && on) { if (threadIdx.x == 0 && blockIdx.x == SW_BLOCK) *(volatile LAS unsigned long long*)(lds + (151552 - 1024) + 528) = __builtin_amdgcn_s_memrealtime(); }
}
__device__ __forceinline__ void sw_stop(LAS unsigned char* lds, int id, bool on) {
    if (SW_ID != 0 && SW_ID == id && on) { if (threadIdx.x == 0 && blockIdx.x == SW_BLOCK) { volatile LAS unsigned long long* q = (volatile LAS unsigned long long*)(lds + (151552 - 1024) + 512);
        q[0] = q[0] + (__builtin_amdgcn_s_memrealtime() - q[2]); } }
}

#define XB_TMO      128
#define XB_XCNT(j)  (256  + 64 * (j))
#define XB_XSUB(j)  (1280 + 64 * (j))
#define XB_XGEN(j)  (2304 + 64 * (j))
#define XB_TOP      3328
#define XB_TOPGEN   3392
#define XCD_BAR_WORDS 3456
#define XB_SPIN_CAP (1u << 22)

__device__ __forceinline__ unsigned xb_ld(unsigned* p)              { return __hip_atomic_load(p, __ATOMIC_RELAXED, __HIP_MEMORY_SCOPE_AGENT); }
__device__ __forceinline__ unsigned xb_add(unsigned* p, unsigned v) { return __hip_atomic_fetch_add(p, v, __ATOMIC_RELAXED, __HIP_MEMORY_SCOPE_AGENT); }
__device__ __forceinline__ unsigned xb_xcc_id() { return (unsigned)__builtin_amdgcn_s_getreg((3 << 11) | 20) & 0xFu; }
#define XB_SPIN(cond, bar) do { unsigned _sp = 0; while (cond) { __builtin_amdgcn_s_sleep(1); \
    if ((++_sp & 255u) == 0u) { if (xb_ld(&(bar)[XB_TMO])) break; if (_sp > XB_SPIN_CAP) { atomicAdd(&(bar)[XB_TMO], 1u); break; } } } } while (0)

struct XcdBarrier { volatile LAS unsigned* st; };

__device__ __forceinline__ XcdBarrier xcd_barrier_post(unsigned* bar, volatile LAS unsigned* st) {
    XcdBarrier b; b.st = st;
    if (threadIdx.x == 0) { const unsigned x = xb_xcc_id(); st[2] = x; (void)xb_add(&bar[XB_XCNT(x)], 1u); }
    return b;
}
__device__ __forceinline__ void xcd_barrier_complete(unsigned* bar, unsigned x, unsigned& nloc, unsigned& nx) {
    const unsigned G = gridDim.x * gridDim.y * gridDim.z;
    unsigned sum, cnt, mine, sp = 0u;
    for (;;) {
        sum = 0u; cnt = 0u;
#pragma unroll
        for (unsigned j = 0; j < 16; ++j) { const unsigned c = xb_ld(&bar[XB_XCNT(j)]); sum += c; cnt += (c > 0u) ? 1u : 0u; }
        mine = xb_ld(&bar[XB_XCNT(x)]);
        if (sum == G) break;
        __builtin_amdgcn_s_sleep(1);
        if ((++sp & 255u) == 0u) { if (xb_ld(&bar[XB_TMO])) break; if (sp > XB_SPIN_CAP) { atomicAdd(&bar[XB_TMO], 1u); break; } }
    }
    nloc = mine > 0u ? mine : 1u; nx = cnt > 0u ? cnt : 1u;
}
__device__ __forceinline__ void xcd_barrier(const XcdBarrier& b, unsigned* bar) {
    asm volatile("s_waitcnt vmcnt(0)" ::: "memory");
    __syncthreads();
    if (threadIdx.x == 0) {
        __builtin_amdgcn_s_waitcnt(0);
        unsigned nloc = b.st[0], nx = b.st[1]; const unsigned bx_ = b.st[2];
        if (nloc == 0u) { xcd_barrier_complete(bar, bx_, nloc, nx); b.st[0] = nloc; b.st[1] = nx; }
        const unsigned old = xb_add(&bar[XB_XSUB(bx_)], 1u);
        const unsigned gen = old / nloc;
        if (old + 1u == (gen + 1u) * nloc) {
            __builtin_amdgcn_fence(__ATOMIC_RELEASE, "agent");
            asm volatile("s_waitcnt vmcnt(0)" ::: "memory");
            const unsigned og = xb_add(&bar[XB_TOP], 1u);
            const unsigned tg = og / nx;
            if (og + 1u == (tg + 1u) * nx) xb_add(&bar[XB_TOPGEN], 1u);
            else XB_SPIN(xb_ld(&bar[XB_TOPGEN]) == tg, bar);
            __builtin_amdgcn_fence(__ATOMIC_ACQUIRE, "agent");
            xb_add(&bar[XB_XGEN(bx_)], 1u);
            asm volatile("s_waitcnt vmcnt(0)" ::: "memory");
        } else {
            XB_SPIN(xb_ld(&bar[XB_XGEN(bx_)]) == gen, bar);
            __builtin_amdgcn_fence(__ATOMIC_ACQUIRE, "agent");
            asm volatile("s_waitcnt vmcnt(0)" ::: "memory");
        }
    }
    __syncthreads();
}

constexpr int BM = 256, BK = 64, HALF = 128, HTB = HALF * BK * 2, NXCD = 8, WGM = 8;
__host__ __device__ __forceinline__ int lds_byte(int r, int c) { const int st = (r >> 4) * 2 + (c >> 5), rr = r & 15, cc = c & 31, ob = rr * 64 + cc * 2; return st * 1024 + (ob ^ (((ob >> 9) & 1) << 5)); }
__host__ __device__ __forceinline__ void stage_rc(int b, int& R, int& C) { const int st = b / 1024, sb = b % 1024, swz = sb ^ (((sb >> 9) & 1) << 5); R = (st >> 1) * 16 + swz / 64; C = (st & 1) * 32 + (swz % 64) / 2; }
__host__ __device__ __forceinline__ int perm32(int rho) { const int n = rho >> 4, i = rho & 15; return 8 * (i >> 2) + 4 * n + (i & 3); }

struct Unit { int pm, pn; };
struct TileOrder {
    int nM, nN, nwg, G, c;
    __device__ __forceinline__ void init(int nM_, int nN_, int G_, int c_) { nM = nM_; nN = nN_; nwg = nM * nN; G = G_; c = c_; }
    __device__ __forceinline__ bool next(int i, Unit& u) const {
        const long L = (long)i * G + c; if (L >= nwg) return false;
        int wgid = (int)L; { const int q = nwg / NXCD, r = nwg % NXCD, xcd = wgid % NXCD, off = wgid / NXCD; wgid = (xcd < r ? xcd * (q + 1) : r * (q + 1) + (xcd - r) * q) + off; }
        const int nig = WGM * nN, gid = wgid / nig, fm = gid * WGM, gsz = (nM - fm) < WGM ? (nM - fm) : WGM;
        u.pm = fm + ((wgid % nig) % gsz); u.pn = (wgid % nig) / gsz; return true;
    }
};

template <int NN> struct LinOrder {
    int nwg, G, c;
    __device__ __forceinline__ void init(int nM_, int, int G_, int c_) { nwg = nM_ * NN; G = G_; c = c_; }
    __device__ __forceinline__ bool next(int i, Unit& u) const { const int L = i * G + c; if (L >= nwg) return false; u.pm = L / NN; u.pn = L % NN; return true; }
};

typedef f32x4 AccT[2][2][4][2];
typedef unsigned u32x8 __attribute__((ext_vector_type(8)));
template <bool F8> struct Frag;
template <> struct Frag<false> { bf16x8 k[2]; };
template <> struct Frag<true> { u32x8 q; };

template <int K, class P>
__device__ __forceinline__ void gemm_phase(LAS unsigned char* lds, const P& p, const int stagger_ticks = 0, const int krep = 1, const bool sw = false) {
    int tid_ = threadIdx.x; asm volatile("" : "+v"(tid_));
    const int tid = tid_, wid = __builtin_amdgcn_readfirstlane(tid >> 6), lane = tid & 63, wr = wid >> 2, wc = wid & 3, fr = lane & 15, fq = lane >> 4;
    constexpr int RB = P::FP8 ? K : K * 2;
    constexpr int nt = RB / 128;
    constexpr unsigned hstep = (unsigned)HALF * RB;
    unsigned vA[2], vB[2], vG[2][2], vGn[2][2];
#pragma unroll
    for (int i = 0; i < 2; ++i) { int R, C; stage_rc(tid * 16 + i * 8192, R, C); const int Rb = P::PERM ? ((R & ~31) + perm32(R & 31)) : R;
        vA[i] = (unsigned)(R * RB + C * 2); vB[i] = (unsigned)(Rb * RB + C * 2); }
    constexpr size_t kstep = (size_t)(BK * 2);
    const unsigned ldsw = (unsigned)wid * 1024u;
    const int aoff = P::FP8 ? lds_byte(wr * 64 + fr, fq * 16) : lds_byte(wr * 64 + fr, fq * 8), boff = P::FP8 ? lds_byte(wc * 32 + fr, fq * 16) : lds_byte(wc * 32 + fr, fq * 8);
#define PG8_SA(b, h) (((b) * 2 + (h)) * HTB)
#define PG8_SB(b, h) ((4 + (b) * 2 + (h)) * HTB)
#define PG8_STAGE(bufoff, gbase, v0, v1) do { \
        __builtin_amdgcn_global_load_lds((const unsigned*)((const char*)(gbase) + (v0)), (LAS unsigned*)(lds + (bufoff) + ldsw), 16, 0, 0); \
        __builtin_amdgcn_global_load_lds((const unsigned*)((const char*)(gbase) + (v1)), (LAS unsigned*)(lds + (bufoff) + ldsw + 8192), 16, 0, 0); } while (0)
#define PG8_STB(bufoff, gbase, h) PG8_STAGE(bufoff, (gbase) + (h) * hstep, vB[0], vB[1])
#define PG8_STAX(bufoff, gbase, h, nx) do { if constexpr (P::GATHER) { PG8_STAGE(bufoff, gbase, ((nx) ? vGn[h][0] : vG[h][0]), ((nx) ? vGn[h][1] : vG[h][1])); } \
        else { PG8_STAGE(bufoff, (gbase) + (h) * hstep, vA[0], vA[1]); } } while (0)
#define PG8_STA(bufoff, gbase, h) PG8_STAX(bufoff, gbase, h, false)
#define PG8_LD8(addr) __builtin_shufflevector(*(const LAS u32x4*)((addr) + f8lo), *(const LAS u32x4*)((addr) + f8hi), 0, 1, 2, 3, 4, 5, 6, 7)
#define PG8_LDA(dst, b, h) do { if constexpr (P::FP8) { _Pragma("unroll") for (int m = 0; m < 4; ++m) dst[m].q = PG8_LD8(lds + PG8_SA(b, h) + aoff + m * 2048); } \
        else { _Pragma("unroll") for (int m = 0; m < 4; ++m) _Pragma("unroll") for (int k = 0; k < 2; ++k) dst[m].k[k] = *(const LAS bf16x8*)(lds + PG8_SA(b, h) + aoff + m * 2048 + k * 1024); } } while (0)
#define PG8_LDB(dst, b, h) do { if constexpr (P::FP8) { _Pragma("unroll") for (int n = 0; n < 2; ++n) dst[n].q = PG8_LD8(lds + PG8_SB(b, h) + boff + n * 2048); } \
        else { _Pragma("unroll") for (int n = 0; n < 2; ++n) _Pragma("unroll") for (int k = 0; k < 2; ++k) dst[n].k[k] = *(const LAS bf16x8*)(lds + PG8_SB(b, h) + boff + n * 2048 + k * 1024); } } while (0)
#define PG8_MMA(ai, bj, At, Bt) do { __builtin_amdgcn_s_setprio(1); if constexpr (P::FP8) { _Pragma("unroll") for (int m = 0; m < 4; ++m) _Pragma("unroll") for (int n = 0; n < 2; ++n) \
            asm volatile("v_mfma_scale_f32_16x16x128_f8f6f4 %0, %1, %2, %0, %3, %3 op_sel_hi:[0,0,0]" : "+v"(acc[ai][bj][m][n]) : "v"(Bt[n].q), "v"(At[m].q), "v"(f8scale)); } \
        else { _Pragma("unroll") for (int m = 0; m < 4; ++m) _Pragma("unroll") for (int n = 0; n < 2; ++n) _Pragma("unroll") for (int k = 0; k < 2; ++k) \
            acc[ai][bj][m][n] = __builtin_amdgcn_mfma_f32_16x16x32_bf16(Bt[n].k[k], At[m].k[k], acc[ai][bj][m][n], 0, 0, 0); } __builtin_amdgcn_s_setprio(0); } while (0)
#define PG8_WAIT_V(n) asm volatile("s_waitcnt vmcnt(" #n ")" ::: "memory")
#define PG8_WAIT_L(n) asm volatile("s_waitcnt lgkmcnt(" #n ")" ::: "memory")
#define PG8_BAR __builtin_amdgcn_s_barrier()
#define PG8_SCHED __builtin_amdgcn_sched_barrier(0)
#define PG8_GROWS(dst, u) do { if constexpr (P::GATHER) { _Pragma("unroll") for (int i = 0; i < 2; ++i) { int R, C; stage_rc(tid * 16 + i * 8192, R, C); \
        _Pragma("unroll") for (int h = 0; h < 2; ++h) dst[h][i] = (unsigned)(p.arow(u, h * HALF + R) * RB + C * 2); } } } while (0)
    Unit cur, nxt; int ui = 0;
    if (!p.next(0, cur)) return;
    sw_start(lds, 1, sw);
    if (stagger_ticks > 0) {
        const unsigned long long t0 = __builtin_amdgcn_s_memrealtime();
        const unsigned k = (blockIdx.x >> 3) & 31u;
        const unsigned long long dt = (unsigned long long)(k * (unsigned)stagger_ticks) >> 5;
        while (__builtin_amdgcn_s_memrealtime() - t0 < dt) __builtin_amdgcn_s_sleep(8);
    }
    AccT acc;
#pragma unroll
    for (int a = 0; a < 2; ++a)
#pragma unroll
        for (int b = 0; b < 2; ++b)
#pragma unroll
            for (int m = 0; m < 4; ++m)
#pragma unroll
                for (int n = 0; n < 2; ++n) acc[a][b][m][n] = (f32x4){0.f, 0.f, 0.f, 0.f};
    Frag<P::FP8> At[4], B0[2], B1[2];
    const int f8lo = (fq & 1) * 16, f8hi = 16 - f8lo;
    unsigned f8scale = 0x7f7f7f7fu; asm volatile("" : "+v"(f8scale));
    const char* cA = p.abase(cur); const char* cB = p.bbase(cur);
    PG8_GROWS(vG, cur);
    PG8_GROWS(vGn, cur);
    PG8_STB(PG8_SB(0, 0), cB, 0); PG8_STB(PG8_SB(0, 1), cB, 1); PG8_STA(PG8_SA(0, 0), cA, 0); PG8_STA(PG8_SA(0, 1), cA, 1);
    if (wr == 1) PG8_BAR;
    PG8_WAIT_V(2); PG8_BAR;
    PG8_STB(PG8_SB(1, 0), cB + kstep, 0); PG8_STA(PG8_SA(1, 0), cA + kstep, 0); PG8_STB(PG8_SB(1, 1), cB + kstep, 1);
    PG8_WAIT_V(6); PG8_BAR;
    for (;;) {
        const bool has_next = p.next(ui + 1, nxt);
        const char* nA = cA; const char* nB = cB;
        if (has_next) { nA = p.abase(nxt); nB = p.bbase(nxt); PG8_GROWS(vGn, nxt); }
        sw_stop(lds, 4, sw && ui > 0); sw_start(lds, 2, sw);
#pragma unroll 1
        for (int krep_ = 0; krep_ < KLOOP_REP * krep; ++krep_) {
        const bool realnext_ = (krep_ == KLOOP_REP * krep - 1);
        if (krep_ > 0) {
#pragma unroll
            for (int a = 0; a < 2; ++a)
#pragma unroll
                for (int b = 0; b < 2; ++b)
#pragma unroll
                    for (int m = 0; m < 4; ++m)
#pragma unroll
                        for (int n = 0; n < 2; ++n) acc[a][b][m][n] = (f32x4){0.f, 0.f, 0.f, 0.f};
        }
#pragma unroll 1
        for (int t = 0; t < nt; t += 2) {
            const bool lastt_ = (t == nt - 2);
            const bool last = lastt_ && realnext_;
            const char* a1 = cA + (size_t)(t + 1) * kstep;
            const char* a2 = lastt_ ? (realnext_ ? nA : cA) : cA + (size_t)(t + 2) * kstep; const char* b2 = lastt_ ? (realnext_ ? nB : cB) : cB + (size_t)(t + 2) * kstep;
            const char* a3 = a2 + kstep; const char* b3 = b2 + kstep;
            PG8_LDB(B0, 0, 0); PG8_LDB(B1, 0, 1); PG8_SCHED; PG8_LDA(At, 0, 0); PG8_STA(PG8_SA(1, 1), a1, 1);
            PG8_WAIT_V(8); PG8_WAIT_L(0); PG8_BAR; PG8_MMA(0, 0, At, B0); PG8_MMA(0, 1, At, B1); PG8_BAR; PG8_SCHED;
            PG8_LDA(At, 0, 1); PG8_STB(PG8_SB(0, 0), b2, 0); PG8_STB(PG8_SB(0, 1), b2, 1); PG8_STAX(PG8_SA(0, 0), a2, 0, last);
            PG8_WAIT_V(8); PG8_WAIT_L(0); PG8_BAR; PG8_MMA(1, 0, At, B0); PG8_MMA(1, 1, At, B1); PG8_BAR; PG8_SCHED;
            PG8_LDB(B0, 1, 0); PG8_LDB(B1, 1, 1); PG8_SCHED; PG8_LDA(At, 1, 0); PG8_STAX(PG8_SA(0, 1), a2, 1, last);
            PG8_WAIT_V(8); PG8_WAIT_L(0); PG8_BAR; PG8_MMA(0, 0, At, B0); PG8_MMA(0, 1, At, B1); PG8_BAR; PG8_SCHED;
            PG8_LDA(At, 1, 1); PG8_STB(PG8_SB(1, 0), b3, 0); PG8_STB(PG8_SB(1, 1), b3, 1); PG8_STAX(PG8_SA(1, 0), a3, 0, last);
            PG8_WAIT_V(8); PG8_WAIT_L(0); PG8_BAR; PG8_MMA(1, 0, At, B0); PG8_MMA(1, 1, At, B1); PG8_BAR; PG8_SCHED;
        }
        }
        sw_stop(lds, 2, sw); sw_start(lds, 3, sw);
        if (GEMM_ALIGN && wr == 0) PG8_BAR;
        if constexpr (P::FP8) asm volatile("s_nop 15\n\ts_nop 15" ::: "memory");
        if constexpr (P::EREP > 1) { int er_ = P::EREP; asm volatile("" : "+s"(er_));
#pragma unroll 1
            for (; er_ > 0; --er_) p.epi(acc, cur, wr, wc, fr, fq); }
        else p.epi(acc, cur, wr, wc, fr, fq);
        sw_stop(lds, 3, sw); sw_start(lds, 4, sw);
        if (!has_next) break;
#pragma unroll
        for (int a = 0; a < 2; ++a)
#pragma unroll
            for (int b = 0; b < 2; ++b)
#pragma unroll
                for (int m = 0; m < 4; ++m)
#pragma unroll
                    for (int n = 0; n < 2; ++n) acc[a][b][m][n] = (f32x4){0.f, 0.f, 0.f, 0.f};
        cur = nxt; cA = nA; cB = nB; ++ui;
        if constexpr (P::GATHER) {
#pragma unroll
            for (int h = 0; h < 2; ++h)
#pragma unroll
                for (int i = 0; i < 2; ++i) vG[h][i] = vGn[h][i];
        }
        if (GEMM_ALIGN && wr == 1) PG8_BAR;
    }
    PG8_WAIT_V(0);
    if (!GEMM_ALIGN && wr == 0) PG8_BAR;
    PG8_BAR;
    sw_stop(lds, 1, sw);
#undef PG8_SA
#undef PG8_SB
#undef PG8_STAGE
#undef PG8_STB
#undef PG8_STA
#undef PG8_STAX
#undef PG8_LDA
#undef PG8_LDB
#undef PG8_MMA
#undef PG8_WAIT_V
#undef PG8_WAIT_L
#undef PG8_BAR
#undef PG8_SCHED
#undef PG8_GROWS
#undef PG8_LD8
}


struct PolU {
    static constexpr bool PERM = true, GATHER = false, FP8 = false; static constexpr int EREP = EREP_U;
    TileOrder S; const bf16_t* A; const bf16_t* B; bf16_t* UT; bf16_t* UTc;
    __device__ __forceinline__ bool next(int i, Unit& u) const { return S.next(i, u); }
    __device__ __forceinline__ const char* abase(const Unit& u) const { return (const char*)A + (unsigned)u.pm * (unsigned)(BM * D * 2); }
    __device__ __forceinline__ const char* bbase(const Unit& u) const { return (const char*)B + (unsigned)u.pn * (unsigned)(BM * D * 2); }
    __device__ __forceinline__ int arow(const Unit&, int) const { return 0; }
    __device__ __forceinline__ void epi(const AccT& acc, const Unit& u, int wr, int wc, int fr, int fq) const {
        bf16_t* base; int Lrow;
        if (u.pn < 256) { const int b = u.pn >> 4; base = UT + (size_t)b * UCH * SEQ + (u.pn & 15) * 256; Lrow = SEQ; }
        else { const int b = u.pn - 256; base = UTc + (size_t)b * UCH * LCTX; Lrow = LCTX; }
        const int ch0 = u.pm * BM + wr * 64 + fr, c0 = wc * 32 + 8 * fq;
#pragma unroll
        for (int ai = 0; ai < 2; ++ai)
#pragma unroll
            for (int m = 0; m < 4; ++m) { bf16_t* rowp = base + (size_t)(ch0 + ai * HALF + m * 16) * Lrow + c0;
#pragma unroll
                for (int bj = 0; bj < 2; ++bj) { const f32x4 v0 = acc[ai][bj][m][0], v1 = acc[ai][bj][m][1];
                    u32x4 w; w.x = cvt_pk_bf16(v0[0], v0[1]); w.y = cvt_pk_bf16(v0[2], v0[3]); w.z = cvt_pk_bf16(v1[0], v1[1]); w.w = cvt_pk_bf16(v1[2], v1[3]);
                    *(u32x4*)(rowp + bj * HALF) = w; } }
    }
};

struct PolF {
    static constexpr bool PERM = true, GATHER = false, FP8 = false; static constexpr int EREP = 1;
    TileOrder S; const bf16_t* DFT; const bf16_t* ZT; bf16_t* MIX; int K, L, tpb  , rowbase; unsigned zstride  ; float scale;
    __device__ __forceinline__ bool next(int i, Unit& u) const { return S.next(i, u); }
    __device__ __forceinline__ const char* abase(const Unit& u) const { return (const char*)DFT + (unsigned)(u.pm % tpb) * (unsigned)(BM * K * 2); }
    __device__ __forceinline__ const char* bbase(const Unit& u) const { return (const char*)ZT + ((unsigned)(u.pm / tpb) * zstride + (unsigned)u.pn * (unsigned)(BM * K)) * 2u; }
    __device__ __forceinline__ int arow(const Unit&, int) const { return 0; }
    __device__ __forceinline__ void epi(const AccT& acc, const Unit& u, int wr, int wc, int fr, int fq) const {
        const int b = u.pm / tpb, kt = u.pm % tpb;
        const int row0 = rowbase + b * L + kt * BM + wr * 64 + fr, c0 = u.pn * BM + wc * 32 + 8 * fq;
#pragma unroll
        for (int ai = 0; ai < 2; ++ai)
#pragma unroll
            for (int m = 0; m < 4; ++m) { bf16_t* rowp = MIX + (size_t)(row0 + ai * HALF + m * 16) * D + c0;
#pragma unroll
                for (int bj = 0; bj < 2; ++bj) { const f32x4 v0 = acc[ai][bj][m][0] * scale, v1 = acc[ai][bj][m][1] * scale;
                    u32x4 w; w.x = cvt_pk_bf16(v0[0], v0[1]); w.y = cvt_pk_bf16(v0[2], v0[3]); w.z = cvt_pk_bf16(v1[0], v1[1]); w.w = cvt_pk_bf16(v1[2], v1[3]);
                    *(u32x4*)(rowp + bj * HALF) = w; } }
    }
};

template <bool F8, bool X16IN>
struct PolR {
    static constexpr bool PERM = true, GATHER = false, FP8 = F8; static constexpr int EREP = 1;
    static constexpr int ES = F8 ? 1 : 2;
    TileOrder S; const void* A; const void* B; int K; const float* srcL; bf16_t* XB; const float* srcC; float* dstC; const float* gate  ;
    __device__ __forceinline__ bool next(int i, Unit& u) const { return S.next(i, u); }
    __device__ __forceinline__ const char* abase(const Unit& u) const { return (const char*)A + (size_t)((unsigned)u.pm * (unsigned)(BM * ES)) * (unsigned)K; }
    __device__ __forceinline__ const char* bbase(const Unit& u) const { return (const char*)B + (unsigned)u.pn * (unsigned)(BM * K * ES); }
    __device__ __forceinline__ int arow(const Unit&, int) const { return 0; }
    __device__ __forceinline__ void epi(const AccT& acc, const Unit& u, int wr, int wc, int fr, int fq) const {
        const bool lat = u.pm < 256;
        const float* gp = gate + (size_t)(lat ? (u.pm >> 4) : 16) * NMOD;
        const int row0 = wr * 64 + fr, col0 = u.pn * BM + wc * 32 + 8 * fq;
        constexpr float gs = F8 ? 1.0f / (F8_HID * F8_W) : 1.0f;
        f32x4 gv[2][2];
#pragma unroll
        for (int bj = 0; bj < 2; ++bj)
#pragma unroll
            for (int n = 0; n < 2; ++n) gv[bj][n] = *(const f32x4*)(gp + col0 + bj * HALF + n * 4) * gs;
        if (lat) {
            bf16_t* xbt = XB + (size_t)u.pm * BM * D; const float* srt = X16IN ? nullptr : srcL + (size_t)u.pm * BM * D;
#pragma unroll
            for (int ai = 0; ai < 2; ++ai)
#pragma unroll
                for (int m = 0; m < 4; ++m) { const unsigned ro = (unsigned)((row0 + ai * HALF + m * 16) * D + col0);
#pragma unroll
                    for (int bj = 0; bj < 2; ++bj) { f32x4 x0, x1;
                        if constexpr (X16IN) { const u32x4 w = *(const u32x4*)(xbt + ro + bj * HALF); x0 = (f32x4){bflo(w.x), bfhi(w.x), bflo(w.y), bfhi(w.y)}; x1 = (f32x4){bflo(w.z), bfhi(w.z), bflo(w.w), bfhi(w.w)}; }
                        else { x0 = *(const f32x4*)(srt + ro + bj * HALF); x1 = *(const f32x4*)(srt + ro + bj * HALF + 4); }
                        x0 += gv[bj][0] * acc[ai][bj][m][0]; x1 += gv[bj][1] * acc[ai][bj][m][1];
                        u32x4 o; o.x = cvt_pk_bf16(x0[0], x0[1]); o.y = cvt_pk_bf16(x0[2], x0[3]); o.z = cvt_pk_bf16(x1[0], x1[1]); o.w = cvt_pk_bf16(x1[2], x1[3]);
                        *(u32x4*)(xbt + ro + bj * HALF) = o; } }
        } else {
            const size_t t0 = (size_t)(u.pm - 256) * BM * D;
#pragma unroll
            for (int ai = 0; ai < 2; ++ai)
#pragma unroll
                for (int m = 0; m < 4; ++m) { const unsigned ro = (unsigned)t0 + (unsigned)((row0 + ai * HALF + m * 16) * D + col0);
#pragma unroll
                    for (int bj = 0; bj < 2; ++bj)
#pragma unroll
                        for (int n = 0; n < 2; ++n) { const f32x4 x = *(const f32x4*)(srcC + ro + bj * HALF + n * 4);
                            *(f32x4*)(dstC + ro + bj * HALF + n * 4) = x + gv[bj][n] * acc[ai][bj][m][n]; } }
        }
    }
};

template <bool GATH, class ORD, bool F8, bool O8 = F8>
struct PolG {
    static constexpr bool PERM = true, GATHER = GATH, FP8 = F8; static constexpr int EREP = GATH ? EREP_GM : EREP_G;
    static constexpr int ES = F8 ? 1 : 2;
    ORD S; const void* A; const void* B; void* H; const int* tok; const int* tile_e; int tile0;
    __device__ __forceinline__ bool next(int i, Unit& u) const { return S.next(i, u); }
    __device__ __forceinline__ const char* abase(const Unit& u) const { return GATH ? (const char*)A : (const char*)A + (unsigned)u.pm * (unsigned)(BM * D * ES); }
    __device__ __forceinline__ const char* bbase(const Unit& u) const { const unsigned e = GATH ? (unsigned)tile_e[tile0 + u.pm] : 0u; return (const char*)B + (e * (unsigned)(2 * DFF) + (unsigned)u.pn * BM) * (unsigned)(D * ES); }
    __device__ __forceinline__ int arow(const Unit& u, int r) const { return tok[(tile0 + u.pm) * BM + r]; }
    __device__ __forceinline__ void epi(const AccT& acc, const Unit& u, int wr, int wc, int fr, int fq) const {
        const int row0 = u.pm * BM + wr * 64 + fr, c0 = u.pn * HALF + wc * 32 + 8 * fq;
        constexpr float isc = F8 ? 1.0f / (F8_ACT * F8_W) : 1.0f;
#pragma unroll
        for (int ai = 0; ai < 2; ++ai)
#pragma unroll
            for (int m = 0; m < 4; ++m) {
                float h[8];
#pragma unroll
                for (int n = 0; n < 2; ++n)
#pragma unroll
                    for (int j = 0; j < 4; ++j) { const float g = acc[ai][0][m][n][j] * isc, up = acc[ai][1][m][n][j] * isc; h[n * 4 + j] = silu_f(g) * up; }
                const size_t ro = (size_t)(row0 + ai * HALF + m * 16) * DFF + c0;
                if constexpr (O8) { u32x2 w; w.x = pk4_fp8(h[0] * F8_HID, h[1] * F8_HID, h[2] * F8_HID, h[3] * F8_HID); w.y = pk4_fp8(h[4] * F8_HID, h[5] * F8_HID, h[6] * F8_HID, h[7] * F8_HID);
                    *(u32x2*)((fp8_t*)H + ro) = w; }
                else { u32x4 w; w.x = cvt_pk_bf16(h[0], h[1]); w.y = cvt_pk_bf16(h[2], h[3]); w.z = cvt_pk_bf16(h[4], h[5]); w.w = cvt_pk_bf16(h[6], h[7]);
                    *(u32x4*)((bf16_t*)H + ro) = w; } }
    }
};

constexpr int NQK_UNITS = (MROWS / BM) * 5;
constexpr float QSCALE = 0.18033688011112042f;
struct PolQKV {
    static constexpr bool PERM = false, GATHER = false, FP8 = false; static constexpr int EREP = EREP_QKV;
    TileOrder S; const bf16_t* HX; const bf16_t* W; unsigned char* ws; const float* qkg  ; const float* ropec; const float* ropes;
    __device__ __forceinline__ bool next(int i, Unit& u) const {
        const int L = i * S.G + S.c;
        if (L < NQK_UNITS) return S.next(i, u);
        if (L < NQK_UNITS + MROWS / BM) { u.pm = L - NQK_UNITS; u.pn = 5; return true; }
        return false;
    }
    __device__ __forceinline__ const char* abase(const Unit& u) const { return u.pn == 5 ? (const char*)W + (unsigned)(1280 * D * 2) : (const char*)HX + (unsigned)u.pm * (unsigned)(BM * D * 2); }
    __device__ __forceinline__ const char* bbase(const Unit& u) const { return u.pn == 5 ? (const char*)HX + (unsigned)u.pm * (unsigned)(BM * D * 2) : (const char*)W + (unsigned)u.pn * (unsigned)(BM * D * 2); }
    __device__ __forceinline__ int arow(const Unit&, int) const { return 0; }
    __device__ __forceinline__ void epi(const AccT& acc, const Unit& u, int wr, int wc, int fr, int fq) const {
        if (u.pn == 5) {
            const bool lat = u.pm < 256;
            bf16_t* base = (bf16_t*)(ws + OFF_V) + (lat ? (size_t)(u.pm >> 4) * 256 * SEQ + (u.pm & 15) * 256 : (size_t)NB * 256 * SEQ + (size_t)(u.pm - 256) * 256 * LCTX);
            const int Lrow = lat ? SEQ : LCTX;
            const int f0 = wr * 64 + fr, p0 = wc * 32 + 8 * (fq & 1) + 4 * (fq >> 1);
#pragma unroll
            for (int ai = 0; ai < 2; ++ai)
#pragma unroll
                for (int m = 0; m < 4; ++m) { bf16_t* rowp = base + (size_t)(f0 + ai * HALF + m * 16) * Lrow + p0;
#pragma unroll
                    for (int bj = 0; bj < 2; ++bj)
#pragma unroll
                        for (int n = 0; n < 2; ++n) { const f32x4 v = acc[ai][bj][m][n]; u32x2 w; w.x = cvt_pk_bf16(v[0], v[1]); w.y = cvt_pk_bf16(v[2], v[3]);
                            *(u32x2*)(rowp + bj * HALF + n * 16) = w; } }
            return;
        }
        const int tile = u.pn; const bool ctxrow = u.pm >= 256;
        if (tile < 4 && ctxrow) return;
        const float* gsrc = qkg + (tile < 4 ? 0 : 64);
        const float osc = tile < 4 ? QSCALE : 1.0f;
        f32x4 gv[2][2];
#pragma unroll
        for (int bj = 0; bj < 2; ++bj)
#pragma unroll
            for (int n = 0; n < 2; ++n) gv[bj][n] = *(const f32x4*)(gsrc + 32 * bj + 16 * n + 4 * fq);
#pragma unroll
        for (int ai = 0; ai < 2; ++ai)
#pragma unroll
            for (int m = 0; m < 4; ++m) {
                const int r = u.pm * BM + ai * HALF + wr * 64 + m * 16 + fr;
                f32x4 v[2][2];
#pragma unroll
                for (int bj = 0; bj < 2; ++bj)
#pragma unroll
                    for (int n = 0; n < 2; ++n) v[bj][n] = acc[ai][bj][m][n];
                float ss = 0.f;
#pragma unroll
                for (int bj = 0; bj < 2; ++bj)
#pragma unroll
                    for (int n = 0; n < 2; ++n) ss += v[bj][n][0] * v[bj][n][0] + v[bj][n][1] * v[bj][n][1] + v[bj][n][2] * v[bj][n][2] + v[bj][n][3] * v[bj][n][3];
                ss += __shfl_xor(ss, 16); ss += __shfl_xor(ss, 32);
                const float rs = rsqrtf(ss * (1.0f / 64.0f) + EPS) * osc;
#pragma unroll
                for (int bj = 0; bj < 2; ++bj)
#pragma unroll
                    for (int n = 0; n < 2; ++n) v[bj][n] = v[bj][n] * rs * gv[bj][n];
                if (!ctxrow) {
                    const int l = r & (SEQ - 1), prow = l >> 6, pcol = l & 63;
#pragma unroll
                    for (int bj = 0; bj < 2; ++bj) { const int pp = bj ? pcol : prow;
                        const f32x4 cs = *(const f32x4*)(ropec + pp * 16 + 4 * fq), sn = *(const f32x4*)(ropes + pp * 16 + 4 * fq);
                        const f32x4 s1 = v[bj][0], s2 = v[bj][1];
                        v[bj][0] = s1 * cs - s2 * sn; v[bj][1] = s1 * sn + s2 * cs; }
                }
                const size_t doff = tile < 4 ? OFF_Q + ((size_t)r * D + (tile * 4 + wc) * 64) * 2 : OFF_K + ((size_t)r * 256 + wc * 64) * 2;
                bf16_t* dst = (bf16_t*)(ws + doff);
#pragma unroll
                for (int bj = 0; bj < 2; ++bj)
#pragma unroll
                    for (int n = 0; n < 2; ++n) { u32x2 w; w.x = cvt_pk_bf16(v[bj][n][0], v[bj][n][1]); w.y = cvt_pk_bf16(v[bj][n][2], v[bj][n][3]);
                        *(u32x2*)(dst + 32 * bj + 16 * n + 4 * fq) = w; }
            }
    }
};

struct PolD {
    static constexpr bool PERM = true, GATHER = false, FP8 = true; static constexpr int EREP = EREP_D;
    LinOrder<4> S; const fp8_t* A; const fp8_t* B; bf16_t* Y; const float* gw; const int* tile_e; int tile0;
    __device__ __forceinline__ bool next(int i, Unit& u) const { return S.next(i, u); }
    __device__ __forceinline__ const char* abase(const Unit& u) const { return (const char*)A + (size_t)(unsigned)u.pm * (size_t)(BM * DFF); }
    __device__ __forceinline__ const char* bbase(const Unit& u) const { const unsigned e = (unsigned)tile_e[tile0 + u.pm]; return (const char*)B + (e * (unsigned)D + (unsigned)u.pn * BM) * (unsigned)DFF; }
    __device__ __forceinline__ int arow(const Unit&, int) const { return 0; }
    __device__ __forceinline__ void epi(const AccT& acc, const Unit& u, int wr, int wc, int fr, int fq) const {
        const int slot0 = (tile0 + u.pm) * BM + wr * 64 + fr, c0 = u.pn * BM + wc * 32 + 8 * fq;
#pragma unroll
        for (int ai = 0; ai < 2; ++ai)
#pragma unroll
            for (int m = 0; m < 4; ++m) { const int slot = slot0 + ai * HALF + m * 16; const float g = gw[slot] * (1.0f / (F8_HID * F8_W)); bf16_t* rowp = Y + (size_t)slot * D + c0;
#pragma unroll
                for (int bj = 0; bj < 2; ++bj) { const f32x4 v0 = acc[ai][bj][m][0] * g, v1 = acc[ai][bj][m][1] * g;
                    u32x4 w; w.x = cvt_pk_bf16(v0[0], v0[1]); w.y = cvt_pk_bf16(v0[2], v0[3]); w.z = cvt_pk_bf16(v1[0], v1[1]); w.w = cvt_pk_bf16(v1[2], v1[3]);
                    *(u32x4*)(rowp + bj * HALF) = w; } }
    }
};

enum { RM_OFF = 0, RM_GU_G = 1, RM_GU_U = 2, RM_QKV = 3 };
template <int RM> __device__ __forceinline__ int rowmap(int n, int off) {
    if (RM == RM_GU_G) return (n >> 7) * 256 + (n & 127);
    if (RM == RM_GU_U) return (n >> 7) * 256 + 128 + (n & 127);
    if (RM == RM_QKV) { const int tile = n >> 8, f = n & 255, hh = f >> 6, d = f & 63, bj = d >> 5, q = d & 31; return tile * 256 + 128 * bj + 32 * hh + q; }
    return n + off;
}
template <int RM>
__device__ __forceinline__ void tconv(const float* __restrict__ src, int Ks, int ldn, int c0, int ncols, bf16_t* __restrict__ dst, int off, LAS unsigned char* lds, int start, int stride) {
    LAS bf16_t* T = (LAS bf16_t*)lds;
    const int tid = otid(), nkt = Ks >> 6, ntile = nkt * (ncols >> 6);
    for (int t = start; t < ntile; t += stride) {
        const int kt = t % nkt, ntl = t / nkt, k0 = kt * 64, n0 = ntl * 64;
        const int kk = tid >> 4, n4 = (tid & 15) * 4;
#pragma unroll
        for (int i = 0; i < 2; ++i) { const int k = kk + 32 * i;
            const f32x4 v = *(const f32x4*)(src + (size_t)(k0 + k) * ldn + c0 + n0 + n4);
#pragma unroll
            for (int j = 0; j < 4; ++j) T[(n4 + j) * 72 + k] = f2bf(v[j]); }
        __syncthreads();
        { const int n = tid >> 3, k8 = (tid & 7) * 8;
          const u32x4 w = *(const LAS u32x4*)(T + n * 72 + k8);
          *(u32x4*)(dst + (size_t)rowmap<RM>(n0 + n, off) * Ks + k0 + k8) = w; }
        __syncthreads();
    }
}

template <int RM>
__device__ __forceinline__ void tconv8(const float* __restrict__ src, int Ks, int ldn, int c0, int ncols, fp8_t* __restrict__ dst, int off, LAS unsigned char* lds, int start, int stride) {
    LAS fp8_t* T = (LAS fp8_t*)lds;
    const int tid = otid(), nkt = Ks >> 6, ntile = nkt * (ncols >> 6);
    for (int t = start; t < ntile; t += stride) {
        const int kt = t % nkt, ntl = t / nkt, k0 = kt * 64, n0 = ntl * 64;
        const int kk = tid >> 4, n4 = (tid & 15) * 4;
#pragma unroll
        for (int i = 0; i < 2; ++i) { const int k = kk + 32 * i;
            const f32x4 v = *(const f32x4*)(src + (size_t)(k0 + k) * ldn + c0 + n0 + n4);
            const unsigned w = pk4_fp8(v[0] * F8_W, v[1] * F8_W, v[2] * F8_W, v[3] * F8_W);
#pragma unroll
            for (int j = 0; j < 4; ++j) T[(n4 + j) * 80 + k] = (fp8_t)(w >> (8 * j)); }
        __syncthreads();
        if (tid < 256) { const int n = tid >> 2, k16 = (tid & 3) * 16;
          const u32x4 w = *(const LAS u32x4*)(T + n * 80 + k16);
          *(u32x4*)(dst + (size_t)rowmap<RM>(n0 + n, off) * Ks + k0 + k16) = w; }
        __syncthreads();
    }
}

template <int RM>
__device__ __forceinline__ void tconv8_tile(const float* __restrict__ src, int Ks, int ldn, fp8_t* __restrict__ dst, LAS unsigned char* lds, int t) {
    LAS fp8_t* T = (LAS fp8_t*)lds;
    const int tid = otid(), nkt = Ks >> 6;
    const int kt = t % nkt, ntl = t / nkt, k0 = kt * 64, n0 = ntl * 64;
    const int kk = tid >> 4, n4 = (tid & 15) * 4;
#pragma unroll
    for (int i = 0; i < 2; ++i) { const int k = kk + 32 * i;
        const f32x4 v = *(const f32x4*)(src + (size_t)(k0 + k) * ldn + n0 + n4);
        const unsigned w = pk4_fp8(v[0] * F8_W, v[1] * F8_W, v[2] * F8_W, v[3] * F8_W);
#pragma unroll
        for (int j = 0; j < 4; ++j) T[(n4 + j) * 80 + k] = (fp8_t)(w >> (8 * j)); }
    __syncthreads();
    if (tid < 256) { const int n = tid >> 2, k16 = (tid & 3) * 16;
      const u32x4 w = *(const LAS u32x4*)(T + n * 80 + k16);
      *(u32x4*)(dst + (size_t)rowmap<RM>(n0 + n, 0) * Ks + k0 + k16) = w; }
    __syncthreads();
}
constexpr int MOE_CONV_TILES = NE * 2688;
struct CvJob { const float* src; fp8_t* dst; int ldn, Ks, rm, n0; };
__device__ __forceinline__ CvJob cv_decode(int q, const float* __restrict__ wg, const float* __restrict__ wu, const float* __restrict__ wd, fp8_t* __restrict__ MGU, fp8_t* __restrict__ MD) {
    CvJob j; const int e = q / 2688, r = q - e * 2688; int kt, ntl;
    if (r < 1792) { const int up = r >= 896, t = r - (up ? 896 : 0); j.src = (up ? wu : wg) + (size_t)e * D * DFF; j.dst = MGU + (size_t)e * 2 * DFF * D; j.ldn = DFF; j.Ks = 1024; j.rm = 1 + up; kt = t & 15; ntl = t >> 4; }
    else { const int t = r - 1792; j.src = wd + (size_t)e * DFF * D; j.dst = MD + (size_t)e * D * DFF; j.ldn = 1024; j.Ks = DFF; j.rm = 0; kt = t % 56; ntl = t / 56; }
    j.n0 = ntl * 64; j.src += (size_t)(kt * 64) * j.ldn + j.n0; j.dst += kt * 64;
    return j;
}
__device__ __forceinline__ void moe_conv_groups(const float* __restrict__ wg, const float* __restrict__ wu, const float* __restrict__ wd, fp8_t* __restrict__ MGU, fp8_t* __restrict__ MD,
                                                LAS unsigned char* lds, int gb, int ge, int gs) {
    if (gb >= ge) return;
    const int tid = otid(), kk = tid >> 4, n4 = (tid & 15) * 4;
    f32x4 v[8], vn[8];
    CvJob cj = cv_decode(4 * gb, wg, wu, wd, MGU, MD), nj = cj;
    { const float* p = cj.src + (size_t)(8 * kk) * cj.ldn + n4;
#pragma unroll
      for (int i = 0; i < 8; ++i) v[i] = *(const f32x4*)(p + (size_t)i * cj.ldn); }
    for (int g = gb; g < ge; g += gs) {
        const bool more = g + gs < ge;
        if (more) { nj = cv_decode(4 * (g + gs), wg, wu, wd, MGU, MD); const float* p = nj.src + (size_t)(8 * kk) * nj.ldn + n4;
#pragma unroll
            for (int i = 0; i < 8; ++i) vn[i] = *(const f32x4*)(p + (size_t)i * nj.ldn); }
#pragma unroll
        for (int j = 0; j < 4; ++j) { u32x2 w; w.x = pk4_fp8(v[0][j] * F8_W, v[1][j] * F8_W, v[2][j] * F8_W, v[3][j] * F8_W); w.y = pk4_fp8(v[4][j] * F8_W, v[5][j] * F8_W, v[6][j] * F8_W, v[7][j] * F8_W);
            *(LAS u32x2*)(lds + (n4 + j) * 272 + 8 * kk) = w; }
        __syncthreads();
#pragma unroll
        for (int i2 = 0; i2 < 2; ++i2) { const int n = (tid >> 4) + 32 * i2, k16 = (tid & 15) * 16, nn = cj.n0 + n;
            const u32x4 w = *(const LAS u32x4*)(lds + n * 272 + k16);
            const int orow = cj.rm == 0 ? nn : ((nn >> 7) * 256 + (nn & 127) + (cj.rm == 2 ? 128 : 0));
            *(u32x4*)(cj.dst + (size_t)orow * cj.Ks + k16) = w; }
        __syncthreads();
        if (more) { cj = nj;
#pragma unroll
            for (int i = 0; i < 8; ++i) v[i] = vn[i]; }
    }
}

__device__ __forceinline__ void fold_job(const float* __restrict__ w_in, bf16_t* __restrict__ WinT, LAS unsigned char* lds) {
    LAS float* W = (LAS float*)lds;
    LAS float* cs = W + 1024; LAS float* sn = cs + 128;
    const int tid = otid();
    if (tid < 128) { cs[tid] = cospif((float)tid / 64.0f); sn[tid] = sinpif((float)tid / 64.0f); }
    for (int it = blockIdx.x; it < 512; it += gridDim.x) {
        const int kb = it >> 2, g = it & 3;
        __syncthreads();
        { const int r = tid >> 6, c2 = (tid & 63) * 2; const f32x2 v = *(const f32x2*)(w_in + (size_t)(kb * 8 + r) * 2048 + g * 128 + c2); W[r * 128 + c2] = v.x; W[r * 128 + c2 + 1] = v.y; }
        __syncthreads();
        const int m = tid & 127, part = (tid >> 7) & 1, rh = tid >> 8;
        float a0 = 0.f, a1 = 0.f, a2 = 0.f, a3 = 0.f;
        for (int d = 0; d < 128; ++d) { const int idx = (m * d) & 127; const float tw = part ? sn[idx] : cs[idx];
            a0 += W[(rh * 4 + 0) * 128 + d] * tw; a1 += W[(rh * 4 + 1) * 128 + d] * tw; a2 += W[(rh * 4 + 2) * 128 + d] * tw; a3 += W[(rh * 4 + 3) * 128 + d] * tw; }
        u32x2 w; w.x = cvt_pk_bf16(a0, a1); w.y = cvt_pk_bf16(a2, a3);
        *(u32x2*)(WinT + (size_t)(2 * (g * 128 + m) + part) * D + kb * 8 + rh * 4) = w;
    }
    __syncthreads();
}

__device__ __forceinline__ void dft_job(bf16_t* __restrict__ DFTc, float* __restrict__ TW, LAS unsigned char* lds) {
    const int tid = otid();
    for (int idx = blockIdx.x * 512 + tid; idx < 256 * 512; idx += gridDim.x * 512) {
        const int k = idx >> 9, lp = idx & 511, kl = (k * (lp & 255)) & 255;
        const float v = lp < 256 ? cospif((float)kl / 128.0f) : -sinpif((float)kl / 128.0f);
        DFTc[idx] = f2bf(v);
    }
    for (int idx = blockIdx.x * 512 + tid; idx < 4096; idx += gridDim.x * 512) {
        const int l2 = idx >> 6, k1 = idx & 63; const float a = (float)(k1 * l2) / 2048.0f;
        TW[idx] = cospif(a); TW[4096 + idx] = sinpif(a);
    }
}

__device__ __forceinline__ void ada_job(const float* __restrict__ c, const float* __restrict__ c_ctx, const float* __restrict__ ada_w, const float* __restrict__ ada_b, float* __restrict__ MOD, LAS unsigned char* lds) {
    LAS float* sc = (LAS float*)lds;
    LAS float* red = sc + 17 * 1024;
    const int tid = otid();
    for (int i = tid; i < 17 * 1024; i += 512) { const float x = i < 16 * 1024 ? c[i] : c_ctx[i - 16 * 1024]; sc[i] = silu_f(x); }
    __syncthreads();
    for (int chunk = blockIdx.x; chunk < 256; chunk += gridDim.x) {
        const int layer = chunk >> 7, n0 = (chunk & 127) * 48;
        const float* wp = ada_w + (size_t)layer * D * NMOD + n0;
        const int col = tid % 48, kg = tid / 48;
        if (kg < 10) {
            float a[17];
#pragma unroll
            for (int r = 0; r < 17; ++r) a[r] = 0.f;
            for (int k = kg; k < D; k += 80) { float w8[8];
#pragma unroll
                for (int u = 0; u < 8; ++u) { const int kk = k + 10 * u; w8[u] = kk < D ? wp[(size_t)kk * NMOD + col] : 0.f; }
#pragma unroll
                for (int u = 0; u < 8; ++u) { const int kk = k + 10 * u; if (kk < D) {
#pragma unroll
                    for (int r = 0; r < 17; ++r) a[r] += sc[r * 1024 + kk] * w8[u]; } } }
#pragma unroll
            for (int r = 0; r < 17; ++r) red[(kg * 17 + r) * 48 + col] = a[r];
        }
        __syncthreads();
        for (int o = tid; o < 17 * 48; o += 512) { const int r = o / 48, cc = o % 48; float s = ada_b[layer * NMOD + n0 + cc];
#pragma unroll
            for (int g = 0; g < 10; ++g) s += red[(g * 17 + r) * 48 + cc];
            MOD[((size_t)layer * 17 + r) * NMOD + n0 + cc] = s; }
        __syncthreads();
    }
}

__device__ __forceinline__ void h3_job(const float* __restrict__ w0, const float* __restrict__ b0, const float* __restrict__ w1, const float* __restrict__ b1,
                                       const float* __restrict__ w2, const float* __restrict__ b2, const float* __restrict__ freq, float* __restrict__ H3) {
    const int tid = otid(), lane = tid & 63, wv = blockIdx.x * 8 + (tid >> 6), nw = gridDim.x * 8;
    const float fr = freq[lane];
    for (int p = wv; p < 4352; p += nw) {
        const int L = p < 4096 ? 4096 : 256, pos = p < 4096 ? p : p - 4096;
        const float t = (float)pos / (float)(L - 1);
        const float w = (float)(2.0 * 3.14159265358979323846 / (double)L) * (float)pos;
        const float band = 1e-4f + (float)(lane & 15) * ((15.0f - 1e-4f) / 15.0f);
        const float ang = w * band;
        const float cz = cosf(ang), sz = -sinf(ang);
        float a = t * w0[lane] + b0[lane];
#pragma unroll
        for (int b = 0; b < 16; ++b) a += __shfl(cz, b) * w0[(1 + b) * 64 + lane] + __shfl(sz, b) * w0[(17 + b) * 64 + lane];
        const float h1 = sinf(fr * a);
        float a2 = b1[lane];
#pragma unroll 8
        for (int i = 0; i < 64; ++i) a2 += __shfl(h1, i) * w1[i * 64 + lane];
        const float h2 = sinf(fr * a2);
        float a3 = b2[lane];
#pragma unroll 8
        for (int i = 0; i < 64; ++i) a3 += __shfl(h2, i) * w2[i * 64 + lane];
        H3[(size_t)p * 64 + lane] = sinf(fr * a3);
    }
}

template <int L>
__device__ __forceinline__ void filt_fin(const float* __restrict__ H3, const float* __restrict__ w3, float* __restrict__ KFo, int cp, LAS unsigned char* lds) {
    LAS float* F = (LAS float*)lds;
    LAS float* Bk = F + 2 * L;
    LAS float* w3c = Bk + 2 * L;
    LAS float* red = w3c + 256;
    const int tid = otid(), lane = tid & 63, wid = tid >> 6;
    const int c0 = cp * 2;
    __syncthreads();
    if (tid < 256) { const int which = tid & 3, j = tid >> 2; w3c[tid] = w3[(size_t)j * 1024 + (which >> 1) * 512 + c0 + (which & 1)]; }
    __syncthreads();
    const float la = -3.0701134573253945f, lb = -15.350567286626973f;
    float dl[2];
#pragma unroll
    for (int cc = 0; cc < 2; ++cc) dl[cc] = fabsf(la + (float)(c0 + cc) * ((lb - la) / 511.0f));
    float ss0 = 0.f, ss1 = 0.f;
    for (int pos = tid; pos < L; pos += 512) {
        const float* hp = H3 + (size_t)pos * 64;
        asm volatile("" ::: "memory");
        f32x4 sv = (f32x4){0.f, 0.f, 0.f, 0.f};
#pragma unroll 4
        for (int j4 = 0; j4 < 16; ++j4) { const f32x4 h = *(const f32x4*)(hp + j4 * 4);
#pragma unroll
            for (int e = 0; e < 4; ++e) sv += h[e] * *(const LAS f32x4*)(w3c + (j4 * 4 + e) * 4); }
        const float s[4] = {sv[0], sv[1], sv[2], sv[3]};
        const float t = (float)pos / (float)(L - 1);
        const float d0 = __expf(-t * dl[0]), d1 = __expf(-t * dl[1]);
        const float f0 = s[0] * d0, f1 = s[1] * d1, g0 = s[2] * d0, g1 = s[3] * d1;
        F[pos] = f0; F[L + pos] = f1; Bk[pos] = g0; Bk[L + pos] = g1;
        ss0 += f0 * f0 + (pos >= 1 ? g0 * g0 : 0.f); ss1 += f1 * f1 + (pos >= 1 ? g1 * g1 : 0.f);
    }
    ss0 = wave_sum(ss0); ss1 = wave_sum(ss1);
    if (lane == 0) { red[wid] = ss0; red[8 + wid] = ss1; }
    __syncthreads();
    float n0 = 0.f, n1 = 0.f;
#pragma unroll
    for (int i = 0; i < 8; ++i) { n0 += red[i]; n1 += red[8 + i]; }
    const float nr[2] = {rsqrtf(n0 + EPS), rsqrtf(n1 + EPS)};
    if constexpr (L == SEQ) {
        bf16_t* RC = (bf16_t*)KFo;
#pragma unroll
        for (int cc = 0; cc < 2; ++cc)
            for (int i2 = tid; i2 < 4 * 4096; i2 += 512) { const int m = i2 >> 12, idx = (i2 & 4095) * 2; float v[2];
#pragma unroll
                for (int e = 0; e < 2; ++e) { const int d = L + m - (idx + e);
                    v[e] = (d >= L || d <= -L) ? 0.f : (d >= 0 ? F[cc * L + d] : Bk[cc * L - d]) * nr[cc]; }
                *(unsigned*)(RC + ((size_t)(c0 + cc) * 4 + m) * 8192 + idx) = cvt_pk_bf16(v[0], v[1]); }
    } else {
#pragma unroll
        for (int cc = 0; cc < 2; ++cc)
            for (int idx = tid; idx < 2 * L; idx += 512) { const int d = idx - L;
                const float v = d >= 0 ? F[cc * L + d] : (d > -L ? Bk[cc * L - d] : 0.f);
                KFo[(size_t)(c0 + cc) * (2 * L) + idx] = v * nr[cc]; }
    }
    __syncthreads();
}

template <bool ROUTE, bool OUT8 = ROUTE, bool SRC16 = false>
__device__ __forceinline__ void norm_phase(const void* __restrict__ srcL_, const float* __restrict__ srcC, int nrows, const float* __restrict__ g, const float* __restrict__ modl  ,
                                           int shift_idx, bf16_t* __restrict__ HX, const float* __restrict__ wrt, unsigned* __restrict__ route, int* __restrict__ hist, LAS unsigned char* lds) {
    const int tid = otid(), lane = tid & 63, wid = tid >> 6;
    LAS int* lh = (LAS int*)lds;
    if (ROUTE) { if (tid < 8) lh[tid] = 0; __syncthreads(); }
    f32x4 rw[ROUTE ? 16 : 1][2];
    if constexpr (ROUTE) {
#pragma unroll
        for (int i = 0; i < 2; ++i)
#pragma unroll
            for (int q = 0; q < 2; ++q)
#pragma unroll
                for (int j = 0; j < 4; ++j) { const int k = i * 512 + lane * 8 + q * 4 + j; rw[(i * 2 + q) * 4 + j][0] = *(const f32x4*)(wrt + (size_t)k * 8); rw[(i * 2 + q) * 4 + j][1] = *(const f32x4*)(wrt + (size_t)k * 8 + 4); }
    }
    const int nwv = gridDim.x * 8, gw = blockIdx.x * 8 + wid, rpw = (nrows + nwv - 1) / nwv;
    const int r0 = gw * rpw, r1 = (r0 + rpw) < nrows ? (r0 + rpw) : nrows;
    f32x4 Am[4], Sh[4]; int curb = -1;
#pragma unroll
    for (int i = 0; i < 4; ++i) { Am[i] = (f32x4){0.f, 0.f, 0.f, 0.f}; Sh[i] = Am[i]; }
    f32x4 nraw[4];
#define NORM_LOAD(rr) do { if (SRC16 && (rr) < NTOK) { const bf16_t* xq_ = (const bf16_t*)srcL_ + (size_t)(rr) * D; \
            nraw[0] = __builtin_bit_cast(f32x4, *(const u32x4*)(xq_ + lane * 8)); nraw[1] = __builtin_bit_cast(f32x4, *(const u32x4*)(xq_ + 512 + lane * 8)); } \
        else { const float* xp_ = (rr) < NTOK ? (const float*)srcL_ + (size_t)(rr) * D : srcC + (size_t)((rr) - NTOK) * D; \
            nraw[0] = *(const f32x4*)(xp_ + lane * 8); nraw[1] = *(const f32x4*)(xp_ + lane * 8 + 4); nraw[2] = *(const f32x4*)(xp_ + 512 + lane * 8); nraw[3] = *(const f32x4*)(xp_ + 512 + lane * 8 + 4); } } while (0)
    if (r0 < r1) NORM_LOAD(r0);
    for (int r = r0; r < r1; ++r) {
        f32x4 x[4];
        if (SRC16 && r < NTOK) {
#pragma unroll
            for (int i = 0; i < 2; ++i) { const u32x4 w = __builtin_bit_cast(u32x4, nraw[i]);
                x[2 * i] = (f32x4){bflo(w.x), bfhi(w.x), bflo(w.y), bfhi(w.y)}; x[2 * i + 1] = (f32x4){bflo(w.z), bfhi(w.z), bflo(w.w), bfhi(w.w)}; }
        } else {
#pragma unroll
            for (int i = 0; i < 4; ++i) x[i] = nraw[i];
        }
        const int bidx = r < NTOK ? (r >> 12) : 16;
        if (bidx != curb) {
            curb = bidx; const float* mp = modl + (size_t)bidx * NMOD + shift_idx * D;
#pragma unroll
            for (int i = 0; i < 2; ++i)
#pragma unroll
                for (int q = 0; q < 2; ++q) { const int o = i * 512 + lane * 8 + q * 4;
                    Sh[2 * i + q] = *(const f32x4*)(mp + o); Am[2 * i + q] = *(const f32x4*)(g + o) * (1.0f + *(const f32x4*)(mp + D + o)); }
        }
        if (r + 1 < r1) NORM_LOAD(r + 1);
        float ss = 0.f;
#pragma unroll
        for (int i = 0; i < 4; ++i) ss += x[i][0] * x[i][0] + x[i][1] * x[i][1] + x[i][2] * x[i][2] + x[i][3] * x[i][3];
        ss = wave_sum(ss);
        const float rs = rsqrtf(ss * (1.0f / 1024.0f) + EPS);
        f32x4 h[4];
#pragma unroll
        for (int i = 0; i < 4; ++i) h[i] = (x[i] * rs) * Am[i] + Sh[i];
        if constexpr (OUT8) {
#pragma unroll
            for (int i = 0; i < 2; ++i) { u32x2 w; w.x = pk4_fp8(h[2 * i][0] * F8_ACT, h[2 * i][1] * F8_ACT, h[2 * i][2] * F8_ACT, h[2 * i][3] * F8_ACT);
                w.y = pk4_fp8(h[2 * i + 1][0] * F8_ACT, h[2 * i + 1][1] * F8_ACT, h[2 * i + 1][2] * F8_ACT, h[2 * i + 1][3] * F8_ACT);
                *(u32x2*)((fp8_t*)HX + (size_t)r * D + i * 512 + lane * 8) = w; }
        } else {
#pragma unroll
        for (int i = 0; i < 2; ++i) { u32x4 w; w.x = cvt_pk_bf16(h[2 * i][0], h[2 * i][1]); w.y = cvt_pk_bf16(h[2 * i][2], h[2 * i][3]); w.z = cvt_pk_bf16(h[2 * i + 1][0], h[2 * i + 1][1]); w.w = cvt_pk_bf16(h[2 * i + 1][2], h[2 * i + 1][3]);
            *(u32x4*)(HX + (size_t)r * D + i * 512 + lane * 8) = w; }
        }
        if (ROUTE) {
            float lg[8];
#pragma unroll
            for (int e = 0; e < 8; ++e) lg[e] = 0.f;
#pragma unroll
            for (int i = 0; i < 2; ++i)
#pragma unroll
                for (int q = 0; q < 2; ++q)
#pragma unroll
                    for (int j = 0; j < 4; ++j) { const float hv = h[2 * i + q][j];
                        const f32x4 wa = rw[(i * 2 + q) * 4 + j][0], wb = rw[(i * 2 + q) * 4 + j][1];
                        lg[0] += hv * wa[0]; lg[1] += hv * wa[1]; lg[2] += hv * wa[2]; lg[3] += hv * wa[3]; lg[4] += hv * wb[0]; lg[5] += hv * wb[1]; lg[6] += hv * wb[2]; lg[7] += hv * wb[3]; }
#pragma unroll
            for (int e = 0; e < 8; ++e) lg[e] = wave_sum(lg[e]);
            int e1 = 0; float v1 = lg[0];
#pragma unroll
            for (int e = 1; e < 8; ++e) if (lg[e] > v1) { v1 = lg[e]; e1 = e; }
            int e2 = -1; float v2 = -3.0e38f;
#pragma unroll
            for (int e = 0; e < 8; ++e) if (e != e1 && lg[e] > v2) { v2 = lg[e]; e2 = e; }
            const float g1 = 1.0f / (1.0f + __expf(v2 - v1)), g2 = 1.0f - g1;
            if (lane == 0) { u32x4 w; w.x = (unsigned)e1; w.y = (unsigned)e2; w.z = __float_as_uint(g1); w.w = __float_as_uint(g2); *(u32x4*)(route + (size_t)r * 4) = w;
                atomicAdd((int*)&lh[e1], 1); atomicAdd((int*)&lh[e2], 1); }
        }
    }
#undef NORM_LOAD
    if (ROUTE) { __syncthreads(); if (tid < 8) hist[blockIdx.x * 8 + tid] = lh[tid]; }
}

template <int L, int NBP>
__device__ __forceinline__ void hyena_pass(const bf16_t* __restrict__ UTb, bf16_t* __restrict__ HTb, int c, const float (&cw)[3][3], const float (&cb)[3], float bias,
                                           const LAS float* kf, LAS float* raw, LAS float* vx, LAS float* x0s) {
    const int tid = otid(), e0 = tid * 8, bb = e0 / L, t0 = e0 % L;
    constexpr int RS = L + 8;
#pragma unroll
    for (int j = 0; j < 3; ++j) {
        const u32x4 w = *(const u32x4*)(UTb + ((size_t)bb * UCH + 1024 + j * 512 + c) * L + t0);
        LAS float* rp = raw + (j * NBP + bb) * RS + 4 + t0;
        *(LAS f32x4*)rp = (f32x4){bflo(w.x), bfhi(w.x), bflo(w.y), bfhi(w.y)};
        *(LAS f32x4*)(rp + 4) = (f32x4){bflo(w.z), bfhi(w.z), bflo(w.w), bfhi(w.w)};
        if (t0 == 0) rp[-1] = 0.f;
        if (t0 == L - 8) rp[8] = 0.f;
    }
    __syncthreads();
    {
        float z[3][8];
#pragma unroll
        for (int j = 0; j < 3; ++j) { const LAS float* rp = raw + (j * NBP + bb) * RS + 4 + t0;
            float r[10];
#pragma unroll
            for (int i = 0; i < 10; ++i) r[i] = rp[i - 1];
#pragma unroll
            for (int i = 0; i < 8; ++i) z[j][i] = r[i] * cw[j][0] + r[i + 1] * cw[j][1] + r[i + 2] * cw[j][2] + cb[j]; }
#pragma unroll
        for (int i = 0; i < 8; ++i) { vx[bb * L + t0 + i] = z[0][i] * z[1][i]; x0s[bb * L + t0 + i] = z[2][i]; }
    }
    __syncthreads();
    float acc[8];
#pragma unroll
    for (int i = 0; i < 8; ++i) acc[i] = 0.f;
    for (int s0 = 0; s0 < L; s0 += 8) {
        const f32x4 va = *(const LAS f32x4*)(vx + bb * L + s0), vb = *(const LAS f32x4*)(vx + bb * L + s0 + 4);
        const float v[8] = {va[0], va[1], va[2], va[3], vb[0], vb[1], vb[2], vb[3]};
        const LAS float* kp = kf + (L + t0 - s0 - 8);
        float w[16];
#pragma unroll
        for (int q4 = 0; q4 < 4; ++q4) { const f32x4 t = *(const LAS f32x4*)(kp + q4 * 4); w[q4 * 4] = t[0]; w[q4 * 4 + 1] = t[1]; w[q4 * 4 + 2] = t[2]; w[q4 * 4 + 3] = t[3]; }
#pragma unroll
        for (int j = 0; j < 8; ++j)
#pragma unroll
            for (int i = 0; i < 8; ++i) acc[i] += w[8 + i - j] * v[j];
    }
    {
        float o[8];
#pragma unroll
        for (int i = 0; i < 8; ++i) o[i] = x0s[bb * L + t0 + i] * (acc[i] + bias * vx[bb * L + t0 + i]);
        u32x4 w; w.x = cvt_pk_bf16(o[0], o[1]); w.y = cvt_pk_bf16(o[2], o[3]); w.z = cvt_pk_bf16(o[4], o[5]); w.w = cvt_pk_bf16(o[6], o[7]);
        *(u32x4*)(HTb + ((size_t)bb * 512 + c) * L + t0) = w;
    }
    __syncthreads();
}

__device__ __forceinline__ unsigned f2_cs_byte(int r, int c) { return (unsigned)(r * 128 + ((((c >> 3) ^ ((r >> 1) & 7))) << 4) + (c & 7) * 2); }
__device__ __forceinline__ void f2_tr8(u32x2 (&o)[8], unsigned a0, unsigned a1, unsigned a2, unsigned a3, unsigned a4, unsigned a5, unsigned a6, unsigned a7) {
    asm volatile("ds_read_b64_tr_b16 %0, %8\n\tds_read_b64_tr_b16 %1, %9\n\tds_read_b64_tr_b16 %2, %10\n\tds_read_b64_tr_b16 %3, %11\n\t"
                 "ds_read_b64_tr_b16 %4, %12\n\tds_read_b64_tr_b16 %5, %13\n\tds_read_b64_tr_b16 %6, %14\n\tds_read_b64_tr_b16 %7, %15\n\ts_waitcnt lgkmcnt(0)"
                 : "=&v"(o[0]), "=&v"(o[1]), "=&v"(o[2]), "=&v"(o[3]), "=&v"(o[4]), "=&v"(o[5]), "=&v"(o[6]), "=&v"(o[7])
                 : "v"(a0), "v"(a1), "v"(a2), "v"(a3), "v"(a4), "v"(a5), "v"(a6), "v"(a7) : "memory");
}
__device__ __forceinline__ bf16x8 f2_frag(const u32x2& lo, const u32x2& hi) { return __builtin_bit_cast(bf16x8, (u32x4){lo.x, lo.y, hi.x, hi.y}); }
__device__ __forceinline__ bf16x8 f2_neg(const bf16x8& v) { u32x4 u = __builtin_bit_cast(u32x4, v); u.x ^= 0x80008000u; u.y ^= 0x80008000u; u.z ^= 0x80008000u; u.w ^= 0x80008000u; return __builtin_bit_cast(bf16x8, u); }

__device__ __forceinline__ void fourier2_phase(const bf16_t* __restrict__ UT, bf16_t* __restrict__ AT, const float* __restrict__ TW, LAS unsigned char* lds) {
    const int tid = otid(), lane = tid & 63, w = __builtin_amdgcn_readfirstlane(tid >> 6), r = lane & 31, h = lane >> 5;
    __syncthreads();
    for (int i = tid; i < 4096; i += 512) { const int rr = i >> 6, cc = i & 63; const float a = (float)((rr * cc) & 63) / 32.0f;
        *(LAS bf16_t*)(lds + f2_cs_byte(rr, cc)) = f2bf(cospif(a)); *(LAS bf16_t*)(lds + 8192 + f2_cs_byte(rr, cc)) = f2bf(sinpif(a)); }
    __syncthreads();
    LAS unsigned char* xr = lds + 16384 + w * 16384;
    const unsigned xb = (unsigned)(unsigned long)xr;
    const int q = (lane & 15) >> 2, pp = lane & 3, blk = (lane >> 4) & 1, qb = (q >> 1) & 1;
    const unsigned L0 = (unsigned)((8 * h + q) * 128 + (16 * blk + 4 * pp) * 2);
    const unsigned tb0 = xb + L0 + qb * 64, tb1 = xb + L0 + (1 - qb) * 64;
    const int nwv = gridDim.x * 8;
    for (int it = blockIdx.x * 8 + w; it < NB * 512; it += nwv) {
        const int b = it >> 9, m = it & 511;
        { const char* src = (const char*)(UT + ((size_t)b * UCH + 2 * m) * SEQ);
#pragma unroll
          for (int i = 0; i < 16; ++i) { const int row = (i & 7) * 8 + (lane >> 3), s2 = (lane & 7) ^ (4 * ((row >> 1) & 1));
              __builtin_amdgcn_global_load_lds((const unsigned*)(src + (i >> 3) * 8192 + (row * 64 + s2 * 8) * 2), (LAS unsigned*)(xr + i * 1024), 16, 0, 0); } }
        asm volatile("s_waitcnt vmcnt(0)" ::: "memory");
        f32x16 Yr[2][2], Yi[2][2];
#pragma unroll
        for (int a = 0; a < 2; ++a)
#pragma unroll
            for (int c = 0; c < 2; ++c)
#pragma unroll
                for (int e = 0; e < 16; ++e) { Yr[a][c][e] = 0.f; Yi[a][c][e] = 0.f; }
#pragma unroll
        for (int ks = 0; ks < 4; ++ks) {
            bf16x8 Cf[2], Sf[2];
#pragma unroll
            for (int kt = 0; kt < 2; ++kt) { const unsigned o = f2_cs_byte(32 * kt + r, 16 * ks + 8 * h); Cf[kt] = *(const LAS bf16x8*)(lds + o); Sf[kt] = *(const LAS bf16x8*)(lds + 8192 + o); }
            u32x2 t[8]; const unsigned ko = ks * 2048;
            f2_tr8(t, tb0 + ko, tb0 + ko + 512, tb1 + ko, tb1 + ko + 512, tb0 + ko + 8192, tb0 + ko + 8192 + 512, tb1 + ko + 8192, tb1 + ko + 8192 + 512);
            const bf16x8 Pf[2] = {f2_frag(t[0], t[1]), f2_frag(t[2], t[3])}, Qf[2] = {f2_frag(t[4], t[5]), f2_frag(t[6], t[7])};
            const bf16x8 Qn[2] = {f2_neg(Qf[0]), f2_neg(Qf[1])};
#pragma unroll
            for (int kt = 0; kt < 2; ++kt)
#pragma unroll
                for (int nt = 0; nt < 2; ++nt) {
                    Yr[kt][nt] = __builtin_amdgcn_mfma_f32_32x32x16_bf16(Cf[kt], Pf[nt], Yr[kt][nt], 0, 0, 0);
                    Yr[kt][nt] = __builtin_amdgcn_mfma_f32_32x32x16_bf16(Sf[kt], Qn[nt], Yr[kt][nt], 0, 0, 0);
                    Yi[kt][nt] = __builtin_amdgcn_mfma_f32_32x32x16_bf16(Sf[kt], Pf[nt], Yi[kt][nt], 0, 0, 0);
                    Yi[kt][nt] = __builtin_amdgcn_mfma_f32_32x32x16_bf16(Cf[kt], Qf[nt], Yi[kt][nt], 0, 0, 0);
                }
        }
#pragma unroll
        for (int nt = 0; nt < 2; ++nt) { const int l2 = 32 * nt + r;
#pragma unroll
            for (int kt = 0; kt < 2; ++kt)
#pragma unroll
                for (int eg = 0; eg < 4; ++eg) { const int k1 = 32 * kt + 8 * eg + 4 * h;
                    const f32x4 tc = *(const f32x4*)(TW + l2 * 64 + k1), ts = *(const f32x4*)(TW + 4096 + l2 * 64 + k1);
                    float yr[4], yi[4];
#pragma unroll
                    for (int j = 0; j < 4; ++j) { const float a = Yr[kt][nt][4 * eg + j], bneg = Yi[kt][nt][4 * eg + j];
                        yr[j] = a * tc[j] - bneg * ts[j]; yi[j] = -(a * ts[j] + bneg * tc[j]); }
                    const unsigned o = (unsigned)(l2 * 128 + ((kt ^ ((l2 >> 1) & 1)) * 64) + (8 * eg + 4 * h) * 2);
                    u32x2 wr_; wr_.x = cvt_pk_bf16(yr[0], yr[1]); wr_.y = cvt_pk_bf16(yr[2], yr[3]); *(LAS u32x2*)(xr + o) = wr_;
                    u32x2 wi_; wi_.x = cvt_pk_bf16(yi[0], yi[1]); wi_.y = cvt_pk_bf16(yi[2], yi[3]); *(LAS u32x2*)(xr + 8192 + o) = wi_; } }
        asm volatile("s_waitcnt lgkmcnt(0)" ::: "memory");
        f32x16 O[2][2];
#pragma unroll
        for (int a = 0; a < 2; ++a)
#pragma unroll
            for (int c = 0; c < 2; ++c)
#pragma unroll
                for (int e = 0; e < 16; ++e) O[a][c][e] = 0.f;
#pragma unroll 1
        for (int ks = 0; ks < 4; ++ks) {
            bf16x8 Cf[2], Sf[2];
#pragma unroll
            for (int kt = 0; kt < 2; ++kt) { const unsigned o = f2_cs_byte(32 * kt + r, 16 * ks + 8 * h); Cf[kt] = *(const LAS bf16x8*)(lds + o); Sf[kt] = *(const LAS bf16x8*)(lds + 8192 + o); }
            u32x2 t[8]; const unsigned ko = ks * 2048;
            f2_tr8(t, tb0 + ko, tb0 + ko + 512, tb1 + ko, tb1 + ko + 512, tb0 + ko + 8192, tb0 + ko + 8192 + 512, tb1 + ko + 8192, tb1 + ko + 8192 + 512);
            const bf16x8 Rf[2] = {f2_frag(t[0], t[1]), f2_frag(t[2], t[3])}, If[2] = {f2_frag(t[4], t[5]), f2_frag(t[6], t[7])};
#pragma unroll
            for (int kt = 0; kt < 2; ++kt)
#pragma unroll
                for (int nt = 0; nt < 2; ++nt) {
                    O[kt][nt] = __builtin_amdgcn_mfma_f32_32x32x16_bf16(Cf[kt], Rf[nt], O[kt][nt], 0, 0, 0);
                    O[kt][nt] = __builtin_amdgcn_mfma_f32_32x32x16_bf16(Sf[kt], If[nt], O[kt][nt], 0, 0, 0);
                }
        }
        { const float sc = 0.001381067932004974f;
#pragma unroll
          for (int kt = 0; kt < 2; ++kt)
#pragma unroll
              for (int nt = 0; nt < 2; ++nt)
#pragma unroll
                  for (int e = 0; e < 16; ++e) { const int k2 = 32 * kt + (e & 3) + 8 * (e >> 2) + 4 * h, k1 = 32 * nt + r;
                      *(LAS bf16_t*)(xr + (64 * k2 + k1) * 2) = f2bf(O[kt][nt][e] * sc); }
          asm volatile("s_waitcnt lgkmcnt(0)" ::: "memory");
          bf16_t* dst = AT + ((size_t)b * 512 + m) * SEQ;
#pragma unroll
          for (int i = 0; i < 8; ++i) *(u32x4*)(dst + (i * 64 + lane) * 8) = *(const LAS u32x4*)(xr + (i * 64 + lane) * 16);
          asm volatile("s_waitcnt lgkmcnt(0)" ::: "memory"); }
    }
    __syncthreads();
}

__device__ __forceinline__ void hyena_prep_phase(const bf16_t* __restrict__ UT, const bf16_t* __restrict__ UTc, bf16_t* __restrict__ VXT, bf16_t* __restrict__ X0T, bf16_t* __restrict__ HTc,
                                                 const float* __restrict__ KFc, const float* __restrict__ conv_w, const float* __restrict__ conv_b, const float* __restrict__ hbias,
                                                 LAS unsigned char* lds) {
    LAS float* kf = (LAS float*)lds;
    LAS float* raw = kf + 8192;
    LAS float* vx = raw + 3 * 4224;
    LAS float* x0s = vx + 4096;
    const int tid = otid(), lane = tid & 63;
    for (int cp = blockIdx.x; cp < 256; cp += gridDim.x)
        for (int cc = 0; cc < 2; ++cc) {
            const int c = cp * 2 + cc;
            float cw[3][3], cb[3];
#pragma unroll
            for (int j = 0; j < 3; ++j) { cb[j] = conv_b[j * 512 + c];
#pragma unroll
                for (int tp = 0; tp < 3; ++tp) cw[j][tp] = conv_w[tp * 1536 + j * 512 + c]; }
            const float bias = hbias[c];
            const int t0 = tid * 8;
#pragma unroll 2
            for (int b = 0; b < NB; ++b) {
                const bf16_t* UTb = UT + (size_t)b * UCH * SEQ;
                float z[3][8];
#pragma unroll
                for (int j = 0; j < 3; ++j) {
                    const bf16_t* rowp = UTb + ((size_t)1024 + j * 512 + c) * SEQ;
                    const u32x4 w = *(const u32x4*)(rowp + t0);
                    float r[10];
                    r[1] = bflo(w.x); r[2] = bfhi(w.x); r[3] = bflo(w.y); r[4] = bfhi(w.y); r[5] = bflo(w.z); r[6] = bfhi(w.z); r[7] = bflo(w.w); r[8] = bfhi(w.w);
                    const float pl_ = bf2f(rowp[t0 > 0 ? t0 - 1 : 0]), nl_ = bf2f(rowp[t0 + 8 < SEQ ? t0 + 8 : SEQ - 1]);
                    r[0] = t0 > 0 ? pl_ : 0.f; r[9] = t0 + 8 < SEQ ? nl_ : 0.f;
#pragma unroll
                    for (int i = 0; i < 8; ++i) z[j][i] = r[i] * cw[j][0] + r[i + 1] * cw[j][1] + r[i + 2] * cw[j][2] + cb[j];
                }
                float pv[8];
#pragma unroll
                for (int i = 0; i < 8; ++i) pv[i] = z[0][i] * z[1][i];
                u32x4 v8; v8.x = cvt_pk_bf16(pv[0], pv[1]); v8.y = cvt_pk_bf16(pv[2], pv[3]); v8.z = cvt_pk_bf16(pv[4], pv[5]); v8.w = cvt_pk_bf16(pv[6], pv[7]);
                { u32x4 x8; x8.x = cvt_pk_bf16(z[2][0], z[2][1]); x8.y = cvt_pk_bf16(z[2][2], z[2][3]); x8.z = cvt_pk_bf16(z[2][4], z[2][5]); x8.w = cvt_pk_bf16(z[2][6], z[2][7]);
                  const size_t o = ((size_t)c * NB + b) * SEQ + t0;
                  *(u32x4*)(VXT + o) = v8; *(u32x4*)(X0T + o) = x8; }
            }
            __syncthreads();
            if (tid < 128) *(LAS f32x4*)(kf + tid * 4) = *(const f32x4*)(KFc + (size_t)c * 512 + tid * 4);
            __syncthreads();
            hyena_pass<LCTX, 16>(UTc, HTc, c, cw, cb, bias, kf, raw, vx, x0s);
        }
}

__device__ __forceinline__ void toep_phase(const bf16_t* __restrict__ RC, const bf16_t* __restrict__ VXT, const bf16_t* __restrict__ X0T, const char* __restrict__ zero16, const float* __restrict__ hbias, bf16_t* __restrict__ HT,
                                           LAS unsigned char* lds) {
    int tid_ = threadIdx.x; asm volatile("" : "+v"(tid_));
    const int tid = tid_, lane = tid & 63, w = __builtin_amdgcn_readfirstlane(tid >> 6), r = lane & 31, h = lane >> 5;
    constexpr int RING = 65536, NST = 272;
    const int cbase = (4096 - 512 * w + 8 * (h - r) - 256) * 2;
    for (int cp = blockIdx.x; cp < 256; cp += gridDim.x)
        for (int cc = 0; cc < 2; ++cc) {
            const int c = cp * 2 + cc;
            const char* rc = (const char*)(RC + (size_t)c * 4 * 8192);
            const char* vxc = (const char*)(VXT + (size_t)c * NB * SEQ) + ((lane & 15) * SEQ + 256 * ((lane >> 4) & 1) + 8 * h - 256) * 2;
#define TOEP_SRC(st_) ({ const int s_ = 16 * (st_) - 256 + 256 * ((lane >> 4) & 1) + 8 * h; (s_ >= 0 && s_ < SEQ) ? vxc + 32 * (st_) : zero16; })
            __syncthreads();
#pragma unroll
            for (int i = 0; i < 8; ++i)
                __builtin_amdgcn_global_load_lds((const unsigned*)(rc + (w * 8 + i) * 1024 + lane * 16), (LAS unsigned*)(lds + (w * 8 + i) * 1024), 16, 0, 0);
            __builtin_amdgcn_global_load_lds((const unsigned*)TOEP_SRC(w), (LAS unsigned*)(lds + RING + w * 1024), 16, 0, 0);
            __builtin_amdgcn_global_load_lds((const unsigned*)TOEP_SRC(8 + w), (LAS unsigned*)(lds + RING + (8 + w) * 1024), 16, 0, 0);
            f32x16 acc[8];
#pragma unroll
            for (int j = 0; j < 8; ++j)
#pragma unroll
                for (int e = 0; e < 16; ++e) acc[j][e] = 0.f;
            for (int k = 0; k < NST / 8; ++k) {
                { int stn = 8 * (k + 2) + w; stn = stn < NST ? stn : NST - 1;
                  __builtin_amdgcn_global_load_lds((const unsigned*)TOEP_SRC(stn), (LAS unsigned*)(lds + RING + ((8 * (k + 2) + w) & 31) * 1024), 16, 0, 0); }
                asm volatile("s_waitcnt vmcnt(2)" ::: "memory");
                __builtin_amdgcn_s_barrier();
                asm volatile("" ::: "memory");
                const LAS unsigned char* ab = lds + cbase + 256 * k;
#pragma unroll
                for (int i = 0; i < 8; ++i) {
                    const bf16x8 bf = *(const LAS bf16x8*)(lds + RING + ((8 * k + i) & 31) * 1024 + lane * 16);
#pragma unroll
                    for (int m = 0; m < 4; ++m) {
                        const u32x4 w0 = *(const LAS u32x4*)(ab + m * 16384 + 32 * i - 16), w1 = *(const LAS u32x4*)(ab + m * 16384 + 32 * i);
                        const u32x4 mid = (u32x4){w0.z, w0.w, w1.x, w1.y};
                        acc[m] = __builtin_amdgcn_mfma_f32_32x32x16_bf16(__builtin_bit_cast(bf16x8, w1), bf, acc[m], 0, 0, 0);
                        acc[4 + m] = __builtin_amdgcn_mfma_f32_32x32x16_bf16(__builtin_bit_cast(bf16x8, mid), bf, acc[4 + m], 0, 0, 0);
                    }
                }
            }
            asm volatile("s_waitcnt vmcnt(0)" ::: "memory");
            __builtin_amdgcn_s_barrier();
            asm volatile("" ::: "memory");
            LAS unsigned char* wt = lds + w * 16640;
            { const int col = lane & 31, b = col & 15, a = col >> 4;
#pragma unroll
              for (int u = 0; u < 2; ++u)
#pragma unroll
                  for (int mp = 0; mp < 2; ++mp)
#pragma unroll
                      for (int e = 0; e < 16; ++e) { const int row = (e & 3) + 8 * (e >> 2) + 4 * h, tl = 4 * u + 2 * mp + 8 * row + 256 * a;
                          *(LAS unsigned*)(wt + (b * 520 + tl) * 2) = cvt_pk_bf16(acc[4 * u + 2 * mp][e], acc[4 * u + 2 * mp + 1][e]); } }
            asm volatile("s_waitcnt lgkmcnt(0)" ::: "memory");
            const float bias = hbias[c];
#pragma unroll 4
            for (int b = 0; b < 16; ++b) {
                const u32x4 y8 = *(const LAS u32x4*)(wt + (b * 520 + 8 * lane) * 2);
                const size_t go = ((size_t)b * 512 + c) * SEQ + 512 * w + 8 * lane, gi = ((size_t)c * NB + b) * SEQ + 512 * w + 8 * lane;
                const u32x4 g0 = *(const u32x4*)(X0T + gi), g1 = *(const u32x4*)(VXT + gi);
                const float x0v[8] = {bflo(g0.x), bfhi(g0.x), bflo(g0.y), bfhi(g0.y), bflo(g0.z), bfhi(g0.z), bflo(g0.w), bfhi(g0.w)};
                const float vxv[8] = {bflo(g1.x), bfhi(g1.x), bflo(g1.y), bfhi(g1.y), bflo(g1.z), bfhi(g1.z), bflo(g1.w), bfhi(g1.w)};
                const float yy[8] = {bflo(y8.x), bfhi(y8.x), bflo(y8.y), bfhi(y8.y), bflo(y8.z), bfhi(y8.z), bflo(y8.w), bfhi(y8.w)};
                float o[8];
#pragma unroll
                for (int i = 0; i < 8; ++i) o[i] = x0v[i] * (yy[i] + bias * vxv[i]);
                u32x4 ww; ww.x = cvt_pk_bf16(o[0], o[1]); ww.y = cvt_pk_bf16(o[2], o[3]); ww.z = cvt_pk_bf16(o[4], o[5]); ww.w = cvt_pk_bf16(o[6], o[7]);
                *(u32x4*)(HT + go) = ww;
            }
#undef TOEP_SRC
        }
    __syncthreads();
}

__device__ __forceinline__ void mix_transpose_phase(const bf16_t* __restrict__ AT, const bf16_t* __restrict__ HT, const bf16_t* __restrict__ HTc, bf16_t* __restrict__ MIX, LAS unsigned char* lds) {
    LAS bf16_t* T = (LAS bf16_t*)lds;
    const int tid = otid();
    for (int t = blockIdx.x; t < 16896; t += gridDim.x) {
        const bf16_t* src; int sld, row0, cb, coff;
        if (t < 16384) { const int t1 = t & 8191, b = t1 >> 9, tb = t1 & 63; cb = (t1 >> 6) & 7; src = (t < 8192 ? AT : HT) + ((size_t)(b * 512 + cb * 64)) * SEQ + tb * 64; sld = SEQ; row0 = b * SEQ + tb * 64; coff = t < 8192 ? 0 : 512; }
        else { const int t2 = t - 16384, b = t2 >> 5, tb = t2 & 3; cb = (t2 >> 2) & 7; src = HTc + ((size_t)(b * 512 + cb * 64)) * LCTX + tb * 64; sld = LCTX; row0 = NTOK + b * LCTX + tb * 64; coff = 512; }
        { const int r = tid >> 3, p = tid & 7; *(LAS u32x4*)(T + r * 72 + p * 8) = *(const u32x4*)(src + (size_t)r * sld + p * 8); }
        __syncthreads();
        { const int tt = tid >> 3, c8 = (tid & 7) * 8; unsigned w[4];
#pragma unroll
          for (int j = 0; j < 4; ++j) w[j] = (unsigned)T[(c8 + 2 * j) * 72 + tt] | ((unsigned)T[(c8 + 2 * j + 1) * 72 + tt] << 16);
          *(u32x4*)(MIX + (size_t)(row0 + tt) * D + coff + cb * 64 + c8) = (u32x4){w[0], w[1], w[2], w[3]}; }
        __syncthreads();
    }
}

__device__ __forceinline__ void attn_issue(LAS unsigned char* lds, int gc, const bf16_t* __restrict__ Kb, const bf16_t* __restrict__ VT, int item, int ci, int w, int lane) {
    LAS unsigned char* sl = lds + (gc & 3) * 32768;
    const int b = item >> 7, hkv = (item >> 5) & 3, qb = item & 31;
    const bool win = ci < 3;
    int kp0 = qb * 128 - 128 + 128 * ci; kp0 = kp0 < 0 ? 0 : (kp0 > SEQ - 128 ? SEQ - 128 : kp0);
    const char* kub = (const char*)Kb + ((size_t)(win ? b * SEQ + kp0 : NTOK + b * LCTX + 128 * (ci - 3)) * 256 + hkv * 64) * 2;
    const char* vub = (const char*)VT + (win ? ((size_t)(b * 256 + hkv * 64) * SEQ + kp0) * 2 : ((size_t)NB * 256 * SEQ + (size_t)(b * 256 + hkv * 64) * LCTX + 128 * (ci - 3)) * 2);
    const unsigned vrow = win ? SEQ * 2u : LCTX * 2u;
#pragma unroll
    for (int i = 0; i < 2; ++i) { const int q = 2 * w + i, key = 8 * q + (lane >> 3), ds = (lane & 7) ^ ((key >> 1) & 7);
        const unsigned lo = (unsigned)(key * 256 + ds * 8) * 2u;
        __builtin_amdgcn_global_load_lds((const unsigned*)(kub + lo), (LAS unsigned*)(sl + q * 1024), 16, 0, 0); }
#pragma unroll
    for (int i = 0; i < 2; ++i) { const int q = 2 * w + i, d = 4 * q + (lane >> 4), ss = (lane & 15) ^ (d & 15);
        const unsigned lo = (unsigned)d * vrow + (unsigned)ss * 16u;
        __builtin_amdgcn_global_load_lds((const unsigned*)(vub + lo), (LAS unsigned*)(sl + 16384 + q * 1024), 16, 0, 0); }
}

__device__ __forceinline__ void attn_softmax(f32x16& S, f32x16 (&O)[2][2], const int qt, float& mrun, float& lrun, bf16x8 (&P)[2], const bool need_mask, const int qp, const int kp0, const int h) {
    if (need_mask) {
#pragma unroll
        for (int e = 0; e < 16; ++e) { const int kp = kp0 + (e & 3) + 8 * (e >> 2) + 4 * h; const bool ok = (unsigned)(qp - kp + 128) <= 256u; S[e] = ok ? S[e] : -1.0e30f; }
    }
    float mx = S[0];
#pragma unroll
    for (int e = 1; e < 16; ++e) mx = fmaxf(mx, S[e]);
    mx = fmaxf(mx, __shfl_xor(mx, 32));
    const float mn = mx > mrun + 6.0f ? mx : mrun;
    if (__any(mn != mrun)) {
        const float alpha = __builtin_amdgcn_exp2f(mrun - mn);
        lrun *= alpha;
#pragma unroll
        for (int dt = 0; dt < 2; ++dt)
#pragma unroll
            for (int e = 0; e < 16; ++e) O[dt][qt][e] *= alpha;
        mrun = mn;
    }
    float ps = 0.f;
#pragma unroll
    for (int e = 0; e < 16; ++e) { S[e] = __builtin_amdgcn_exp2f(S[e] - mn); ps += S[e]; }
    lrun += ps;
#pragma unroll
    for (int s2 = 0; s2 < 2; ++s2) { u32x4 pk;
        pk.x = cvt_pk_bf16(S[8 * s2 + 0], S[8 * s2 + 1]); pk.y = cvt_pk_bf16(S[8 * s2 + 2], S[8 * s2 + 3]);
        pk.z = cvt_pk_bf16(S[8 * s2 + 4], S[8 * s2 + 5]); pk.w = cvt_pk_bf16(S[8 * s2 + 6], S[8 * s2 + 7]);
        P[s2] = __builtin_bit_cast(bf16x8, pk); }
}

__device__ __forceinline__ void attn_chunk(const bool WIN, const int ktlo, const int kthi, const LAS unsigned char* sl, const bf16x8 (&Qf)[2][4], f32x16 (&O)[2][2], float (&mrun)[2], float (&lrun)[2], int kpc, int q0w, int lane) {
    const int r = lane & 31, h = lane >> 5;
#pragma unroll 1
    for (int kt = ktlo; kt < kthi; ++kt) {
        const int kp0 = kpc + 32 * kt;
        f32x16 S0, S1;
        { bf16x8 kf[4];
          const int key = 32 * kt + r, sw = (key >> 1) & 7;
#pragma unroll
          for (int ks = 0; ks < 4; ++ks) kf[ks] = *(const LAS bf16x8*)(sl + key * 128 + (((2 * ks + h) ^ sw) << 4));
#pragma unroll
          for (int e = 0; e < 16; ++e) { S0[e] = 0.f; S1[e] = 0.f; }
#pragma unroll
          for (int ks = 0; ks < 4; ++ks) S0 = __builtin_amdgcn_mfma_f32_32x32x16_bf16(kf[ks], Qf[0][ks], S0, 0, 0, 0);
#pragma unroll
          for (int ks = 0; ks < 4; ++ks) S1 = __builtin_amdgcn_mfma_f32_32x32x16_bf16(kf[ks], Qf[1][ks], S1, 0, 0, 0); }
        bf16x8 vf[2][2];
#pragma unroll
        for (int dt = 0; dt < 2; ++dt)
#pragma unroll
            for (int s2 = 0; s2 < 2; ++s2) { const int d = 32 * dt + r; vf[dt][s2] = *(const LAS bf16x8*)(sl + 16384 + d * 256 + (((4 * kt + 2 * s2 + h) ^ (d & 15)) << 4)); }
        __builtin_amdgcn_sched_barrier(0);
        const int dq0 = kp0 - q0w, dq1 = kp0 - (q0w + 32);
        bf16x8 P0[2], P1[2];
        attn_softmax(S0, O, 0, mrun[0], lrun[0], P0, WIN && (dq0 < -96 || dq0 > 96), q0w + r, kp0, h);
#pragma unroll
        for (int dt = 0; dt < 2; ++dt)
#pragma unroll
            for (int s2 = 0; s2 < 2; ++s2) O[dt][0] = __builtin_amdgcn_mfma_f32_32x32x16_bf16(vf[dt][s2], P0[s2], O[dt][0], 0, 0, 0);
        __builtin_amdgcn_sched_barrier(0);
        attn_softmax(S1, O, 1, mrun[1], lrun[1], P1, WIN && (dq1 < -96 || dq1 > 96), q0w + 32 + r, kp0, h);
#pragma unroll
        for (int dt = 0; dt < 2; ++dt)
#pragma unroll
            for (int s2 = 0; s2 < 2; ++s2) O[dt][1] = __builtin_amdgcn_mfma_f32_32x32x16_bf16(vf[dt][s2], P1[s2], O[dt][1], 0, 0, 0);
        __builtin_amdgcn_sched_barrier(0);
    }
}

__device__ __forceinline__ void attn_phase(const bf16_t* __restrict__ Q, const bf16_t* __restrict__ Kb, const bf16_t* __restrict__ VT, bf16_t* __restrict__ AO, const float* __restrict__ sink, LAS unsigned char* lds) {
    int tid_ = threadIdx.x; asm volatile("" : "+v"(tid_));
    const int tid = tid_, lane = tid & 63, w = __builtin_amdgcn_readfirstlane(tid >> 6), r = lane & 31, h = lane >> 5;
    const int G = gridDim.x;
    int nitems = 0; for (int it = blockIdx.x; it < 2048; it += G) ++nitems;
    const int nch = nitems * 5;
    __syncthreads();
    if (nch > 0) { attn_issue(lds, 0, Kb, VT, blockIdx.x, 0, w, lane); attn_issue(lds, 1, Kb, VT, blockIdx.x, 1, w, lane); }
    int gc = 0;
    for (int item = blockIdx.x; item < 2048; item += G) {
        const int b = item >> 7, hkv = (item >> 5) & 3, qb = item & 31, head = hkv * 4 + (w >> 1), q0w = qb * 128 + (w & 1) * 64;
        bf16x8 Qf[2][4];
#pragma unroll
        for (int qt = 0; qt < 2; ++qt)
#pragma unroll
            for (int ks = 0; ks < 4; ++ks) Qf[qt][ks] = *(const bf16x8*)((const char*)Q + ((size_t)(b * SEQ + q0w) * D + head * 64) * 2 + (unsigned)((32 * qt + r) * D + 16 * ks + 8 * h) * 2u);
        f32x16 O[2][2];
#pragma unroll
        for (int dt = 0; dt < 2; ++dt)
#pragma unroll
            for (int qt = 0; qt < 2; ++qt)
#pragma unroll
                for (int e = 0; e < 16; ++e) O[dt][qt][e] = 0.f;
        const float sk = sink[head] * 1.4426950408889634f;
        float mrun[2] = {sk, sk}, lrun[2] = {h == 0 ? 1.0f : 0.0f, h == 0 ? 1.0f : 0.0f};
#pragma unroll 1
        for (int ci = 0; ci < 5; ++ci, ++gc) {
            { int g2 = gc + 2, it2 = item, c2 = ci + 2;
              if (c2 >= 5) { c2 -= 5; it2 += G; }
              if (g2 >= nch) { it2 = item; c2 = 0; }
              attn_issue(lds, g2, Kb, VT, it2, c2, w, lane); }
            asm volatile("s_waitcnt vmcnt(8)" ::: "memory");
            __builtin_amdgcn_s_barrier();
            asm volatile("" ::: "memory");
            const LAS unsigned char* sl = lds + (gc & 3) * 32768;
            { const bool win = ci < 3; const int kpc = qb * 128 - 128 + 128 * ci;
              int ktlo = 0, kthi = 4;
              if (win) { ktlo = (q0w - 128 - kpc) >> 5; ktlo = ktlo < 0 ? 0 : ktlo; kthi = ((q0w + 191 - kpc) >> 5) + 1; kthi = kthi > 4 ? 4 : kthi; if (kpc < 0 || kpc >= SEQ) kthi = 0; }
              attn_chunk(win, ktlo, kthi, sl, Qf, O, mrun, lrun, kpc, q0w, lane); }
        }
#pragma unroll
        for (int qt = 0; qt < 2; ++qt) {
            const float lt = lrun[qt] + __shfl_xor(lrun[qt], 32), inv = __builtin_amdgcn_rcpf(lt);
            bf16_t* op = (bf16_t*)((char*)AO + ((size_t)(b * SEQ + q0w) * D + head * 64) * 2 + (unsigned)((32 * qt + r) * D + 4 * h) * 2u);
#pragma unroll
            for (int dt = 0; dt < 2; ++dt)
#pragma unroll
                for (int eg = 0; eg < 4; ++eg) { u32x2 wv; wv.x = cvt_pk_bf16(O[dt][qt][4 * eg] * inv, O[dt][qt][4 * eg + 1] * inv); wv.y = cvt_pk_bf16(O[dt][qt][4 * eg + 2] * inv, O[dt][qt][4 * eg + 3] * inv);
                    *(u32x2*)(op + 32 * dt + 8 * eg) = wv; }
        }
    }
    asm volatile("s_waitcnt vmcnt(0)" ::: "memory");
    __syncthreads();
}

__device__ __forceinline__ void slots_phase(const unsigned* __restrict__ route, const int* __restrict__ hist, int* __restrict__ tok, float* __restrict__ gw, int* __restrict__ slotof, int* __restrict__ tile_e, LAS unsigned char* lds) {
    LAS int* hl = (LAS int*)lds;
    LAS int* cnt = hl + 2048;
    LAS int* base = cnt + 8;
    LAS int* pst = base + 8;
    LAS int* wcnt = pst + 16;
    const int tid = otid(), lane = tid & 63, wid = tid >> 6;
    __syncthreads();
    if (tid < 256) { const u32x4 a = *(const u32x4*)(hist + tid * 8), b = *(const u32x4*)(hist + tid * 8 + 4);
        *(LAS u32x4*)(hl + tid * 8) = a; *(LAS u32x4*)(hl + tid * 8 + 4) = b; }
    __syncthreads();
    if (tid < 8) { int tot = 0, bs = 0; for (int k = 0; k < 256; ++k) { const int h = hl[k * 8 + tid]; if (k < (int)blockIdx.x) bs += h; tot += h; } cnt[tid] = tot; base[tid] = bs; }
    __syncthreads();
    if (tid == 0) { int p = 0; for (int e = 0; e < 8; ++e) { pst[e] = p; p += (cnt[e] + 255) & ~255; } pst[8] = p; }
    __syncthreads();
    const int token = blockIdx.x * 256 + (tid >> 1), k = tid & 1;
    const int mye = (int)route[(size_t)token * 4 + k]; const float myg = __uint_as_float(route[(size_t)token * 4 + 2 + k]);
    int rk = 0;
#pragma unroll
    for (int e = 0; e < 8; ++e) { const unsigned long long mask = __ballot(mye == e);
        if (lane == 0) wcnt[e * 8 + wid] = __popcll(mask);
        if (mye == e) rk = __popcll(mask & ((1ull << lane) - 1ull)); }
    __syncthreads();
    int pre = 0;
    for (int w = 0; w < wid; ++w) pre += wcnt[mye * 8 + w];
    const int slot = pst[mye] + base[mye] + pre + rk;
    tok[slot] = token; gw[slot] = myg; slotof[token * 2 + k] = slot;
    if (blockIdx.x == 0) {
        for (int e = 0; e < 8; ++e) for (int s = pst[e] + cnt[e] + tid; s < pst[e + 1]; s += 512) { tok[s] = 0; gw[s] = 0.f; }
        for (int t = tid; t < MAXTILES; t += 512) { int e = 0;
#pragma unroll
            for (int q = 1; q < 8; ++q) if (t * 256 >= pst[q]) e = q;
            tile_e[t] = e; }
        if (tid == 0) tile_e[1023] = pst[8] >> 8;
    }
}

__device__ __forceinline__ void combine_phase(float* __restrict__ out, const bf16_t* __restrict__ XB, const bf16_t* __restrict__ Y, const int* __restrict__ slotof, const float* __restrict__ gate  ) {
    const int tid = otid(), lane = tid & 63, wid = tid >> 6, nwv = gridDim.x * 8, gw = blockIdx.x * 8 + wid, tpw = (NTOK + nwv - 1) / nwv;
    const int t0 = gw * tpw, t1 = (t0 + tpw) < NTOK ? (t0 + tpw) : NTOK;
    if (t0 >= t1) return;
    f32x4 gv[4]; int curb = -1;
#pragma unroll
    for (int i = 0; i < 4; ++i) gv[i] = (f32x4){0.f, 0.f, 0.f, 0.f};
    int sa = slotof[t0 * 2], sb = slotof[t0 * 2 + 1];
    int sa2 = 0, sb2 = 0;
    if (t0 + 1 < t1) { sa2 = slotof[(t0 + 1) * 2]; sb2 = slotof[(t0 + 1) * 2 + 1]; }
    u32x4 y1[2], y2[2], xw[2];
#pragma unroll
    for (int i = 0; i < 2; ++i) { const int o = i * 512 + lane * 8; y1[i] = *(const u32x4*)(Y + (size_t)sa * D + o); y2[i] = *(const u32x4*)(Y + (size_t)sb * D + o); xw[i] = *(const u32x4*)(XB + (size_t)t0 * D + o); }
    for (int t = t0; t < t1; ++t) {
        const int bidx = t >> 12;
        if (bidx != curb) { curb = bidx; const float* gp = gate + (size_t)bidx * NMOD;
#pragma unroll
            for (int i = 0; i < 2; ++i) { gv[2 * i] = *(const f32x4*)(gp + i * 512 + lane * 8); gv[2 * i + 1] = *(const f32x4*)(gp + i * 512 + lane * 8 + 4); } }
        u32x4 cy1[2], cy2[2], cx[2];
#pragma unroll
        for (int i = 0; i < 2; ++i) { cy1[i] = y1[i]; cy2[i] = y2[i]; cx[i] = xw[i]; }
        const int na = sa2, nb = sb2;
        if (t + 2 < t1) { sa2 = slotof[(t + 2) * 2]; sb2 = slotof[(t + 2) * 2 + 1]; }
        if (t + 1 < t1) {
#pragma unroll
            for (int i = 0; i < 2; ++i) { const int o = i * 512 + lane * 8; y1[i] = *(const u32x4*)(Y + (size_t)na * D + o); y2[i] = *(const u32x4*)(Y + (size_t)nb * D + o); xw[i] = *(const u32x4*)(XB + (size_t)(t + 1) * D + o); }
        }
#pragma unroll
        for (int i = 0; i < 2; ++i) { const int o = i * 512 + lane * 8;
            float* xp = out + (size_t)t * D + o;
            f32x4 xa = (f32x4){bflo(cx[i].x), bfhi(cx[i].x), bflo(cx[i].y), bfhi(cx[i].y)}, xb = (f32x4){bflo(cx[i].z), bfhi(cx[i].z), bflo(cx[i].w), bfhi(cx[i].w)};
            const f32x4 ga = gv[2 * i], gb = gv[2 * i + 1];
            xa[0] += ga[0] * (bflo(cy1[i].x) + bflo(cy2[i].x)); xa[1] += ga[1] * (bfhi(cy1[i].x) + bfhi(cy2[i].x)); xa[2] += ga[2] * (bflo(cy1[i].y) + bflo(cy2[i].y)); xa[3] += ga[3] * (bfhi(cy1[i].y) + bfhi(cy2[i].y));
            xb[0] += gb[0] * (bflo(cy1[i].z) + bflo(cy2[i].z)); xb[1] += gb[1] * (bfhi(cy1[i].z) + bfhi(cy2[i].z)); xb[2] += gb[2] * (bflo(cy1[i].w) + bflo(cy2[i].w)); xb[3] += gb[3] * (bfhi(cy1[i].w) + bfhi(cy2[i].w));
            *(f32x4*)xp = xa; *(f32x4*)(xp + 4) = xb; }
    }
}

#ifndef FFN_FP8
#define FFN_FP8 1
#endif
constexpr int MQ_G1 = (FFN_FP8 ? 32 : 20), MQ_WO = 24, MQ_GU = 20, MQ_FD = (FFN_FP8 ? 32 : 48), MQ_QKV = (FFN_FP8 ? 40 : 20);
constexpr int MB_G1 = 0, MB_WO = MB_G1 + 96 * MQ_G1, MB_GU = MB_WO + 192 * MQ_WO, MB_FD = MB_GU + 64 * MQ_GU, MB_QKV = MB_FD + 192 * MQ_FD, MB_REM = MB_QKV + 160 * MQ_QKV;
static_assert(MB_REM <= NE * 2688 && MQ_G1 % 4 == 0 && MQ_WO % 4 == 0 && MQ_GU % 4 == 0 && MQ_FD % 4 == 0 && MQ_QKV % 4 == 0, "moe conversion quotas");
#define MOE_CONV(first, count) do { sw_start(lds, 7, true); moe_conv_groups(INP(30), INP(31), INP(32), (fp8_t*)OUTP() + DO_MGU, (fp8_t*)OUTP() + DO_MD, lds, (first) / 4, ((first) + (count)) / 4, 1); sw_stop(lds, 7, true); } while (0)
#ifndef STAG_R1
#define STAG_R1 0
#endif
#ifndef STAG_R2
#define STAG_R2 0
#endif
#ifndef STAG_FFN
#define STAG_FFN 0
#endif
#ifndef STAG_MOE
#define STAG_MOE 0
#endif
#ifndef PROBE_MASK
#define PROBE_MASK 0u
#endif
#define REP(k) for (int rep_ = 0; rep_ < (((PROBE_MASK >> (k)) & 1u) ? 2 : 1); ++rep_)
#ifndef PHMASK
#define PHMASK 0xffffffffu
#endif
#define XBAR(n) do { sw_start(lds, 5, true); sw_start(lds, 6, SW_PHASE == (n)); xcd_barrier(bar, (unsigned*)WSP()); sw_stop(lds, 5, true); sw_stop(lds, 6, SW_PHASE == (n)); } while (0)
struct Args { const float* in[33]; float* out; unsigned char* ws; };

__device__ __forceinline__ unsigned long long ldq(volatile LAS unsigned* tab, int i) {
    unsigned lo = tab[2 * i], hi = tab[2 * i + 1];
    lo = __builtin_amdgcn_readfirstlane(lo); hi = __builtin_amdgcn_readfirstlane(hi);
    return ((unsigned long long)hi << 32) | (unsigned long long)lo;
}
#define GAS __attribute__((address_space(1)))
#define INP(i) ((const float*)(const GAS float*)ldq(tab, (i)))
#define OUTP() ((float*)(GAS float*)ldq(tab, 33))
#define WSP() ((unsigned char*)(GAS unsigned char*)ldq(tab, 34))
#define WSF(off) ((float*)(ws + (off)))
#define WSB(off) ((bf16_t*)(ws + (off)))
#define WSI(off) ((int*)(ws + (off)))

__global__ void __launch_bounds__(512, 2) fwd_kernel(Args a_unused) {
    extern __shared__ __attribute__((aligned(16))) unsigned char lds_raw[];
    LAS unsigned char* lds = (LAS unsigned char*)lds_raw;
    volatile LAS unsigned* misc = (volatile LAS unsigned*)(lds + LDS_MISC);
    volatile LAS unsigned* tab = misc + 16;
    const int tid = otid(), G = gridDim.x, bx = blockIdx.x;
    if (tid < 4) misc[tid] = 0u;
    if (SW_ID != 0 && tid < 8) misc[128 + tid] = 0u;
    if (tid < 70) { const unsigned* ka = (const unsigned*)__builtin_amdgcn_kernarg_segment_ptr(); tab[tid] = ka[tid]; }
    __syncthreads();
    XcdBarrier bar = xcd_barrier_post((unsigned*)WSP(), misc);

    if (PHMASK & (1u << 0)) REP(0) {
    { unsigned char* ws = WSP();
      REP(20) {
      tconv<RM_OFF>(INP(8), 1024, 2048, 512, 1536, WSB(OFF_WIN), 1024, lds, bx, G);
      tconv<RM_OFF>(INP(9), 1024, 1024, 0, 1024, WSB(OFF_WOUT), 0, lds, bx, G);
#if FFN_FP8 == 1
      tconv8<RM_GU_G>(INP(21), 1024, DFF, 0, DFF, (fp8_t*)(ws + OFF_WGU), 0, lds, bx, G);
      tconv8<RM_GU_U>(INP(22), 1024, DFF, 0, DFF, (fp8_t*)(ws + OFF_WGU), 0, lds, bx, G);
#else
      tconv<RM_GU_G>(INP(21), 1024, DFF, 0, DFF, WSB(OFF_WGU), 0, lds, bx, G);
      tconv<RM_GU_U>(INP(22), 1024, DFF, 0, DFF, WSB(OFF_WGU), 0, lds, bx, G);
#endif
#if FFN_FP8
      tconv8<RM_OFF>(INP(23), DFF, 1024, 0, 1024, (fp8_t*)(ws + OFF_WD), 0, lds, bx, G);
#else
      tconv<RM_OFF>(INP(23), DFF, 1024, 0, 1024, WSB(OFF_WD), 0, lds, bx, G);
#endif
      tconv<RM_QKV>(INP(24), 1024, 1536, 0, 1280, WSB(OFF_WQKV), 0, lds, bx, G);
      tconv<RM_OFF>(INP(24), 1024, 1536, 1280, 256, WSB(OFF_WQKV), 1280, lds, bx, G);
      tconv<RM_OFF>(INP(25), 1024, 1024, 0, 1024, WSB(OFF_WO2), 0, lds, bx, G);
      }
      REP(21) fold_job(INP(8), WSB(OFF_WIN), lds);
      dft_job(WSB(OFF_DFTC), WSF(OFF_TW), lds);
      REP(22) ada_job(INP(1), INP(3), INP(4), INP(5), WSF(OFF_MOD), lds);
      REP(23) h3_job(INP(13), INP(14), INP(15), INP(16), INP(17), INP(18), INP(20), WSF(OFF_H3));
      float* ROPEC = WSF(OFF_ROPE); float* ROPES = ROPEC + 1024;
      for (int idx = bx * 512 + tid; idx < 1024; idx += G * 512) { const int pp = idx >> 4, i = idx & 15; const float inv = powf(10000.0f, -(float)i / 16.0f), ang = (float)pp * inv; ROPEC[idx] = cosf(ang); ROPES[idx] = sinf(ang); }
      if (bx == 0 && tid < 128) ROPEC[2048 + tid] = tid < 64 ? INP(26)[tid] : INP(27)[tid - 64];
    }
    }
    XBAR(1);

    if (PHMASK & (1u << 1)) REP(1) {
    { unsigned char* ws = WSP();
      for (int cp = bx; cp < 256; cp += G) { filt_fin<SEQ>(WSF(OFF_H3), INP(19), WSF(OFF_RC), cp, lds); filt_fin<LCTX>(WSF(OFF_H3) + (size_t)SEQ * 64, INP(19), WSF(OFF_KFC), cp, lds); }
      norm_phase<false>(INP(0), INP(2), MROWS, INP(6), WSF(OFF_MOD), 0, WSB(OFF_HX), nullptr, nullptr, nullptr, lds);
    }
    }
    XBAR(2);

    if (PHMASK & (1u << 2)) REP(2) {
    { unsigned char* ws = WSP();
      PolU p; p.S.init(UCH / BM, MROWS / BM, G, bx); p.A = WSB(OFF_WIN); p.B = WSB(OFF_HX); p.UT = WSB(OFF_UT); p.UTc = WSB(OFF_UTC); gemm_phase<D>(lds, p, 0, KREP_G1, SW_PHASE == 2);
      if (bx >= 160) MOE_CONV(MB_G1 + (bx - 160) * MQ_G1, MQ_G1); }
    }
    XBAR(3);

    if (PHMASK & (1u << 3)) REP(3) {
    REP(17) { unsigned char* ws = WSP();
      fourier2_phase(WSB(OFF_UT), WSB(OFF_AT), WSF(OFF_TW), lds); }
    { unsigned char* ws = WSP();
      PolF p; p.S.init(NB, 2, G, bx); p.DFT = WSB(OFF_DFTC); p.ZT = WSB(OFF_UTC); p.MIX = WSB(OFF_MIX); p.K = 512; p.L = LCTX; p.tpb = 1; p.rowbase = NTOK; p.zstride = (unsigned)UCH * LCTX; p.scale = 0.005524271728019903f; gemm_phase<512>(lds, p); }
    REP(18) { unsigned char* ws = WSP();
      hyena_prep_phase(WSB(OFF_UT), WSB(OFF_UTC), WSB(OFF_VXT), WSB(OFF_X0T), WSB(OFF_HTC), WSF(OFF_KFC), INP(10), INP(11), INP(12), lds); }
    __syncthreads();
    REP(19) { unsigned char* ws = WSP();
      toep_phase(WSB(OFF_RC), WSB(OFF_VXT), WSB(OFF_X0T), (const char*)(ws + OFF_ZERO16), INP(12), WSB(OFF_HT), lds); }
    }
    XBAR(5);

    if (PHMASK & (1u << 4)) REP(4) {
    { unsigned char* ws = WSP(); mix_transpose_phase(WSB(OFF_AT), WSB(OFF_HT), WSB(OFF_HTC), WSB(OFF_MIX), lds); }
    }
    XBAR(6);

    if (PHMASK & (1u << 5)) REP(5) {
    { unsigned char* ws = WSP();
      PolR<false, false> p; p.S.init(MROWS / BM, 4, G, bx); p.A = WSB(OFF_MIX); p.B = WSB(OFF_WOUT); p.K = D; p.srcL = INP(0); p.XB = WSB(OFF_XB); p.srcC = INP(2); p.dstC = WSF(OFF_CTXR); p.gate = WSF(OFF_MOD) + 2 * D; gemm_phase<D>(lds, p, STAG_R1);
      if (bx >= 64) MOE_CONV(MB_WO + (bx - 64) * MQ_WO, MQ_WO); }
    }
    XBAR(7);

    if (PHMASK & (1u << 6)) REP(6) {
    { unsigned char* ws = WSP(); norm_phase<false, FFN_FP8 == 1, true>(WSB(OFF_XB), WSF(OFF_CTXR), MROWS, INP(7), WSF(OFF_MOD), 3, WSB(OFF_HX), nullptr, nullptr, nullptr, lds); }
    }
    XBAR(8);

    if (PHMASK & (1u << 7)) REP(7) {
    { unsigned char* ws = WSP();
      PolG<false, TileOrder, FFN_FP8 == 1, FFN_FP8 != 0> p; p.S.init(MROWS / BM, DFF / HALF, G, bx); p.A = WSB(OFF_HX); p.B = WSB(OFF_WGU); p.H = WSB(OFF_HID); p.tok = nullptr; p.tile_e = nullptr; p.tile0 = 0; gemm_phase<D>(lds, p, STAG_FFN, KREP_FFN, SW_PHASE == 7);
      if (bx >= 192) MOE_CONV(MB_GU + (bx - 192) * MQ_GU, MQ_GU); }
    }
    XBAR(9);

    if (PHMASK & (1u << 8)) REP(8) {
    { unsigned char* ws = WSP();
      PolR<FFN_FP8 != 0, true> p; p.S.init(MROWS / BM, 4, G, bx); p.A = WSB(OFF_HID); p.B = WSB(OFF_WD); p.K = DFF; p.srcL = nullptr; p.XB = WSB(OFF_XB); p.srcC = WSF(OFF_CTXR); p.dstC = WSF(OFF_CTXR); p.gate = WSF(OFF_MOD) + 5 * D; gemm_phase<DFF>(lds, p, STAG_R2);
      if (bx >= 64) MOE_CONV(MB_FD + (bx - 64) * MQ_FD, MQ_FD); }
    }
    XBAR(10);

    if (PHMASK & (1u << 9)) REP(9) {
    { unsigned char* ws = WSP();
      norm_phase<false, false, true>(WSB(OFF_XB), WSF(OFF_CTXR), MROWS, INP(6) + D, WSF(OFF_MOD) + 17 * NMOD, 0, WSB(OFF_HX), nullptr, nullptr, nullptr, lds);
      moe_conv_groups(INP(30), INP(31), INP(32), (fp8_t*)OUTP() + DO_MGU, (fp8_t*)OUTP() + DO_MD, lds, MB_REM / 4 + bx, MOE_CONV_TILES / 4, G);
    }
    }
    XBAR(11);

    if (PHMASK & (1u << 10)) REP(10) {
    { unsigned char* ws = WSP();
      PolQKV p; p.S.init(MROWS / BM, 5, G, bx); p.HX = WSB(OFF_HX); p.W = WSB(OFF_WQKV); p.ws = ws; p.qkg = WSF(OFF_ROPE) + 2048; p.ropec = WSF(OFF_ROPE); p.ropes = WSF(OFF_ROPE) + 1024; gemm_phase<D>(lds, p);
      if (bx >= 96) MOE_CONV(MB_QKV + (bx - 96) * MQ_QKV, MQ_QKV); }
    }
    XBAR(12);

    if (PHMASK & (1u << 11)) REP(11) {
    { unsigned char* ws = WSP(); attn_phase(WSB(OFF_Q), WSB(OFF_K), WSB(OFF_V), WSB(OFF_AO), INP(28), lds); }
    }
    XBAR(13);

    if (PHMASK & (1u << 12)) REP(12) {
    { unsigned char* ws = WSP();
      PolR<false, true> p; p.S.init(NTOK / BM, 4, G, bx); p.A = WSB(OFF_AO); p.B = WSB(OFF_WO2); p.K = D; p.srcL = nullptr; p.XB = WSB(OFF_XB); p.srcC = WSF(OFF_CTXR); p.dstC = WSF(OFF_CTXR); p.gate = WSF(OFF_MOD) + 17 * NMOD + 2 * D; gemm_phase<D>(lds, p, STAG_R1); }
    }
    XBAR(14);

    if (PHMASK & (1u << 13)) REP(13) {
    { unsigned char* ws = WSP();
      norm_phase<true, true, true>(WSB(OFF_XB), nullptr, NTOK, INP(7) + D, WSF(OFF_MOD) + 17 * NMOD, 3, (bf16_t*)((unsigned char*)OUTP() + DO_HX8), INP(29), (unsigned*)(ws + OFF_ROUTE), WSI(OFF_HIST), lds); }
    }
    XBAR(15);

    if (PHMASK & (1u << 14)) REP(14) {
    { unsigned char* ws = WSP(); slots_phase((const unsigned*)(ws + OFF_ROUTE), WSI(OFF_HIST), WSI(OFF_TOK), WSF(OFF_GW), WSI(OFF_SLOTOF), WSI(OFF_TILEE), lds); }
    }
    XBAR(16);

    if (PHMASK & (1u << 15)) REP(15) {
#pragma unroll
    for (int ch = 0; ch < NCHUNK; ++ch) {
        { unsigned char* ws = WSP();
          const int ntiles = WSI(OFF_TILEE)[1023], per = (ntiles + NCHUNK - 1) / NCHUNK, t0 = ch * per; int ntc = ntiles - t0; ntc = ntc > per ? per : ntc; if (ntc < 0) ntc = 0;
          PolG<true, LinOrder<DFF / HALF>, true> p; p.S.init(ntc, DFF / HALF, G, bx); p.A = (unsigned char*)OUTP() + DO_HX8; p.B = (unsigned char*)OUTP() + DO_MGU; p.H = ws + OFF_HIDM; p.tok = WSI(OFF_TOK); p.tile_e = WSI(OFF_TILEE); p.tile0 = t0; gemm_phase<D>(lds, p, STAG_MOE, KREP_MOE, SW_PHASE == 15); }
        XBAR(17);
        { unsigned char* ws = WSP();
          const int ntiles = WSI(OFF_TILEE)[1023], per = (ntiles + NCHUNK - 1) / NCHUNK, t0 = ch * per; int ntc = ntiles - t0; ntc = ntc > per ? per : ntc; if (ntc < 0) ntc = 0;
          PolD p; p.S.init(ntc, 4, G, bx); p.A = (const fp8_t*)(ws + OFF_HIDM); p.B = (const fp8_t*)OUTP() + DO_MD; p.Y = WSB(OFF_Y); p.gw = WSF(OFF_GW); p.tile_e = WSI(OFF_TILEE); p.tile0 = t0; gemm_phase<DFF>(lds, p); }
        XBAR(18);
    }
    }

    if (PHMASK & (1u << 16)) REP(16) {
    { unsigned char* ws = WSP(); combine_phase(OUTP(), WSB(OFF_XB), WSB(OFF_Y), WSI(OFF_SLOTOF), WSF(OFF_MOD) + 17 * NMOD + 5 * D); }
    }
    if (SW_ID != 0) { if (threadIdx.x == 0 && blockIdx.x == SW_BLOCK) { const unsigned long long dt = *(volatile LAS unsigned long long*)(lds + LDS_MISC + 512) * (unsigned long long)SW_AMP, t0 = __builtin_amdgcn_s_memrealtime();
        while (__builtin_amdgcn_s_memrealtime() - t0 < dt) __builtin_amdgcn_s_sleep(32); } }
}

extern "C" void kernel_launch(void* const* d_in, const int* in_sizes, int n_in, void* d_out, int out_size, void* d_ws, size_t ws_size, hipStream_t stream) {
    static int grid = 0;
    if (grid == 0) {
        if (n_in != 33 || in_sizes[0] != NTOK * D || out_size != NTOK * D || ws_size < WS_NEED) {
            fprintf(stderr, "kernel_launch: unexpected shapes: n_in %d in0 %d out %d ws %zu (need %zu)\n", n_in, n_in > 0 ? in_sizes[0] : -1, out_size, ws_size, (size_t)WS_NEED); grid = -1; return; }
        int dev = 0, cus = 0;
        if (hipGetDevice(&dev) != hipSuccess || hipDeviceGetAttribute(&cus, hipDeviceAttributeMultiprocessorCount, dev) != hipSuccess) { grid = -1; return; }
        if (hipFuncSetAttribute((const void*)fwd_kernel, hipFuncAttributeMaxDynamicSharedMemorySize, LDS_BYTES) != hipSuccess) { fprintf(stderr, "kernel_launch: hipFuncSetAttribute failed\n"); grid = -1; return; }
        int per_cu = 0;
        if (hipOccupancyMaxActiveBlocksPerMultiprocessor(&per_cu, (const void*)fwd_kernel, 512, LDS_BYTES) != hipSuccess || per_cu < 1) { fprintf(stderr, "kernel_launch: occupancy query says %d\n", per_cu); }
        (void)hipGetLastError();
        if (cus != 256) { fprintf(stderr, "kernel_launch: built for 256 CUs, device has %d\n", cus); grid = -1; return; }
        grid = 256;
    }
    if (grid < 0) return;
    if (hipMemsetAsync((char*)d_ws + OFF_CTL, 0, 65536, stream) != hipSuccess) return;
    Args a{};
    for (int i = 0; i < 33; ++i) a.in[i] = (const float*)d_in[i];
    a.out = (float*)d_out; a.ws = (unsigned char*)d_ws;
    hipLaunchKernelGGL(fwd_kernel, dim3(grid), dim3(512), LDS_BYTES, stream, a);
}
```

```cpp
#include <hip/hip_runtime.h>
#include <cstdio>
#include <cstdint>

#define LAS __attribute__((address_space(3)))
typedef unsigned short bf16_t;
typedef short bf16x8 __attribute__((ext_vector_type(8)));
typedef float f32x4 __attribute__((ext_vector_type(4)));
typedef float f32x2 __attribute__((ext_vector_type(2)));
typedef unsigned u32x4 __attribute__((ext_vector_type(4)));
typedef unsigned u32x2 __attribute__((ext_vector_type(2)));
typedef __bf16 bf16x2_t __attribute__((ext_vector_type(2)));
typedef float f32x16 __attribute__((ext_vector_type(16)));
typedef int i32x8 __attribute__((ext_vector_type(8)));
typedef unsigned char fp8_t;

#ifndef KREP_G1
#define KREP_G1 1
#endif
#ifndef KREP_FFN
#define KREP_FFN 1
#endif
#ifndef KREP_MOE
#define KREP_MOE 1
#endif
#ifndef KLOOP_REP
#define KLOOP_REP 1
#endif
#ifndef EREP_U
#define EREP_U 1
#endif
#ifndef EREP_G
#define EREP_G 1
#endif
#ifndef EREP_GM
#define EREP_GM 1
#endif
#ifndef EREP_QKV
#define EREP_QKV 1
#endif
#ifndef EREP_D
#define EREP_D 1
#endif
#ifndef GEMM_ALIGN
#define GEMM_ALIGN 1
#endif
constexpr int D = 1024, NB = 16, SEQ = 4096, NTOK = NB * SEQ, LCTX = 256, NCTX = NB * LCTX, MROWS = NTOK + NCTX;
constexpr int DFF = 3584, NE = 8, NMOD = 6 * D;
constexpr int UCH = 2560;
constexpr int MAXSLOT = 133120;
constexpr int MAXTILES = MAXSLOT / 256;
constexpr int NCHUNK = 1;
constexpr float EPS = 1e-6f;

constexpr size_t al4k(size_t x) { return (x + 4095) & ~(size_t)4095; }
constexpr size_t MiB = 1024 * 1024;
constexpr size_t OFF_CTL = 0;
constexpr size_t OFF_MOD = 65536;
constexpr size_t OFF_ROPE = OFF_MOD + al4k((size_t)2 * 17 * NMOD * 4);
constexpr size_t OFF_H3 = OFF_ROPE + al4k(2 * 64 * 16 * 4 + 512);
constexpr size_t OFF_KF = OFF_H3 + al4k((size_t)4352 * 64 * 4);
constexpr size_t OFF_KFC = OFF_KF + (size_t)512 * 8192 * 4;
constexpr size_t OFF_ROUTE = OFF_KFC + (size_t)512 * 512 * 4;
constexpr size_t OFF_HIST = OFF_ROUTE + (size_t)NTOK * 16;
constexpr size_t OFF_TOK = OFF_HIST + al4k(256 * 8 * 4);
constexpr size_t OFF_GW = OFF_TOK + al4k((size_t)MAXSLOT * 4);
constexpr size_t OFF_SLOTOF = OFF_GW + al4k((size_t)MAXSLOT * 4);
constexpr size_t OFF_TILEE = OFF_SLOTOF + (size_t)NTOK * 8;
constexpr size_t OFF_CTXR = OFF_TILEE + 4096;
constexpr size_t OFF_WIN = OFF_CTXR + (size_t)NCTX * D * 4;
constexpr size_t OFF_WOUT = OFF_WIN + (size_t)UCH * D * 2;
constexpr size_t OFF_WGU = OFF_WOUT + (size_t)D * D * 2;
constexpr size_t OFF_WD = OFF_WGU + (size_t)2 * DFF * D * 2;
constexpr size_t OFF_WQKV = OFF_WD + (size_t)D * DFF * 2;
constexpr size_t OFF_WO2 = OFF_WQKV + (size_t)1536 * D * 2;
constexpr size_t OFF_DFTC = OFF_WO2 + (size_t)D * D * 2;
constexpr size_t OFF_A_END = OFF_DFTC + (size_t)256 * 512 * 2;
static_assert(OFF_A_END <= 80 * MiB, "region A");
constexpr size_t OFF_HX = 80 * MiB;
constexpr size_t OFF_UT = 216 * MiB;
constexpr size_t OFF_UTC = 536 * MiB;
constexpr size_t OFF_MIX = 556 * MiB;
constexpr size_t OFF_HT = 692 * MiB;
constexpr size_t OFF_HTC = 756 * MiB;
constexpr size_t OFF_DFT = 760 * MiB;
constexpr size_t OFF_HID = 216 * MiB;
constexpr size_t OFF_Q = 216 * MiB;
constexpr size_t OFF_K = 344 * MiB;
constexpr size_t OFF_V = 378 * MiB;
constexpr size_t OFF_AO = 412 * MiB;
constexpr size_t OFF_HIDM = 144 * MiB;
constexpr size_t OFF_Y = 600 * MiB;
constexpr size_t OFF_XB = 896 * MiB;
static_assert(OFF_HIDM + (size_t)MAXSLOT * DFF <= OFF_Y && OFF_Y + (size_t)MAXSLOT * D * 2 <= OFF_XB, "moe map");
constexpr size_t DO_MGU = 0;
constexpr size_t DO_MD = 56 * MiB;
constexpr size_t DO_HX8 = 96 * MiB;
constexpr size_t OFF_AT = 760 * MiB;
constexpr size_t OFF_TW = OFF_KF;
constexpr size_t OFF_VXT = 824 * MiB;
constexpr size_t OFF_X0T = 888 * MiB;
constexpr size_t OFF_ZERO16 = 32768;
constexpr size_t OFF_RC = 952 * MiB;
constexpr size_t WS_NEED = 1024 * MiB;


constexpr int LDS_BYTES = 151552;
constexpr int LDS_MISC = LDS_BYTES - 1024;

__device__ __forceinline__ unsigned cvt_pk_bf16(float lo, float hi) { unsigned r; asm volatile("v_cvt_pk_bf16_f32 %0, %1, %2" : "=v"(r) : "v"(lo), "v"(hi)); return r; }
__device__ __forceinline__ bf16_t f2bf(float f) { unsigned u = __float_as_uint(f); u += 0x7FFFu + ((u >> 16) & 1u); return (bf16_t)(u >> 16); }
__device__ __forceinline__ float bf2f(bf16_t b) { return __uint_as_float(((unsigned)b) << 16); }
__device__ __forceinline__ float bflo(unsigned u) { return __uint_as_float(u << 16); }
__device__ __forceinline__ float bfhi(unsigned u) { return __uint_as_float(u & 0xffff0000u); }
__device__ __forceinline__ float dot2(unsigned a, unsigned b, float acc) { return __builtin_amdgcn_fdot2_f32_bf16(__builtin_bit_cast(bf16x2_t, a), __builtin_bit_cast(bf16x2_t, b), acc, false); }
__device__ __forceinline__ float wave_sum(float v) {
#pragma unroll
    for (int o = 32; o >= 1; o >>= 1) v += __shfl_xor(v, o);
    return v;
}
__device__ __forceinline__ unsigned pk4_fp8(float a, float b, float c, float d) { int w = __builtin_amdgcn_cvt_pk_fp8_f32(a, b, 0, false); w = __builtin_amdgcn_cvt_pk_fp8_f32(c, d, w, true); return (unsigned)w; }
constexpr float F8_ACT = 8.0f, F8_W = 64.0f, F8_HID = 4.0f;
__device__ __forceinline__ int otid() { int t = threadIdx.x; asm volatile("" : "+v"(t)); return t; }
__device__ __forceinline__ float silu_f(float x) { return x * __builtin_amdgcn_rcpf(1.0f + __builtin_amdgcn_exp2f(-1.4426950408889634f * x)); }

#ifndef SW_ID
#define SW_ID 0
#endif
#ifndef SW_AMP
#define SW_AMP 8
#endif
#ifndef SW_BLOCK
#define SW_BLOCK 0
#endif
#ifndef SW_PHASE
#define SW_PHASE 0
#endif
__device__ __forceinline__ void sw_start(LAS unsigned char* lds, int id, bool on) {
    if (SW_ID != 0 && SW_ID == id && on) { if (threadIdx.x == 0 && blockIdx.x == SW_BLOCK) *(volatile LAS unsigned long long*)(lds + (151552 - 1024) + 528) = __builtin_amdgcn_s_memrealtime(); }
}
__device__ __forceinline__ void sw_stop(LAS unsigned char* lds, int id, bool on) {
    if (SW_ID != 0 && SW_ID == id && on) { if (threadIdx.x == 0 && blockIdx.x == SW_BLOCK) { volatile LAS unsigned long long* q = (volatile LAS unsigned long long*)(lds + (151552 - 1024) + 512);
        q[0] = q[0] + (__builtin_amdgcn_s_memrealtime() - q[2]); } }
}

#define XB_TMO      128
#define XB_XCNT(j)  (256  + 64 * (j))
#define XB_XSUB(j)  (1280 + 64 * (j))
#define XB_XGEN(j)  (2304 + 64 * (j))
#define XB_TOP      3328
#define XB_TOPGEN   3392
#define XCD_BAR_WORDS 3456
#define XB_SPIN_CAP (1u << 22)

__device__ __forceinline__ unsigned xb_ld(unsigned* p)              { return __hip_atomic_load(p, __ATOMIC_RELAXED, __HIP_MEMORY_SCOPE_AGENT); }
__device__ __forceinline__ unsigned xb_add(unsigned* p, unsigned v) { return __hip_atomic_fetch_add(p, v, __ATOMIC_RELAXED, __HIP_MEMORY_SCOPE_AGENT); }
__device__ __forceinline__ unsigned xb_xcc_id() { return (unsigned)__builtin_amdgcn_s_getreg((3 << 11) | 20) & 0xFu; }
#define XB_SPIN(cond, bar) do { unsigned _sp = 0; while (cond) { __builtin_amdgcn_s_sleep(1); \
    if ((++_sp & 255u) == 0u) { if (xb_ld(&(bar)[XB_TMO])) break; if (_sp > XB_SPIN_CAP) { atomicAdd(&(bar)[XB_TMO], 1u); break; } } } } while (0)

struct XcdBarrier { volatile LAS unsigned* st; };

__device__ __forceinline__ XcdBarrier xcd_barrier_post(unsigned* bar, volatile LAS unsigned* st) {
    XcdBarrier b; b.st = st;
    if (threadIdx.x == 0) { const unsigned x = xb_xcc_id(); st[2] = x; (void)xb_add(&bar[XB_XCNT(x)], 1u); }
    return b;
}
__device__ __forceinline__ void xcd_barrier_complete(unsigned* bar, unsigned x, unsigned& nloc, unsigned& nx) {
    const unsigned G = gridDim.x * gridDim.y * gridDim.z;
    unsigned sum, cnt, mine, sp = 0u;
    for (;;) {
        sum = 0u; cnt = 0u;
#pragma unroll
        for (unsigned j = 0; j < 16; ++j) { const unsigned c = xb_ld(&bar[XB_XCNT(j)]); sum += c; cnt += (c > 0u) ? 1u : 0u; }
        mine = xb_ld(&bar[XB_XCNT(x)]);
        if (sum == G) break;
        __builtin_amdgcn_s_sleep(1);
        if ((++sp & 255u) == 0u) { if (xb_ld(&bar[XB_TMO])) break; if (sp > XB_SPIN_CAP) { atomicAdd(&bar[XB_TMO], 1u); break; } }
    }
    nloc = mine > 0u ? mine : 1u; nx = cnt > 0u ? cnt : 1u;
}
__device__ __forceinline__ void xcd_barrier(const XcdBarrier& b, unsigned* bar) {
    asm volatile("s_waitcnt vmcnt(0)" ::: "memory");
    __syncthreads();
    if (threadIdx.x == 0) {
        __builtin_amdgcn_s_waitcnt(0);
        unsigned nloc = b.st[0], nx = b.st[1]; const unsigned bx_ = b.st[2];
        if (nloc == 0u) { xcd_barrier_complete(bar, bx_, nloc, nx); b.st[0] = nloc; b.st[1] = nx; }
        const unsigned old = xb_add(&bar[XB_XSUB(bx_)], 1u);
        const unsigned gen = old / nloc;
        if (old + 1u == (gen + 1u) * nloc) {
            __builtin_amdgcn_fence(__ATOMIC_RELEASE, "agent");
            asm volatile("s_waitcnt vmcnt(0)" ::: "memory");
            const unsigned og = xb_add(&bar[XB_TOP], 1u);
            const unsigned tg = og / nx;
            if (og + 1u == (tg + 1u) * nx) xb_add(&bar[XB_TOPGEN], 1u);
            else XB_SPIN(xb_ld(&bar[XB_TOPGEN]) == tg, bar);
            __builtin_amdgcn_fence(__ATOMIC_ACQUIRE, "agent");
            xb_add(&bar[XB_XGEN(bx_)], 1u);
            asm volatile("s_waitcnt vmcnt(0)" ::: "memory");
        } else {
            XB_SPIN(xb_ld(&bar[XB_XGEN(bx_)]) == gen, bar);
            __builtin_amdgcn_fence(__ATOMIC_ACQUIRE, "agent");
            asm volatile("s_waitcnt vmcnt(0)" ::: "memory");
        }
    }
    __syncthreads();
}

constexpr int BM = 256, BK = 64, HALF = 128, HTB = HALF * BK * 2, NXCD = 8, WGM = 8;
__host__ __device__ __forceinline__ int lds_byte(int r, int c) { const int st = (r >> 4) * 2 + (c >> 5), rr = r & 15, cc = c & 31, ob = rr * 64 + cc * 2; return st * 1024 + (ob ^ (((ob >> 9) & 1) << 5)); }
__host__ __device__ __forceinline__ void stage_rc(int b, int& R, int& C) { const int st = b / 1024, sb = b % 1024, swz = sb ^ (((sb >> 9) & 1) << 5); R = (st >> 1) * 16 + swz / 64; C = (st & 1) * 32 + (swz % 64) / 2; }
__host__ __device__ __forceinline__ int perm32(int rho) { const int n = rho >> 4, i = rho & 15; return 8 * (i >> 2) + 4 * n + (i & 3); }

struct Unit { int pm, pn; };
struct TileOrder {
    int nM, nN, nwg, G, c;
    __device__ __forceinline__ void init(int nM_, int nN_, int G_, int c_) { nM = nM_; nN = nN_; nwg = nM * nN; G = G_; c = c_; }
    __device__ __forceinline__ bool next(int i, Unit& u) const {
        const long L = (long)i * G + c; if (L >= nwg) return false;
        int wgid = (int)L; { const int q = nwg / NXCD, r = nwg % NXCD, xcd = wgid % NXCD, off = wgid / NXCD; wgid = (xcd < r ? xcd * (q + 1) : r * (q + 1) + (xcd - r) * q) + off; }
        const int nig = WGM * nN, gid = wgid / nig, fm = gid * WGM, gsz = (nM - fm) < WGM ? (nM - fm) : WGM;
        u.pm = fm + ((wgid % nig) % gsz); u.pn = (wgid % nig) / gsz; return true;
    }
};

template <int NN> struct LinOrder {
    int nwg, G, c;
    __device__ __forceinline__ void init(int nM_, int, int G_, int c_) { nwg = nM_ * NN; G = G_; c = c_; }
    __device__ __forceinline__ bool next(int i, Unit& u) const { const int L = i * G + c; if (L >= nwg) return false; u.pm = L / NN; u.pn = L % NN; return true; }
};

typedef f32x4 AccT[2][2][4][2];
typedef unsigned u32x8 __attribute__((ext_vector_type(8)));
template <bool F8> struct Frag;
template <> struct Frag<false> { bf16x8 k[2]; };
template <> struct Frag<true> { u32x8 q; };

template <int K, class P>
__device__ __forceinline__ void gemm_phase(LAS unsigned char* lds, const P& p, const int stagger_ticks = 0, const int krep = 1, const bool sw = false) {
    int tid_ = threadIdx.x; asm volatile("" : "+v"(tid_));
    const int tid = tid_, wid = __builtin_amdgcn_readfirstlane(tid >> 6), lane = tid & 63, wr = wid >> 2, wc = wid & 3, fr = lane & 15, fq = lane >> 4;
    constexpr int RB = P::FP8 ? K : K * 2;
    constexpr int nt = RB / 128;
    constexpr unsigned hstep = (unsigned)HALF * RB;
    unsigned vA[2], vB[2], vG[2][2], vGn[2][2];
#pragma unroll
    for (int i = 0; i < 2; ++i) { int R, C; stage_rc(tid * 16 + i * 8192, R, C); const int Rb = P::PERM ? ((R & ~31) + perm32(R & 31)) : R;
        vA[i] = (unsigned)(R * RB + C * 2); vB[i] = (unsigned)(Rb * RB + C * 2); }
    constexpr size_t kstep = (size_t)(BK * 2);
    const unsigned ldsw = (unsigned)wid * 1024u;
    const int aoff = P::FP8 ? lds_byte(wr * 64 + fr, fq * 16) : lds_byte(wr * 64 + fr, fq * 8), boff = P::FP8 ? lds_byte(wc * 32 + fr, fq * 16) : lds_byte(wc * 32 + fr, fq * 8);
#define PG8_SA(b, h) (((b) * 2 + (h)) * HTB)
#define PG8_SB(b, h) ((4 + (b) * 2 + (h)) * HTB)
#define PG8_STAGE(bufoff, gbase, v0, v1) do { \
        __builtin_amdgcn_global_load_lds((const unsigned*)((const char*)(gbase) + (v0)), (LAS unsigned*)(lds + (bufoff) + ldsw), 16, 0, 0); \
        __builtin_amdgcn_global_load_lds((const unsigned*)((const char*)(gbase) + (v1)), (LAS unsigned*)(lds + (bufoff) + ldsw + 8192), 16, 0, 0); } while (0)
#define PG8_STB(bufoff, gbase, h) PG8_STAGE(bufoff, (gbase) + (h) * hstep, vB[0], vB[1])
#define PG8_STAX(bufoff, gbase, h, nx) do { if constexpr (P::GATHER) { PG8_STAGE(bufoff, gbase, ((nx) ? vGn[h][0] : vG[h][0]), ((nx) ? vGn[h][1] : vG[h][1])); } \
        else { PG8_STAGE(bufoff, (gbase) + (h) * hstep, vA[0], vA[1]); } } while (0)
#define PG8_STA(bufoff, gbase, h) PG8_STAX(bufoff, gbase, h, false)
#define PG8_LD8(addr) __builtin_shufflevector(*(const LAS u32x4*)((addr) + f8lo), *(const LAS u32x4*)((addr) + f8hi), 0, 1, 2, 3, 4, 5, 6, 7)
#define PG8_LDA(dst, b, h) do { if constexpr (P::FP8) { _Pragma("unroll") for (int m = 0; m < 4; ++m) dst[m].q = PG8_LD8(lds + PG8_SA(b, h) + aoff + m * 2048); } \
        else { _Pragma("unroll") for (int m = 0; m < 4; ++m) _Pragma("unroll") for (int k = 0; k < 2; ++k) dst[m].k[k] = *(const LAS bf16x8*)(lds + PG8_SA(b, h) + aoff + m * 2048 + k * 1024); } } while (0)
#define PG8_LDB(dst, b, h) do { if constexpr (P::FP8) { _Pragma("unroll") for (int n = 0; n < 2; ++n) dst[n].q = PG8_LD8(lds + PG8_SB(b, h) + boff + n * 2048); } \
        else { _Pragma("unroll") for (int n = 0; n < 2; ++n) _Pragma("unroll") for (int k = 0; k < 2; ++k) dst[n].k[k] = *(const LAS bf16x8*)(lds + PG8_SB(b, h) + boff + n * 2048 + k * 1024); } } while (0)
#define PG8_MMA(ai, bj, At, Bt) do { __builtin_amdgcn_s_setprio(1); if constexpr (P::FP8) { _Pragma("unroll") for (int m = 0; m < 4; ++m) _Pragma("unroll") for (int n = 0; n < 2; ++n) \
            asm volatile("v_mfma_scale_f32_16x16x128_f8f6f4 %0, %1, %2, %0, %3, %3 op_sel_hi:[0,0,0]" : "+v"(acc[ai][bj][m][n]) : "v"(Bt[n].q), "v"(At[m].q), "v"(f8scale)); } \
        else { _Pragma("unroll") for (int m = 0; m < 4; ++m) _Pragma("unroll") for (int n = 0; n < 2; ++n) _Pragma("unroll") for (int k = 0; k < 2; ++k) \
            acc[ai][bj][m][n] = __builtin_amdgcn_mfma_f32_16x16x32_bf16(Bt[n].k[k], At[m].k[k], acc[ai][bj][m][n], 0, 0, 0); } __builtin_amdgcn_s_setprio(0); } while (0)
#define PG8_WAIT_V(n) asm volatile("s_waitcnt vmcnt(" #n ")" ::: "memory")
#define PG8_WAIT_L(n) asm volatile("s_waitcnt lgkmcnt(" #n ")" ::: "memory")
#define PG8_BAR __builtin_amdgcn_s_barrier()
#define PG8_SCHED __builtin_amdgcn_sched_barrier(0)
#define PG8_GROWS(dst, u) do { if constexpr (P::GATHER) { _Pragma("unroll") for (int i = 0; i < 2; ++i) { int R, C; stage_rc(tid * 16 + i * 8192, R, C); \
        _Pragma("unroll") for (int h = 0; h < 2; ++h) dst[h][i] = (unsigned)(p.arow(u, h * HALF + R) * RB + C * 2); } } } while (0)
    Unit cur, nxt; int ui = 0;
    if (!p.next(0, cur)) return;
    sw_start(lds, 1, sw);
    if (stagger_ticks > 0) {
        const unsigned long long t0 = __builtin_amdgcn_s_memrealtime();
        const unsigned k = (blockIdx.x >> 3) & 31u;
        const unsigned long long dt = (unsigned long long)(k * (unsigned)stagger_ticks) >> 5;
        while (__builtin_amdgcn_s_memrealtime() - t0 < dt) __builtin_amdgcn_s_sleep(8);
    }
    AccT acc;
#pragma unroll
    for (int a = 0; a < 2; ++a)
#pragma unroll
        for (int b = 0; b < 2; ++b)
#pragma unroll
            for (int m = 0; m < 4; ++m)
#pragma unroll
                for (int n = 0; n < 2; ++n) acc[a][b][m][n] = (f32x4){0.f, 0.f, 0.f, 0.f};
    Frag<P::FP8> At[4], B0[2], B1[2];
    const int f8lo = (fq & 1) * 16, f8hi = 16 - f8lo;
    unsigned f8scale = 0x7f7f7f7fu; asm volatile("" : "+v"(f8scale));
    const char* cA = p.abase(cur); const char* cB = p.bbase(cur);
    PG8_GROWS(vG, cur);
    PG8_GROWS(vGn, cur);
    PG8_STB(PG8_SB(0, 0), cB, 0); PG8_STB(PG8_SB(0, 1), cB, 1); PG8_STA(PG8_SA(0, 0), cA, 0); PG8_STA(PG8_SA(0, 1), cA, 1);
    if (wr == 1) PG8_BAR;
    PG8_WAIT_V(2); PG8_BAR;
    PG8_STB(PG8_SB(1, 0), cB + kstep, 0); PG8_STA(PG8_SA(1, 0), cA + kstep, 0); PG8_STB(PG8_SB(1, 1), cB + kstep, 1);
    PG8_WAIT_V(6); PG8_BAR;
    for (;;) {
        const bool has_next = p.next(ui + 1, nxt);
        const char* nA = cA; const char* nB = cB;
        if (has_next) { nA = p.abase(nxt); nB = p.bbase(nxt); PG8_GROWS(vGn, nxt); }
        sw_stop(lds, 4, sw && ui > 0); sw_start(lds, 2, sw);
#pragma unroll 1
        for (int krep_ = 0; krep_ < KLOOP_REP * krep; ++krep_) {
        const bool realnext_ = (krep_ == KLOOP_REP * krep - 1);
        if (krep_ > 0) {
#pragma unroll
            for (int a = 0; a < 2; ++a)
#pragma unroll
                for (int b = 0; b < 2; ++b)
#pragma unroll
                    for (int m = 0; m < 4; ++m)
#pragma unroll
                        for (int n = 0; n < 2; ++n) acc[a][b][m][n] = (f32x4){0.f, 0.f, 0.f, 0.f};
        }
#pragma unroll 1
        for (int t = 0; t < nt; t += 2) {
            const bool lastt_ = (t == nt - 2);
            const bool last = lastt_ && realnext_;
            const char* a1 = cA + (size_t)(t + 1) * kstep;
            const char* a2 = lastt_ ? (realnext_ ? nA : cA) : cA + (size_t)(t + 2) * kstep; const char* b2 = lastt_ ? (realnext_ ? nB : cB) : cB + (size_t)(t + 2) * kstep;
            const char* a3 = a2 + kstep; const char* b3 = b2 + kstep;
            PG8_LDB(B0, 0, 0); PG8_LDB(B1, 0, 1); PG8_SCHED; PG8_LDA(At, 0, 0); PG8_STA(PG8_SA(1, 1), a1, 1);
            PG8_WAIT_V(8); PG8_WAIT_L(0); PG8_BAR; PG8_MMA(0, 0, At, B0); PG8_MMA(0, 1, At, B1); PG8_BAR; PG8_SCHED;
            PG8_LDA(At, 0, 1); PG8_STB(PG8_SB(0, 0), b2, 0); PG8_STB(PG8_SB(0, 1), b2, 1); PG8_STAX(PG8_SA(0, 0), a2, 0, last);
            PG8_WAIT_V(8); PG8_WAIT_L(0); PG8_BAR; PG8_MMA(1, 0, At, B0); PG8_MMA(1, 1, At, B1); PG8_BAR; PG8_SCHED;
            PG8_LDB(B0, 1, 0); PG8_LDB(B1, 1, 1); PG8_SCHED; PG8_LDA(At, 1, 0); PG8_STAX(PG8_SA(0, 1), a2, 1, last);
            PG8_WAIT_V(8); PG8_WAIT_L(0); PG8_BAR; PG8_MMA(0, 0, At, B0); PG8_MMA(0, 1, At, B1); PG8_BAR; PG8_SCHED;
            PG8_LDA(At, 1, 1); PG8_STB(PG8_SB(1, 0), b3, 0); PG8_STB(PG8_SB(1, 1), b3, 1); PG8_STAX(PG8_SA(1, 0), a3, 0, last);
            PG8_WAIT_V(8); PG8_WAIT_L(0); PG8_BAR; PG8_MMA(1, 0, At, B0); PG8_MMA(1, 1, At, B1); PG8_BAR; PG8_SCHED;
        }
        }
        sw_stop(lds, 2, sw); sw_start(lds, 3, sw);
        if (GEMM_ALIGN && wr == 0) PG8_BAR;
        if constexpr (P::FP8) asm volatile("s_nop 15\n\ts_nop 15" ::: "memory");
        if constexpr (P::EREP > 1) { int er_ = P::EREP; asm volatile("" : "+s"(er_));
#pragma unroll 1
            for (; er_ > 0; --er_) p.epi(acc, cur, wr, wc, fr, fq); }
        else p.epi(acc, cur, wr, wc, fr, fq);
        sw_stop(lds, 3, sw); sw_start(lds, 4, sw);
        if (!has_next) break;
#pragma unroll
        for (int a = 0; a < 2; ++a)
#pragma unroll
            for (int b = 0; b < 2; ++b)
#pragma unroll
                for (int m = 0; m < 4; ++m)
#pragma unroll
                    for (int n = 0; n < 2; ++n) acc[a][b][m][n] = (f32x4){0.f, 0.f, 0.f, 0.f};
        cur = nxt; cA = nA; cB = nB; ++ui;
        if constexpr (P::GATHER) {
#pragma unroll
            for (int h = 0; h < 2; ++h)
#pragma unroll
                for (int i = 0; i < 2; ++i) vG[h][i] = vGn[h][i];
        }
        if (GEMM_ALIGN && wr == 1) PG8_BAR;
    }
    PG8_WAIT_V(0);
    if (!GEMM_ALIGN && wr == 0) PG8_BAR;
    PG8_BAR;
    sw_stop(lds, 1, sw);
#undef PG8_SA
#undef PG8_SB
#undef PG8_STAGE
#undef PG8_STB
#undef PG8_STA
#undef PG8_STAX
#undef PG8_LDA
#undef PG8_LDB
#undef PG8_MMA
#undef PG8_WAIT_V
#undef PG8_WAIT_L
#undef PG8_BAR
#undef PG8_SCHED
#undef PG8_GROWS
#undef PG8_LD8
}


struct PolU {
    static constexpr bool PERM = true, GATHER = false, FP8 = false; static constexpr int EREP = EREP_U;
    TileOrder S; const bf16_t* A; const bf16_t* B; bf16_t* UT; bf16_t* UTc;
    __device__ __forceinline__ bool next(int i, Unit& u) const { return S.next(i, u); }
    __device__ __forceinline__ const char* abase(const Unit& u) const { return (const char*)A + (unsigned)u.pm * (unsigned)(BM * D * 2); }
    __device__ __forceinline__ const char* bbase(const Unit& u) const { return (const char*)B + (unsigned)u.pn * (unsigned)(BM * D * 2); }
    __device__ __forceinline__ int arow(const Unit&, int) const { return 0; }
    __device__ __forceinline__ void epi(const AccT& acc, const Unit& u, int wr, int wc, int fr, int fq) const {
        bf16_t* base; int Lrow;
        if (u.pn < 256) { const int b = u.pn >> 4; base = UT + (size_t)b * UCH * SEQ + (u.pn & 15) * 256; Lrow = SEQ; }
        else { const int b = u.pn - 256; base = UTc + (size_t)b * UCH * LCTX; Lrow = LCTX; }
        const int ch0 = u.pm * BM + wr * 64 + fr, c0 = wc * 32 + 8 * fq;
#pragma unroll
        for (int ai = 0; ai < 2; ++ai)
#pragma unroll
            for (int m = 0; m < 4; ++m) { bf16_t* rowp = base + (size_t)(ch0 + ai * HALF + m * 16) * Lrow + c0;
#pragma unroll
                for (int bj = 0; bj < 2; ++bj) { const f32x4 v0 = acc[ai][bj][m][0], v1 = acc[ai][bj][m][1];
                    u32x4 w; w.x = cvt_pk_bf16(v0[0], v0[1]); w.y = cvt_pk_bf16(v0[2], v0[3]); w.z = cvt_pk_bf16(v1[0], v1[1]); w.w = cvt_pk_bf16(v1[2], v1[3]);
                    *(u32x4*)(rowp + bj * HALF) = w; } }
    }
};

struct PolF {
    static constexpr bool PERM = true, GATHER = false, FP8 = false; static constexpr int EREP = 1;
    TileOrder S; const bf16_t* DFT; const bf16_t* ZT; bf16_t* MIX; int K, L, tpb  , rowbase; unsigned zstride  ; float scale;
    __device__ __forceinline__ bool next(int i, Unit& u) const { return S.next(i, u); }
    __device__ __forceinline__ const char* abase(const Unit& u) const { return (const char*)DFT + (unsigned)(u.pm % tpb) * (unsigned)(BM * K * 2); }
    __device__ __forceinline__ const char* bbase(const Unit& u) const { return (const char*)ZT + ((unsigned)(u.pm / tpb) * zstride + (unsigned)u.pn * (unsigned)(BM * K)) * 2u; }
    __device__ __forceinline__ int arow(const Unit&, int) const { return 0; }
    __device__ __forceinline__ void epi(const AccT& acc, const Unit& u, int wr, int wc, int fr, int fq) const {
        const int b = u.pm / tpb, kt = u.pm % tpb;
        const int row0 = rowbase + b * L + kt * BM + wr * 64 + fr, c0 = u.pn * BM + wc * 32 + 8 * fq;
#pragma unroll
        for (int ai = 0; ai < 2; ++ai)
#pragma unroll
            for (int m = 0; m < 4; ++m) { bf16_t* rowp = MIX + (size_t)(row0 + ai * HALF + m * 16) * D + c0;
#pragma unroll
                for (int bj = 0; bj < 2; ++bj) { const f32x4 v0 = acc[ai][bj][m][0] * scale, v1 = acc[ai][bj][m][1] * scale;
                    u32x4 w; w.x = cvt_pk_bf16(v0[0], v0[1]); w.y = cvt_pk_bf16(v0[2], v0[3]); w.z = cvt_pk_bf16(v1[0], v1[1]); w.w = cvt_pk_bf16(v1[2], v1[3]);
                    *(u32x4*)(rowp + bj * HALF) = w; } }
    }
};

template <bool F8, bool X16IN>
struct PolR {
    static constexpr bool PERM = true, GATHER = false, FP8 = F8; static constexpr int EREP = 1;
    static constexpr int ES = F8 ? 1 : 2;
    TileOrder S; const void* A; const void* B; int K; const float* srcL; bf16_t* XB; const float* srcC; float* dstC; const float* gate  ;
    __device__ __forceinline__ bool next(int i, Unit& u) const { return S.next(i, u); }
    __device__ __forceinline__ const char* abase(const Unit& u) const { return (const char*)A + (size_t)((unsigned)u.pm * (unsigned)(BM * ES)) * (unsigned)K; }
    __device__ __forceinline__ const char* bbase(const Unit& u) const { return (const char*)B + (unsigned)u.pn * (unsigned)(BM * K * ES); }
    __device__ __forceinline__ int arow(const Unit&, int) const { return 0; }
    __device__ __forceinline__ void epi(const AccT& acc, const Unit& u, int wr, int wc, int fr, int fq) const {
        const bool lat = u.pm < 256;
        const float* gp = gate + (size_t)(lat ? (u.pm >> 4) : 16) * NMOD;
        const int row0 = wr * 64 + fr, col0 = u.pn * BM + wc * 32 + 8 * fq;
        constexpr float gs = F8 ? 1.0f / (F8_HID * F8_W) : 1.0f;
        f32x4 gv[2][2];
#pragma unroll
        for (int bj = 0; bj < 2; ++bj)
#pragma unroll
            for (int n = 0; n < 2; ++n) gv[bj][n] = *(const f32x4*)(gp + col0 + bj * HALF + n * 4) * gs;
        if (lat) {
            bf16_t* xbt = XB + (size_t)u.pm * BM * D; const float* srt = X16IN ? nullptr : srcL + (size_t)u.pm * BM * D;
#pragma unroll
            for (int ai = 0; ai < 2; ++ai)
#pragma unroll
                for (int m = 0; m < 4; ++m) { const unsigned ro = (unsigned)((row0 + ai * HALF + m * 16) * D + col0);
#pragma unroll
                    for (int bj = 0; bj < 2; ++bj) { f32x4 x0, x1;
                        if constexpr (X16IN) { const u32x4 w = *(const u32x4*)(xbt + ro + bj * HALF); x0 = (f32x4){bflo(w.x), bfhi(w.x), bflo(w.y), bfhi(w.y)}; x1 = (f32x4){bflo(w.z), bfhi(w.z), bflo(w.w), bfhi(w.w)}; }
                        else { x0 = *(const f32x4*)(srt + ro + bj * HALF); x1 = *(const f32x4*)(srt + ro + bj * HALF + 4); }
                        x0 += gv[bj][0] * acc[ai][bj][m][0]; x1 += gv[bj][1] * acc[ai][bj][m][1];
                        u32x4 o; o.x = cvt_pk_bf16(x0[0], x0[1]); o.y = cvt_pk_bf16(x0[2], x0[3]); o.z = cvt_pk_bf16(x1[0], x1[1]); o.w = cvt_pk_bf16(x1[2], x1[3]);
                        *(u32x4*)(xbt + ro + bj * HALF) = o; } }
        } else {
            const size_t t0 = (size_t)(u.pm - 256) * BM * D;
#pragma unroll
            for (int ai = 0; ai < 2; ++ai)
#pragma unroll
                for (int m = 0; m < 4; ++m) { const unsigned ro = (unsigned)t0 + (unsigned)((row0 + ai * HALF + m * 16) * D + col0);
#pragma unroll
                    for (int bj = 0; bj < 2; ++bj)
#pragma unroll
                        for (int n = 0; n < 2; ++n) { const f32x4 x = *(const f32x4*)(srcC + ro + bj * HALF + n * 4);
                            *(f32x4*)(dstC + ro + bj * HALF + n * 4) = x + gv[bj][n] * acc[ai][bj][m][n]; } }
        }
    }
};

template <bool GATH, class ORD, bool F8, bool O8 = F8>
struct PolG {
    static constexpr bool PERM = true, GATHER = GATH, FP8 = F8; static constexpr int EREP = GATH ? EREP_GM : EREP_G;
    static constexpr int ES = F8 ? 1 : 2;
    ORD S; const void* A; const void* B; void* H; const int* tok; const int* tile_e; int tile0;
    __device__ __forceinline__ bool next(int i, Unit& u) const { return S.next(i, u); }
    __device__ __forceinline__ const char* abase(const Unit& u) const { return GATH ? (const char*)A : (const char*)A + (unsigned)u.pm * (unsigned)(BM * D * ES); }
    __device__ __forceinline__ const char* bbase(const Unit& u) const { const unsigned e = GATH ? (unsigned)tile_e[tile0 + u.pm] : 0u; return (const char*)B + (e * (unsigned)(2 * DFF) + (unsigned)u.pn * BM) * (unsigned)(D * ES); }
    __device__ __forceinline__ int arow(const Unit& u, int r) const { return tok[(tile0 + u.pm) * BM + r]; }
    __device__ __forceinline__ void epi(const AccT& acc, const Unit& u, int wr, int wc, int fr, int fq) const {
        const int row0 = u.pm * BM + wr * 64 + fr, c0 = u.pn * HALF + wc * 32 + 8 * fq;
        constexpr float isc = F8 ? 1.0f / (F8_ACT * F8_W) : 1.0f;
#pragma unroll
        for (int ai = 0; ai < 2; ++ai)
#pragma unroll
            for (int m = 0; m < 4; ++m) {
                float h[8];
#pragma unroll
                for (int n = 0; n < 2; ++n)
#pragma unroll
                    for (int j = 0; j < 4; ++j) { const float g = acc[ai][0][m][n][j] * isc, up = acc[ai][1][m][n][j] * isc; h[n * 4 + j] = silu_f(g) * up; }
                const size_t ro = (size_t)(row0 + ai * HALF + m * 16) * DFF + c0;
                if constexpr (O8) { u32x2 w; w.x = pk4_fp8(h[0] * F8_HID, h[1] * F8_HID, h[2] * F8_HID, h[3] * F8_HID); w.y = pk4_fp8(h[4] * F8_HID, h[5] * F8_HID, h[6] * F8_HID, h[7] * F8_HID);
                    *(u32x2*)((fp8_t*)H + ro) = w; }
                else { u32x4 w; w.x = cvt_pk_bf16(h[0], h[1]); w.y = cvt_pk_bf16(h[2], h[3]); w.z = cvt_pk_bf16(h[4], h[5]); w.w = cvt_pk_bf16(h[6], h[7]);
                    *(u32x4*)((bf16_t*)H + ro) = w; } }
    }
};

constexpr int NQK_UNITS = (MROWS / BM) * 5;
constexpr float QSCALE = 0.18033688011112042f;
struct PolQKV {
    static constexpr bool PERM = false, GATHER = false, FP8 = false; static constexpr int EREP = EREP_QKV;
    TileOrder S; const bf16_t* HX; const bf16_t* W; unsigned char* ws; const float* qkg  ; const float* ropec; const float* ropes;
    __device__ __forceinline__ bool next(int i, Unit& u) const {
        const int L = i * S.G + S.c;
        if (L < NQK_UNITS) return S.next(i, u);
        if (L < NQK_UNITS + MROWS / BM) { u.pm = L - NQK_UNITS; u.pn = 5; return true; }
        return false;
    }
    __device__ __forceinline__ const char* abase(const Unit& u) const { return u.pn == 5 ? (const char*)W + (unsigned)(1280 * D * 2) : (const char*)HX + (unsigned)u.pm * (unsigned)(BM * D * 2); }
    __device__ __forceinline__ const char* bbase(const Unit& u) const { return u.pn == 5 ? (const char*)HX + (unsigned)u.pm * (unsigned)(BM * D * 2) : (const char*)W + (unsigned)u.pn * (unsigned)(BM * D * 2); }
    __device__ __forceinline__ int arow(const Unit&, int) const { return 0; }
    __device__ __forceinline__ void epi(const AccT& acc, const Unit& u, int wr, int wc, int fr, int fq) const {
        if (u.pn == 5) {
            const bool lat = u.pm < 256;
            bf16_t* base = (bf16_t*)(ws + OFF_V) + (lat ? (size_t)(u.pm >> 4) * 256 * SEQ + (u.pm & 15) * 256 : (size_t)NB * 256 * SEQ + (size_t)(u.pm - 256) * 256 * LCTX);
            const int Lrow = lat ? SEQ : LCTX;
            const int f0 = wr * 64 + fr, p0 = wc * 32 + 8 * (fq & 1) + 4 * (fq >> 1);
#pragma unroll
            for (int ai = 0; ai < 2; ++ai)
#pragma unroll
                for (int m = 0; m < 4; ++m) { bf16_t* rowp = base + (size_t)(f0 + ai * HALF + m * 16) * Lrow + p0;
#pragma unroll
                    for (int bj = 0; bj < 2; ++bj)
#pragma unroll
                        for (int n = 0; n < 2; ++n) { const f32x4 v = acc[ai][bj][m][n]; u32x2 w; w.x = cvt_pk_bf16(v[0], v[1]); w.y = cvt_pk_bf16(v[2], v[3]);
                            *(u32x2*)(rowp + bj * HALF + n * 16) = w; } }
            return;
        }
        const int tile = u.pn; const bool ctxrow = u.pm >= 256;
        if (tile < 4 && ctxrow) return;
        const float* gsrc = qkg + (tile < 4 ? 0 : 64);
        const float osc = tile < 4 ? QSCALE : 1.0f;
        f32x4 gv[2][2];
#pragma unroll
        for (int bj = 0; bj < 2; ++bj)
#pragma unroll
            for (int n = 0; n < 2; ++n) gv[bj][n] = *(const f32x4*)(gsrc + 32 * bj + 16 * n + 4 * fq);
#pragma unroll
        for (int ai = 0; ai < 2; ++ai)
#pragma unroll
            for (int m = 0; m < 4; ++m) {
                const int r = u.pm * BM + ai * HALF + wr * 64 + m * 16 + fr;
                f32x4 v[2][2];
#pragma unroll
                for (int bj = 0; bj < 2; ++bj)
#pragma unroll
                    for (int n = 0; n < 2; ++n) v[bj][n] = acc[ai][bj][m][n];
                float ss = 0.f;
#pragma unroll
                for (int bj = 0; bj < 2; ++bj)
#pragma unroll
                    for (int n = 0; n < 2; ++n) ss += v[bj][n][0] * v[bj][n][0] + v[bj][n][1] * v[bj][n][1] + v[bj][n][2] * v[bj][n][2] + v[bj][n][3] * v[bj][n][3];
                ss += __shfl_xor(ss, 16); ss += __shfl_xor(ss, 32);
                const float rs = rsqrtf(ss * (1.0f / 64.0f) + EPS) * osc;
#pragma unroll
                for (int bj = 0; bj < 2; ++bj)
#pragma unroll
                    for (int n = 0; n < 2; ++n) v[bj][n] = v[bj][n] * rs * gv[bj][n];
                if (!ctxrow) {
                    const int l = r & (SEQ - 1), prow = l >> 6, pcol = l & 63;
#pragma unroll
                    for (int bj = 0; bj < 2; ++bj) { const int pp = bj ? pcol : prow;
                        const f32x4 cs = *(const f32x4*)(ropec + pp * 16 + 4 * fq), sn = *(const f32x4*)(ropes + pp * 16 + 4 * fq);
                        const f32x4 s1 = v[bj][0], s2 = v[bj][1];
                        v[bj][0] = s1 * cs - s2 * sn; v[bj][1] = s1 * sn + s2 * cs; }
                }
                const size_t doff = tile < 4 ? OFF_Q + ((size_t)r * D + (tile * 4 + wc) * 64) * 2 : OFF_K + ((size_t)r * 256 + wc * 64) * 2;
                bf16_t* dst = (bf16_t*)(ws + doff);
#pragma unroll
                for (int bj = 0; bj < 2; ++bj)
#pragma unroll
                    for (int n = 0; n < 2; ++n) { u32x2 w; w.x = cvt_pk_bf16(v[bj][n][0], v[bj][n][1]); w.y = cvt_pk_bf16(v[bj][n][2], v[bj][n][3]);
                        *(u32x2*)(dst + 32 * bj + 16 * n + 4 * fq) = w; }
            }
    }
};

struct PolD {
    static constexpr bool PERM = true, GATHER = false, FP8 = true; static constexpr int EREP = EREP_D;
    LinOrder<4> S; const fp8_t* A; const fp8_t* B; bf16_t* Y; const float* gw; const int* tile_e; int tile0;
    __device__ __forceinline__ bool next(int i, Unit& u) const { return S.next(i, u); }
    __device__ __forceinline__ const char* abase(const Unit& u) const { return (const char*)A + (size_t)(unsigned)u.pm * (size_t)(BM * DFF); }
    __device__ __forceinline__ const char* bbase(const Unit& u) const { const unsigned e = (unsigned)tile_e[tile0 + u.pm]; return (const char*)B + (e * (unsigned)D + (unsigned)u.pn * BM) * (unsigned)DFF; }
    __device__ __forceinline__ int arow(const Unit&, int) const { return 0; }
    __device__ __forceinline__ void epi(const AccT& acc, const Unit& u, int wr, int wc, int fr, int fq) const {
        const int slot0 = (tile0 + u.pm) * BM + wr * 64 + fr, c0 = u.pn * BM + wc * 32 + 8 * fq;
#pragma unroll
        for (int ai = 0; ai < 2; ++ai)
#pragma unroll
            for (int m = 0; m < 4; ++m) { const int slot = slot0 + ai * HALF + m * 16; const float g = gw[slot] * (1.0f / (F8_HID * F8_W)); bf16_t* rowp = Y + (size_t)slot * D + c0;
#pragma unroll
                for (int bj = 0; bj < 2; ++bj) { const f32x4 v0 = acc[ai][bj][m][0] * g, v1 = acc[ai][bj][m][1] * g;
                    u32x4 w; w.x = cvt_pk_bf16(v0[0], v0[1]); w.y = cvt_pk_bf16(v0[2], v0[3]); w.z = cvt_pk_bf16(v1[0], v1[1]); w.w = cvt_pk_bf16(v1[2], v1[3]);
                    *(u32x4*)(rowp + bj * HALF) = w; } }
    }
};

enum { RM_OFF = 0, RM_GU_G = 1, RM_GU_U = 2, RM_QKV = 3 };
template <int RM> __device__ __forceinline__ int rowmap(int n, int off) {
    if (RM == RM_GU_G) return (n >> 7) * 256 + (n & 127);
    if (RM == RM_GU_U) return (n >> 7) * 256 + 128 + (n & 127);
    if (RM == RM_QKV) { const int tile = n >> 8, f = n & 255, hh = f >> 6, d = f & 63, bj = d >> 5, q = d & 31; return tile * 256 + 128 * bj + 32 * hh + q; }
    return n + off;
}
template <int RM>
__device__ __forceinline__ void tconv(const float* __restrict__ src, int Ks, int ldn, int c0, int ncols, bf16_t* __restrict__ dst, int off, LAS unsigned char* lds, int start, int stride) {
    LAS bf16_t* T = (LAS bf16_t*)lds;
    const int tid = otid(), nkt = Ks >> 6, ntile = nkt * (ncols >> 6);
    for (int t = start; t < ntile; t += stride) {
        const int kt = t % nkt, ntl = t / nkt, k0 = kt * 64, n0 = ntl * 64;
        const int kk = tid >> 4, n4 = (tid & 15) * 4;
#pragma unroll
        for (int i = 0; i < 2; ++i) { const int k = kk + 32 * i;
            const f32x4 v = *(const f32x4*)(src + (size_t)(k0 + k) * ldn + c0 + n0 + n4);
#pragma unroll
            for (int j = 0; j < 4; ++j) T[(n4 + j) * 72 + k] = f2bf(v[j]); }
        __syncthreads();
        { const int n = tid >> 3, k8 = (tid & 7) * 8;
          const u32x4 w = *(const LAS u32x4*)(T + n * 72 + k8);
          *(u32x4*)(dst + (size_t)rowmap<RM>(n0 + n, off) * Ks + k0 + k8) = w; }
        __syncthreads();
    }
}

template <int RM>
__device__ __forceinline__ void tconv8(const float* __restrict__ src, int Ks, int ldn, int c0, int ncols, fp8_t* __restrict__ dst, int off, LAS unsigned char* lds, int start, int stride) {
    LAS fp8_t* T = (LAS fp8_t*)lds;
    const int tid = otid(), nkt = Ks >> 6, ntile = nkt * (ncols >> 6);
    for (int t = start; t < ntile; t += stride) {
        const int kt = t % nkt, ntl = t / nkt, k0 = kt * 64, n0 = ntl * 64;
        const int kk = tid >> 4, n4 = (tid & 15) * 4;
#pragma unroll
        for (int i = 0; i < 2; ++i) { const int k = kk + 32 * i;
            const f32x4 v = *(const f32x4*)(src + (size_t)(k0 + k) * ldn + c0 + n0 + n4);
            const unsigned w = pk4_fp8(v[0] * F8_W, v[1] * F8_W, v[2] * F8_W, v[3] * F8_W);
#pragma unroll
            for (int j = 0; j < 4; ++j) T[(n4 + j) * 80 + k] = (fp8_t)(w >> (8 * j)); }
        __syncthreads();
        if (tid < 256) { const int n = tid >> 2, k16 = (tid & 3) * 16;
          const u32x4 w = *(const LAS u32x4*)(T + n * 80 + k16);
          *(u32x4*)(dst + (size_t)rowmap<RM>(n0 + n, off) * Ks + k0 + k16) = w; }
        __syncthreads();
    }
}

template <int RM>
__device__ __forceinline__ void tconv8_tile(const float* __restrict__ src, int Ks, int ldn, fp8_t* __restrict__ dst, LAS unsigned char* lds, int t) {
    LAS fp8_t* T = (LAS fp8_t*)lds;
    const int tid = otid(), nkt = Ks >> 6;
    const int kt = t % nkt, ntl = t / nkt, k0 = kt * 64, n0 = ntl * 64;
    const int kk = tid >> 4, n4 = (tid & 15) * 4;
#pragma unroll
    for (int i = 0; i < 2; ++i) { const int k = kk + 32 * i;
        const f32x4 v = *(const f32x4*)(src + (size_t)(k0 + k) * ldn + n0 + n4);
        const unsigned w = pk4_fp8(v[0] * F8_W, v[1] * F8_W, v[2] * F8_W, v[3] * F8_W);
#pragma unroll
        for (int j = 0; j < 4; ++j) T[(n4 + j) * 80 + k] = (fp8_t)(w >> (8 * j)); }
    __syncthreads();
    if (tid < 256) { const int n = tid >> 2, k16 = (tid & 3) * 16;
      const u32x4 w = *(const LAS u32x4*)(T + n * 80 + k16);
      *(u32x4*)(dst + (size_t)rowmap<RM>(n0 + n, 0) * Ks + k0 + k16) = w; }
    __syncthreads();
}
constexpr int MOE_CONV_TILES = NE * 2688;
struct CvJob { const float* src; fp8_t* dst; int ldn, Ks, rm, n0; };
__device__ __forceinline__ CvJob cv_decode(int q, const float* __restrict__ wg, const float* __restrict__ wu, const float* __restrict__ wd, fp8_t* __restrict__ MGU, fp8_t* __restrict__ MD) {
    CvJob j; const int e = q / 2688, r = q - e * 2688; int kt, ntl;
    if (r < 1792) { const int up = r >= 896, t = r - (up ? 896 : 0); j.src = (up ? wu : wg) + (size_t)e * D * DFF; j.dst = MGU + (size_t)e * 2 * DFF * D; j.ldn = DFF; j.Ks = 1024; j.rm = 1 + up; kt = t & 15; ntl = t >> 4; }
    else { const int t = r - 1792; j.src = wd + (size_t)e * DFF * D; j.dst = MD + (size_t)e * D * DFF; j.ldn = 1024; j.Ks = DFF; j.rm = 0; kt = t % 56; ntl = t / 56; }
    j.n0 = ntl * 64; j.src += (size_t)(kt * 64) * j.ldn + j.n0; j.dst += kt * 64;
    return j;
}
__device__ __forceinline__ void moe_conv_groups(const float* __restrict__ wg, const float* __restrict__ wu, const float* __restrict__ wd, fp8_t* __restrict__ MGU, fp8_t* __restrict__ MD,
                                                LAS unsigned char* lds, int gb, int ge, int gs) {
    if (gb >= ge) return;
    const int tid = otid(), kk = tid >> 4, n4 = (tid & 15) * 4;
    f32x4 v[8], vn[8];
    CvJob cj = cv_decode(4 * gb, wg, wu, wd, MGU, MD), nj = cj;
    { const float* p = cj.src + (size_t)(8 * kk) * cj.ldn + n4;
#pragma unroll
      for (int i = 0; i < 8; ++i) v[i] = *(const f32x4*)(p + (size_t)i * cj.ldn); }
    for (int g = gb; g < ge; g += gs) {
        const bool more = g + gs < ge;
        if (more) { nj = cv_decode(4 * (g + gs), wg, wu, wd, MGU, MD); const float* p = nj.src + (size_t)(8 * kk) * nj.ldn + n4;
#pragma unroll
            for (int i = 0; i < 8; ++i) vn[i] = *(const f32x4*)(p + (size_t)i * nj.ldn); }
#pragma unroll
        for (int j = 0; j < 4; ++j) { u32x2 w; w.x = pk4_fp8(v[0][j] * F8_W, v[1][j] * F8_W, v[2][j] * F8_W, v[3][j] * F8_W); w.y = pk4_fp8(v[4][j] * F8_W, v[5][j] * F8_W, v[6][j] * F8_W, v[7][j] * F8_W);
            *(LAS u32x2*)(lds + (n4 + j) * 272 + 8 * kk) = w; }
        __syncthreads();
#pragma unroll
        for (int i2 = 0; i2 < 2; ++i2) { const int n = (tid >> 4) + 32 * i2, k16 = (tid & 15) * 16, nn = cj.n0 + n;
            const u32x4 w = *(const LAS u32x4*)(lds + n * 272 + k16);
            const int orow = cj.rm == 0 ? nn : ((nn >> 7) * 256 + (nn & 127) + (cj.rm == 2 ? 128 : 0));
            *(u32x4*)(cj.dst + (size_t)orow * cj.Ks + k16) = w; }
        __syncthreads();
        if (more) { cj = nj;
#pragma unroll
            for (int i = 0; i < 8; ++i) v[i] = vn[i]; }
    }
}

__device__ __forceinline__ void fold_job(const float* __restrict__ w_in, bf16_t* __restrict__ WinT, LAS unsigned char* lds) {
    LAS float* W = (LAS float*)lds;
    LAS float* cs = W + 1024; LAS float* sn = cs + 128;
    const int tid = otid();
    if (tid < 128) { cs[tid] = cospif((float)tid / 64.0f); sn[tid] = sinpif((float)tid / 64.0f); }
    for (int it = blockIdx.x; it < 512; it += gridDim.x) {
        const int kb = it >> 2, g = it & 3;
        __syncthreads();
        { const int r = tid >> 6, c2 = (tid & 63) * 2; const f32x2 v = *(const f32x2*)(w_in + (size_t)(kb * 8 + r) * 2048 + g * 128 + c2); W[r * 128 + c2] = v.x; W[r * 128 + c2 + 1] = v.y; }
        __syncthreads();
        const int m = tid & 127, part = (tid >> 7) & 1, rh = tid >> 8;
        float a0 = 0.f, a1 = 0.f, a2 = 0.f, a3 = 0.f;
        for (int d = 0; d < 128; ++d) { const int idx = (m * d) & 127; const float tw = part ? sn[idx] : cs[idx];
            a0 += W[(rh * 4 + 0) * 128 + d] * tw; a1 += W[(rh * 4 + 1) * 128 + d] * tw; a2 += W[(rh * 4 + 2) * 128 + d] * tw; a3 += W[(rh * 4 + 3) * 128 + d] * tw; }
        u32x2 w; w.x = cvt_pk_bf16(a0, a1); w.y = cvt_pk_bf16(a2, a3);
        *(u32x2*)(WinT + (size_t)(2 * (g * 128 + m) + part) * D + kb * 8 + rh * 4) = w;
    }
    __syncthreads();
}

__device__ __forceinline__ void dft_job(bf16_t* __restrict__ DFTc, float* __restrict__ TW, LAS unsigned char* lds) {
    const int tid = otid();
    for (int idx = blockIdx.x * 512 + tid; idx < 256 * 512; idx += gridDim.x * 512) {
        const int k = idx >> 9, lp = idx & 511, kl = (k * (lp & 255)) & 255;
        const float v = lp < 256 ? cospif((float)kl / 128.0f) : -sinpif((float)kl / 128.0f);
        DFTc[idx] = f2bf(v);
    }
    for (int idx = blockIdx.x * 512 + tid; idx < 4096; idx += gridDim.x * 512) {
        const int l2 = idx >> 6, k1 = idx & 63; const float a = (float)(k1 * l2) / 2048.0f;
        TW[idx] = cospif(a); TW[4096 + idx] = sinpif(a);
    }
}

__device__ __forceinline__ void ada_job(const float* __restrict__ c, const float* __restrict__ c_ctx, const float* __restrict__ ada_w, const float* __restrict__ ada_b, float* __restrict__ MOD, LAS unsigned char* lds) {
    LAS float* sc = (LAS float*)lds;
    LAS float* red = sc + 17 * 1024;
    const int tid = otid();
    for (int i = tid; i < 17 * 1024; i += 512) { const float x = i < 16 * 1024 ? c[i] : c_ctx[i - 16 * 1024]; sc[i] = silu_f(x); }
    __syncthreads();
    for (int chunk = blockIdx.x; chunk < 256; chunk += gridDim.x) {
        const int layer = chunk >> 7, n0 = (chunk & 127) * 48;
        const float* wp = ada_w + (size_t)layer * D * NMOD + n0;
        const int col = tid % 48, kg = tid / 48;
        if (kg < 10) {
            float a[17];
#pragma unroll
            for (int r = 0; r < 17; ++r) a[r] = 0.f;
            for (int k = kg; k < D; k += 80) { float w8[8];
#pragma unroll
                for (int u = 0; u < 8; ++u) { const int kk = k + 10 * u; w8[u] = kk < D ? wp[(size_t)kk * NMOD + col] : 0.f; }
#pragma unroll
                for (int u = 0; u < 8; ++u) { const int kk = k + 10 * u; if (kk < D) {
#pragma unroll
                    for (int r = 0; r < 17; ++r) a[r] += sc[r * 1024 + kk] * w8[u]; } } }
#pragma unroll
            for (int r = 0; r < 17; ++r) red[(kg * 17 + r) * 48 + col] = a[r];
        }
        __syncthreads();
        for (int o = tid; o < 17 * 48; o += 512) { const int r = o / 48, cc = o % 48; float s = ada_b[layer * NMOD + n0 + cc];
#pragma unroll
            for (int g = 0; g < 10; ++g) s += red[(g * 17 + r) * 48 + cc];
            MOD[((size_t)layer * 17 + r) * NMOD + n0 + cc] = s; }
        __syncthreads();
    }
}

__device__ __forceinline__ void h3_job(const float* __restrict__ w0, const float* __restrict__ b0, const float* __restrict__ w1, const float* __restrict__ b1,
                                       const float* __restrict__ w2, const float* __restrict__ b2, const float* __restrict__ freq, float* __restrict__ H3) {
    const int tid = otid(), lane = tid & 63, wv = blockIdx.x * 8 + (tid >> 6), nw = gridDim.x * 8;
    const float fr = freq[lane];
    for (int p = wv; p < 4352; p += nw) {
        const int L = p < 4096 ? 4096 : 256, pos = p < 4096 ? p : p - 4096;
        const float t = (float)pos / (float)(L - 1);
        const float w = (float)(2.0 * 3.14159265358979323846 / (double)L) * (float)pos;
        const float band = 1e-4f + (float)(lane & 15) * ((15.0f - 1e-4f) / 15.0f);
        const float ang = w * band;
        const float cz = cosf(ang), sz = -sinf(ang);
        float a = t * w0[lane] + b0[lane];
#pragma unroll
        for (int b = 0; b < 16; ++b) a += __shfl(cz, b) * w0[(1 + b) * 64 + lane] + __shfl(sz, b) * w0[(17 + b) * 64 + lane];
        const float h1 = sinf(fr * a);
        float a2 = b1[lane];
#pragma unroll 8
        for (int i = 0; i < 64; ++i) a2 += __shfl(h1, i) * w1[i * 64 + lane];
        const float h2 = sinf(fr * a2);
        float a3 = b2[lane];
#pragma unroll 8
        for (int i = 0; i < 64; ++i) a3 += __shfl(h2, i) * w2[i * 64 + lane];
        H3[(size_t)p * 64 + lane] = sinf(fr * a3);
    }
}

template <int L>
__device__ __forceinline__ void filt_fin(const float* __restrict__ H3, const float* __restrict__ w3, float* __restrict__ KFo, int cp, LAS unsigned char* lds) {
    LAS float* F = (LAS float*)lds;
    LAS float* Bk = F + 2 * L;
    LAS float* w3c = Bk + 2 * L;
    LAS float* red = w3c + 256;
    const int tid = otid(), lane = tid & 63, wid = tid >> 6;
    const int c0 = cp * 2;
    __syncthreads();
    if (tid < 256) { const int which = tid & 3, j = tid >> 2; w3c[tid] = w3[(size_t)j * 1024 + (which >> 1) * 512 + c0 + (which & 1)]; }
    __syncthreads();
    const float la = -3.0701134573253945f, lb = -15.350567286626973f;
    float dl[2];
#pragma unroll
    for (int cc = 0; cc < 2; ++cc) dl[cc] = fabsf(la + (float)(c0 + cc) * ((lb - la) / 511.0f));
    float ss0 = 0.f, ss1 = 0.f;
    for (int pos = tid; pos < L; pos += 512) {
        const float* hp = H3 + (size_t)pos * 64;
        asm volatile("" ::: "memory");
        f32x4 sv = (f32x4){0.f, 0.f, 0.f, 0.f};
#pragma unroll 4
        for (int j4 = 0; j4 < 16; ++j4) { const f32x4 h = *(const f32x4*)(hp + j4 * 4);
#pragma unroll
            for (int e = 0; e < 4; ++e) sv += h[e] * *(const LAS f32x4*)(w3c + (j4 * 4 + e) * 4); }
        const float s[4] = {sv[0], sv[1], sv[2], sv[3]};
        const float t = (float)pos / (float)(L - 1);
        const float d0 = __expf(-t * dl[0]), d1 = __expf(-t * dl[1]);
        const float f0 = s[0] * d0, f1 = s[1] * d1, g0 = s[2] * d0, g1 = s[3] * d1;
        F[pos] = f0; F[L + pos] = f1; Bk[pos] = g0; Bk[L + pos] = g1;
        ss0 += f0 * f0 + (pos >= 1 ? g0 * g0 : 0.f); ss1 += f1 * f1 + (pos >= 1 ? g1 * g1 : 0.f);
    }
    ss0 = wave_sum(ss0); ss1 = wave_sum(ss1);
    if (lane == 0) { red[wid] = ss0; red[8 + wid] = ss1; }
    __syncthreads();
    float n0 = 0.f, n1 = 0.f;
#pragma unroll
    for (int i = 0; i < 8; ++i) { n0 += red[i]; n1 += red[8 + i]; }
    const float nr[2] = {rsqrtf(n0 + EPS), rsqrtf(n1 + EPS)};
    if constexpr (L == SEQ) {
        bf16_t* RC = (bf16_t*)KFo;
#pragma unroll
        for (int cc = 0; cc < 2; ++cc)
            for (int i2 = tid; i2 < 4 * 4096; i2 += 512) { const int m = i2 >> 12, idx = (i2 & 4095) * 2; float v[2];
#pragma unroll
                for (int e = 0; e < 2; ++e) { const int d = L + m + 4 - (idx + e);
                    v[e] = (d >= L || d <= -L) ? 0.f : (d >= 0 ? F[cc * L + d] : Bk[cc * L - d]) * nr[cc]; }
                *(unsigned*)(RC + ((size_t)(c0 + cc) * 4 + m) * 8192 + idx) = cvt_pk_bf16(v[0], v[1]); }
    } else {
#pragma unroll
        for (int cc = 0; cc < 2; ++cc)
            for (int idx = tid; idx < 2 * L; idx += 512) { const int d = idx - L;
                const float v = d >= 0 ? F[cc * L + d] : (d > -L ? Bk[cc * L - d] : 0.f);
                KFo[(size_t)(c0 + cc) * (2 * L) + idx] = v * nr[cc]; }
    }
    __syncthreads();
}

template <bool ROUTE, bool OUT8 = ROUTE, bool SRC16 = false>
__device__ __forceinline__ void norm_phase(const void* __restrict__ srcL_, const float* __restrict__ srcC, int nrows, const float* __restrict__ g, const float* __restrict__ modl  ,
                                           int shift_idx, bf16_t* __restrict__ HX, const float* __restrict__ wrt, unsigned* __restrict__ route, int* __restrict__ hist, LAS unsigned char* lds) {
    const int tid = otid(), lane = tid & 63, wid = tid >> 6;
    LAS int* lh = (LAS int*)lds;
    if (ROUTE) { if (tid < 8) lh[tid] = 0; __syncthreads(); }
    f32x4 rw[ROUTE ? 16 : 1][2];
    if constexpr (ROUTE) {
#pragma unroll
        for (int i = 0; i < 2; ++i)
#pragma unroll
            for (int q = 0; q < 2; ++q)
#pragma unroll
                for (int j = 0; j < 4; ++j) { const int k = i * 512 + lane * 8 + q * 4 + j; rw[(i * 2 + q) * 4 + j][0] = *(const f32x4*)(wrt + (size_t)k * 8); rw[(i * 2 + q) * 4 + j][1] = *(const f32x4*)(wrt + (size_t)k * 8 + 4); }
    }
    const int nwv = gridDim.x * 8, gw = blockIdx.x * 8 + wid, rpw = (nrows + nwv - 1) / nwv;
    const int r0 = gw * rpw, r1 = (r0 + rpw) < nrows ? (r0 + rpw) : nrows;
    f32x4 Am[4], Sh[4]; int curb = -1;
#pragma unroll
    for (int i = 0; i < 4; ++i) { Am[i] = (f32x4){0.f, 0.f, 0.f, 0.f}; Sh[i] = Am[i]; }
    f32x4 nraw[4];
#define NORM_LOAD(rr) do { if (SRC16 && (rr) < NTOK) { const bf16_t* xq_ = (const bf16_t*)srcL_ + (size_t)(rr) * D; \
            nraw[0] = __builtin_bit_cast(f32x4, *(const u32x4*)(xq_ + lane * 8)); nraw[1] = __builtin_bit_cast(f32x4, *(const u32x4*)(xq_ + 512 + lane * 8)); } \
        else { const float* xp_ = (rr) < NTOK ? (const float*)srcL_ + (size_t)(rr) * D : srcC + (size_t)((rr) - NTOK) * D; \
            nraw[0] = *(const f32x4*)(xp_ + lane * 8); nraw[1] = *(const f32x4*)(xp_ + lane * 8 + 4); nraw[2] = *(const f32x4*)(xp_ + 512 + lane * 8); nraw[3] = *(const f32x4*)(xp_ + 512 + lane * 8 + 4); } } while (0)
    if (r0 < r1) NORM_LOAD(r0);
    for (int r = r0; r < r1; ++r) {
        f32x4 x[4];
        if (SRC16 && r < NTOK) {
#pragma unroll
            for (int i = 0; i < 2; ++i) { const u32x4 w = __builtin_bit_cast(u32x4, nraw[i]);
                x[2 * i] = (f32x4){bflo(w.x), bfhi(w.x), bflo(w.y), bfhi(w.y)}; x[2 * i + 1] = (f32x4){bflo(w.z), bfhi(w.z), bflo(w.w), bfhi(w.w)}; }
        } else {
#pragma unroll
            for (int i = 0; i < 4; ++i) x[i] = nraw[i];
        }
        const int bidx = r < NTOK ? (r >> 12) : 16;
        if (bidx != curb) {
            curb = bidx; const float* mp = modl + (size_t)bidx * NMOD + shift_idx * D;
#pragma unroll
            for (int i = 0; i < 2; ++i)
#pragma unroll
                for (int q = 0; q < 2; ++q) { const int o = i * 512 + lane * 8 + q * 4;
                    Sh[2 * i + q] = *(const f32x4*)(mp + o); Am[2 * i + q] = *(const f32x4*)(g + o) * (1.0f + *(const f32x4*)(mp + D + o)); }
        }
        if (r + 1 < r1) NORM_LOAD(r + 1);
        float ss = 0.f;
#pragma unroll
        for (int i = 0; i < 4; ++i) ss += x[i][0] * x[i][0] + x[i][1] * x[i][1] + x[i][2] * x[i][2] + x[i][3] * x[i][3];
        ss = wave_sum(ss);
        const float rs = rsqrtf(ss * (1.0f / 1024.0f) + EPS);
        f32x4 h[4];
#pragma unroll
        for (int i = 0; i < 4; ++i) h[i] = (x[i] * rs) * Am[i] + Sh[i];
        if constexpr (OUT8) {
#pragma unroll
            for (int i = 0; i < 2; ++i) { u32x2 w; w.x = pk4_fp8(h[2 * i][0] * F8_ACT, h[2 * i][1] * F8_ACT, h[2 * i][2] * F8_ACT, h[2 * i][3] * F8_ACT);
                w.y = pk4_fp8(h[2 * i + 1][0] * F8_ACT, h[2 * i + 1][1] * F8_ACT, h[2 * i + 1][2] * F8_ACT, h[2 * i + 1][3] * F8_ACT);
                *(u32x2*)((fp8_t*)HX + (size_t)r * D + i * 512 + lane * 8) = w; }
        } else {
#pragma unroll
        for (int i = 0; i < 2; ++i) { u32x4 w; w.x = cvt_pk_bf16(h[2 * i][0], h[2 * i][1]); w.y = cvt_pk_bf16(h[2 * i][2], h[2 * i][3]); w.z = cvt_pk_bf16(h[2 * i + 1][0], h[2 * i + 1][1]); w.w = cvt_pk_bf16(h[2 * i + 1][2], h[2 * i + 1][3]);
            *(u32x4*)(HX + (size_t)r * D + i * 512 + lane * 8) = w; }
        }
        if (ROUTE) {
            float lg[8];
#pragma unroll
            for (int e = 0; e < 8; ++e) lg[e] = 0.f;
#pragma unroll
            for (int i = 0; i < 2; ++i)
#pragma unroll
                for (int q = 0; q < 2; ++q)
#pragma unroll
                    for (int j = 0; j < 4; ++j) { const float hv = h[2 * i + q][j];
                        const f32x4 wa = rw[(i * 2 + q) * 4 + j][0], wb = rw[(i * 2 + q) * 4 + j][1];
                        lg[0] += hv * wa[0]; lg[1] += hv * wa[1]; lg[2] += hv * wa[2]; lg[3] += hv * wa[3]; lg[4] += hv * wb[0]; lg[5] += hv * wb[1]; lg[6] += hv * wb[2]; lg[7] += hv * wb[3]; }
#pragma unroll
            for (int e = 0; e < 8; ++e) lg[e] = wave_sum(lg[e]);
            int e1 = 0; float v1 = lg[0];
#pragma unroll
            for (int e = 1; e < 8; ++e) if (lg[e] > v1) { v1 = lg[e]; e1 = e; }
            int e2 = -1; float v2 = -3.0e38f;
#pragma unroll
            for (int e = 0; e < 8; ++e) if (e != e1 && lg[e] > v2) { v2 = lg[e]; e2 = e; }
            const float g1 = 1.0f / (1.0f + __expf(v2 - v1)), g2 = 1.0f - g1;
            if (lane == 0) { u32x4 w; w.x = (unsigned)e1; w.y = (unsigned)e2; w.z = __float_as_uint(g1); w.w = __float_as_uint(g2); *(u32x4*)(route + (size_t)r * 4) = w;
                atomicAdd((int*)&lh[e1], 1); atomicAdd((int*)&lh[e2], 1); }
        }
    }
#undef NORM_LOAD
    if (ROUTE) { __syncthreads(); if (tid < 8) hist[blockIdx.x * 8 + tid] = lh[tid]; }
}

template <int L, int NBP>
__device__ __forceinline__ void hyena_pass(const bf16_t* __restrict__ UTb, bf16_t* __restrict__ HTb, int c, const float (&cw)[3][3], const float (&cb)[3], float bias,
                                           const LAS float* kf, LAS float* raw, LAS float* vx, LAS float* x0s) {
    const int tid = otid(), e0 = tid * 8, bb = e0 / L, t0 = e0 % L;
    constexpr int RS = L + 8;
#pragma unroll
    for (int j = 0; j < 3; ++j) {
        const u32x4 w = *(const u32x4*)(UTb + ((size_t)bb * UCH + 1024 + j * 512 + c) * L + t0);
        LAS float* rp = raw + (j * NBP + bb) * RS + 4 + t0;
        *(LAS f32x4*)rp = (f32x4){bflo(w.x), bfhi(w.x), bflo(w.y), bfhi(w.y)};
        *(LAS f32x4*)(rp + 4) = (f32x4){bflo(w.z), bfhi(w.z), bflo(w.w), bfhi(w.w)};
        if (t0 == 0) rp[-1] = 0.f;
        if (t0 == L - 8) rp[8] = 0.f;
    }
    __syncthreads();
    {
        float z[3][8];
#pragma unroll
        for (int j = 0; j < 3; ++j) { const LAS float* rp = raw + (j * NBP + bb) * RS + 4 + t0;
            float r[10];
#pragma unroll
            for (int i = 0; i < 10; ++i) r[i] = rp[i - 1];
#pragma unroll
            for (int i = 0; i < 8; ++i) z[j][i] = r[i] * cw[j][0] + r[i + 1] * cw[j][1] + r[i + 2] * cw[j][2] + cb[j]; }
#pragma unroll
        for (int i = 0; i < 8; ++i) { vx[bb * L + t0 + i] = z[0][i] * z[1][i]; x0s[bb * L + t0 + i] = z[2][i]; }
    }
    __syncthreads();
    float acc[8];
#pragma unroll
    for (int i = 0; i < 8; ++i) acc[i] = 0.f;
    for (int s0 = 0; s0 < L; s0 += 8) {
        const f32x4 va = *(const LAS f32x4*)(vx + bb * L + s0), vb = *(const LAS f32x4*)(vx + bb * L + s0 + 4);
        const float v[8] = {va[0], va[1], va[2], va[3], vb[0], vb[1], vb[2], vb[3]};
        const LAS float* kp = kf + (L + t0 - s0 - 8);
        float w[16];
#pragma unroll
        for (int q4 = 0; q4 < 4; ++q4) { const f32x4 t = *(const LAS f32x4*)(kp + q4 * 4); w[q4 * 4] = t[0]; w[q4 * 4 + 1] = t[1]; w[q4 * 4 + 2] = t[2]; w[q4 * 4 + 3] = t[3]; }
#pragma unroll
        for (int j = 0; j < 8; ++j)
#pragma unroll
            for (int i = 0; i < 8; ++i) acc[i] += w[8 + i - j] * v[j];
    }
    {
        float o[8];
#pragma unroll
        for (int i = 0; i < 8; ++i) o[i] = x0s[bb * L + t0 + i] * (acc[i] + bias * vx[bb * L + t0 + i]);
        u32x4 w; w.x = cvt_pk_bf16(o[0], o[1]); w.y = cvt_pk_bf16(o[2], o[3]); w.z = cvt_pk_bf16(o[4], o[5]); w.w = cvt_pk_bf16(o[6], o[7]);
        *(u32x4*)(HTb + ((size_t)bb * 512 + c) * L + t0) = w;
    }
    __syncthreads();
}

__device__ __forceinline__ unsigned f2_cs_byte(int r, int c) { return (unsigned)(r * 128 + ((((c >> 3) ^ ((r >> 1) & 7))) << 4) + (c & 7) * 2); }
__device__ __forceinline__ void f2_tr8(u32x2 (&o)[8], unsigned a0, unsigned a1, unsigned a2, unsigned a3, unsigned a4, unsigned a5, unsigned a6, unsigned a7) {
    asm volatile("ds_read_b64_tr_b16 %0, %8\n\tds_read_b64_tr_b16 %1, %9\n\tds_read_b64_tr_b16 %2, %10\n\tds_read_b64_tr_b16 %3, %11\n\t"
                 "ds_read_b64_tr_b16 %4, %12\n\tds_read_b64_tr_b16 %5, %13\n\tds_read_b64_tr_b16 %6, %14\n\tds_read_b64_tr_b16 %7, %15\n\ts_waitcnt lgkmcnt(0)"
                 : "=&v"(o[0]), "=&v"(o[1]), "=&v"(o[2]), "=&v"(o[3]), "=&v"(o[4]), "=&v"(o[5]), "=&v"(o[6]), "=&v"(o[7])
                 : "v"(a0), "v"(a1), "v"(a2), "v"(a3), "v"(a4), "v"(a5), "v"(a6), "v"(a7) : "memory");
}
__device__ __forceinline__ bf16x8 f2_frag(const u32x2& lo, const u32x2& hi) { return __builtin_bit_cast(bf16x8, (u32x4){lo.x, lo.y, hi.x, hi.y}); }
__device__ __forceinline__ bf16x8 f2_neg(const bf16x8& v) { u32x4 u = __builtin_bit_cast(u32x4, v); u.x ^= 0x80008000u; u.y ^= 0x80008000u; u.z ^= 0x80008000u; u.w ^= 0x80008000u; return __builtin_bit_cast(bf16x8, u); }

__device__ __forceinline__ void fourier2_phase(const bf16_t* __restrict__ UT, bf16_t* __restrict__ AT, const float* __restrict__ TW, LAS unsigned char* lds) {
    const int tid = otid(), lane = tid & 63, w = __builtin_amdgcn_readfirstlane(tid >> 6), r = lane & 31, h = lane >> 5;
    __syncthreads();
    for (int i = tid; i < 4096; i += 512) { const int rr = i >> 6, cc = i & 63; const float a = (float)((rr * cc) & 63) / 32.0f;
        *(LAS bf16_t*)(lds + f2_cs_byte(rr, cc)) = f2bf(cospif(a)); *(LAS bf16_t*)(lds + 8192 + f2_cs_byte(rr, cc)) = f2bf(sinpif(a)); }
    __syncthreads();
    LAS unsigned char* xr = lds + 16384 + w * 16384;
    const unsigned xb = (unsigned)(unsigned long)xr;
    const int q = (lane & 15) >> 2, pp = lane & 3, blk = (lane >> 4) & 1, qb = (q >> 1) & 1;
    const unsigned L0 = (unsigned)((8 * h + q) * 128 + (16 * blk + 4 * pp) * 2);
    const unsigned tb0 = xb + L0 + qb * 64, tb1 = xb + L0 + (1 - qb) * 64;
    const int nwv = gridDim.x * 8;
    for (int it = blockIdx.x * 8 + w; it < NB * 512; it += nwv) {
        const int b = it >> 9, m = it & 511;
        { const char* src = (const char*)(UT + ((size_t)b * UCH + 2 * m) * SEQ);
#pragma unroll
          for (int i = 0; i < 16; ++i) { const int row = (i & 7) * 8 + (lane >> 3), s2 = (lane & 7) ^ (4 * ((row >> 1) & 1));
              __builtin_amdgcn_global_load_lds((const unsigned*)(src + (i >> 3) * 8192 + (row * 64 + s2 * 8) * 2), (LAS unsigned*)(xr + i * 1024), 16, 0, 0); } }
        asm volatile("s_waitcnt vmcnt(0)" ::: "memory");
        f32x16 Yr[2][2], Yi[2][2];
#pragma unroll
        for (int a = 0; a < 2; ++a)
#pragma unroll
            for (int c = 0; c < 2; ++c)
#pragma unroll
                for (int e = 0; e < 16; ++e) { Yr[a][c][e] = 0.f; Yi[a][c][e] = 0.f; }
#pragma unroll
        for (int ks = 0; ks < 4; ++ks) {
            bf16x8 Cf[2], Sf[2];
#pragma unroll
            for (int kt = 0; kt < 2; ++kt) { const unsigned o = f2_cs_byte(32 * kt + r, 16 * ks + 8 * h); Cf[kt] = *(const LAS bf16x8*)(lds + o); Sf[kt] = *(const LAS bf16x8*)(lds + 8192 + o); }
            u32x2 t[8]; const unsigned ko = ks * 2048;
            f2_tr8(t, tb0 + ko, tb0 + ko + 512, tb1 + ko, tb1 + ko + 512, tb0 + ko + 8192, tb0 + ko + 8192 + 512, tb1 + ko + 8192, tb1 + ko + 8192 + 512);
            const bf16x8 Pf[2] = {f2_frag(t[0], t[1]), f2_frag(t[2], t[3])}, Qf[2] = {f2_frag(t[4], t[5]), f2_frag(t[6], t[7])};
            const bf16x8 Qn[2] = {f2_neg(Qf[0]), f2_neg(Qf[1])};
#pragma unroll
            for (int kt = 0; kt < 2; ++kt)
#pragma unroll
                for (int nt = 0; nt < 2; ++nt) {
                    Yr[kt][nt] = __builtin_amdgcn_mfma_f32_32x32x16_bf16(Cf[kt], Pf[nt], Yr[kt][nt], 0, 0, 0);
                    Yr[kt][nt] = __builtin_amdgcn_mfma_f32_32x32x16_bf16(Sf[kt], Qn[nt], Yr[kt][nt], 0, 0, 0);
                    Yi[kt][nt] = __builtin_amdgcn_mfma_f32_32x32x16_bf16(Sf[kt], Pf[nt], Yi[kt][nt], 0, 0, 0);
                    Yi[kt][nt] = __builtin_amdgcn_mfma_f32_32x32x16_bf16(Cf[kt], Qf[nt], Yi[kt][nt], 0, 0, 0);
                }
        }
#pragma unroll
        for (int nt = 0; nt < 2; ++nt) { const int l2 = 32 * nt + r;
#pragma unroll
            for (int kt = 0; kt < 2; ++kt)
#pragma unroll
                for (int eg = 0; eg < 4; ++eg) { const int k1 = 32 * kt + 8 * eg + 4 * h;
                    const f32x4 tc = *(const f32x4*)(TW + l2 * 64 + k1), ts = *(const f32x4*)(TW + 4096 + l2 * 64 + k1);
                    float yr[4], yi[4];
#pragma unroll
                    for (int j = 0; j < 4; ++j) { const float a = Yr[kt][nt][4 * eg + j], bneg = Yi[kt][nt][4 * eg + j];
                        yr[j] = a * tc[j] - bneg * ts[j]; yi[j] = -(a * ts[j] + bneg * tc[j]); }
                    const unsigned o = (unsigned)(l2 * 128 + ((kt ^ ((l2 >> 1) & 1)) * 64) + (8 * eg + 4 * h) * 2);
                    u32x2 wr_; wr_.x = cvt_pk_bf16(yr[0], yr[1]); wr_.y = cvt_pk_bf16(yr[2], yr[3]); *(LAS u32x2*)(xr + o) = wr_;
                    u32x2 wi_; wi_.x = cvt_pk_bf16(yi[0], yi[1]); wi_.y = cvt_pk_bf16(yi[2], yi[3]); *(LAS u32x2*)(xr + 8192 + o) = wi_; } }
        asm volatile("s_waitcnt lgkmcnt(0)" ::: "memory");
        f32x16 O[2][2];
#pragma unroll
        for (int a = 0; a < 2; ++a)
#pragma unroll
            for (int c = 0; c < 2; ++c)
#pragma unroll
                for (int e = 0; e < 16; ++e) O[a][c][e] = 0.f;
#pragma unroll 1
        for (int ks = 0; ks < 4; ++ks) {
            bf16x8 Cf[2], Sf[2];
#pragma unroll
            for (int kt = 0; kt < 2; ++kt) { const unsigned o = f2_cs_byte(32 * kt + r, 16 * ks + 8 * h); Cf[kt] = *(const LAS bf16x8*)(lds + o); Sf[kt] = *(const LAS bf16x8*)(lds + 8192 + o); }
            u32x2 t[8]; const unsigned ko = ks * 2048;
            f2_tr8(t, tb0 + ko, tb0 + ko + 512, tb1 + ko, tb1 + ko + 512, tb0 + ko + 8192, tb0 + ko + 8192 + 512, tb1 + ko + 8192, tb1 + ko + 8192 + 512);
            const bf16x8 Rf[2] = {f2_frag(t[0], t[1]), f2_frag(t[2], t[3])}, If[2] = {f2_frag(t[4], t[5]), f2_frag(t[6], t[7])};
#pragma unroll
            for (int kt = 0; kt < 2; ++kt)
#pragma unroll
                for (int nt = 0; nt < 2; ++nt) {
                    O[kt][nt] = __builtin_amdgcn_mfma_f32_32x32x16_bf16(Cf[kt], Rf[nt], O[kt][nt], 0, 0, 0);
                    O[kt][nt] = __builtin_amdgcn_mfma_f32_32x32x16_bf16(Sf[kt], If[nt], O[kt][nt], 0, 0, 0);
                }
        }
        { const float sc = 0.001381067932004974f;
#pragma unroll
          for (int kt = 0; kt < 2; ++kt)
#pragma unroll
              for (int nt = 0; nt < 2; ++nt)
#pragma unroll
                  for (int e = 0; e < 16; ++e) { const int k2 = 32 * kt + (e & 3) + 8 * (e >> 2) + 4 * h, k1 = 32 * nt + r;
                      *(LAS bf16_t*)(xr + (64 * k2 + k1) * 2) = f2bf(O[kt][nt][e] * sc); }
          asm volatile("s_waitcnt lgkmcnt(0)" ::: "memory");
          bf16_t* dst = AT + ((size_t)b * 512 + m) * SEQ;
#pragma unroll
          for (int i = 0; i < 8; ++i) *(u32x4*)(dst + (i * 64 + lane) * 8) = *(const LAS u32x4*)(xr + (i * 64 + lane) * 16);
          asm volatile("s_waitcnt lgkmcnt(0)" ::: "memory"); }
    }
    __syncthreads();
}

__device__ __forceinline__ void hyena_prep_phase(const bf16_t* __restrict__ UT, const bf16_t* __restrict__ UTc, bf16_t* __restrict__ VXT, bf16_t* __restrict__ X0T, bf16_t* __restrict__ HTc,
                                                 const float* __restrict__ KFc, const float* __restrict__ conv_w, const float* __restrict__ conv_b, const float* __restrict__ hbias,
                                                 LAS unsigned char* lds) {
    LAS float* kf = (LAS float*)lds;
    LAS float* raw = kf + 8192;
    LAS float* vx = raw + 3 * 4224;
    LAS float* x0s = vx + 4096;
    const int tid = otid(), lane = tid & 63;
    for (int cp = blockIdx.x; cp < 256; cp += gridDim.x)
        for (int cc = 0; cc < 2; ++cc) {
            const int c = cp * 2 + cc;
            float cw[3][3], cb[3];
#pragma unroll
            for (int j = 0; j < 3; ++j) { cb[j] = conv_b[j * 512 + c];
#pragma unroll
                for (int tp = 0; tp < 3; ++tp) cw[j][tp] = conv_w[tp * 1536 + j * 512 + c]; }
            const float bias = hbias[c];
            const int t0 = tid * 8;
#pragma unroll 2
            for (int b = 0; b < NB; ++b) {
                const bf16_t* UTb = UT + (size_t)b * UCH * SEQ;
                float z[3][8];
#pragma unroll
                for (int j = 0; j < 3; ++j) {
                    const bf16_t* rowp = UTb + ((size_t)1024 + j * 512 + c) * SEQ;
                    const u32x4 w = *(const u32x4*)(rowp + t0);
                    float r[10];
                    r[1] = bflo(w.x); r[2] = bfhi(w.x); r[3] = bflo(w.y); r[4] = bfhi(w.y); r[5] = bflo(w.z); r[6] = bfhi(w.z); r[7] = bflo(w.w); r[8] = bfhi(w.w);
                    const float pl_ = bf2f(rowp[t0 > 0 ? t0 - 1 : 0]), nl_ = bf2f(rowp[t0 + 8 < SEQ ? t0 + 8 : SEQ - 1]);
                    r[0] = t0 > 0 ? pl_ : 0.f; r[9] = t0 + 8 < SEQ ? nl_ : 0.f;
#pragma unroll
                    for (int i = 0; i < 8; ++i) z[j][i] = r[i] * cw[j][0] + r[i + 1] * cw[j][1] + r[i + 2] * cw[j][2] + cb[j];
                }
                float pv[8];
#pragma unroll
                for (int i = 0; i < 8; ++i) pv[i] = z[0][i] * z[1][i];
                u32x4 v8; v8.x = cvt_pk_bf16(pv[0], pv[1]); v8.y = cvt_pk_bf16(pv[2], pv[3]); v8.z = cvt_pk_bf16(pv[4], pv[5]); v8.w = cvt_pk_bf16(pv[6], pv[7]);
                { u32x4 x8; x8.x = cvt_pk_bf16(z[2][0], z[2][1]); x8.y = cvt_pk_bf16(z[2][2], z[2][3]); x8.z = cvt_pk_bf16(z[2][4], z[2][5]); x8.w = cvt_pk_bf16(z[2][6], z[2][7]);
                  const size_t o = ((size_t)c * NB + b) * SEQ + t0;
                  *(u32x4*)(VXT + o) = v8; *(u32x4*)(X0T + o) = x8; }
            }
            __syncthreads();
            if (tid < 128) *(LAS f32x4*)(kf + tid * 4) = *(const f32x4*)(KFc + (size_t)c * 512 + tid * 4);
            __syncthreads();
            hyena_pass<LCTX, 16>(UTc, HTc, c, cw, cb, bias, kf, raw, vx, x0s);
        }
}

__device__ __forceinline__ void toep_phase(const bf16_t* __restrict__ RC, const bf16_t* __restrict__ VXT, const bf16_t* __restrict__ X0T, const char* __restrict__ zero16, const float* __restrict__ hbias, bf16_t* __restrict__ HT,
                                           LAS unsigned char* lds) {
    int tid_ = threadIdx.x; asm volatile("" : "+v"(tid_));
    const int tid = tid_, lane = tid & 63, w = __builtin_amdgcn_readfirstlane(tid >> 6), r = lane & 31, h = lane >> 5;
    constexpr int RING = 65536, NST = 272, NSL = 64;
    const int cbase = (4096 - 512 * w + 8 * (h - r) - 256) * 2;
    const int offL = (h ? (lane - 32) : (lane + 32)) * 16 + 8;
    for (int cp = blockIdx.x; cp < 256; cp += gridDim.x)
        for (int cc = 0; cc < 2; ++cc) {
            const int c = cp * 2 + cc;
            const char* rc = (const char*)(RC + (size_t)c * 4 * 8192);
            const char* vxc = (const char*)(VXT + (size_t)c * NB * SEQ) + ((lane & 15) * SEQ + 256 * ((lane >> 4) & 1) + 8 * h - 256) * 2;
#define TOEP_SRC(st_) ({ const int s_ = 16 * (st_) - 256 + 256 * ((lane >> 4) & 1) + 8 * h; (s_ >= 0 && s_ < SEQ) ? vxc + 32 * (st_) : zero16; })
            __syncthreads();
#pragma unroll
            for (int i = 0; i < 8; ++i)
                __builtin_amdgcn_global_load_lds((const unsigned*)(rc + (w * 8 + i) * 1024 + lane * 16), (LAS unsigned*)(lds + (w * 8 + i) * 1024), 16, 0, 0);
            __builtin_amdgcn_global_load_lds((const unsigned*)TOEP_SRC(w), (LAS unsigned*)(lds + RING + w * 1024), 16, 0, 0);
            __builtin_amdgcn_global_load_lds((const unsigned*)TOEP_SRC(8 + w), (LAS unsigned*)(lds + RING + (8 + w) * 1024), 16, 0, 0);
            if (w == 0) { *(LAS u32x4*)(lds + RING + 63 * 1024 + lane * 16) = (u32x4){0u, 0u, 0u, 0u}; asm volatile("s_waitcnt lgkmcnt(0)" ::: "memory"); }
            f32x16 acc[8];
#pragma unroll
            for (int j = 0; j < 8; ++j)
#pragma unroll
                for (int e = 0; e < 16; ++e) acc[j][e] = 0.f;
            for (int k = 0; k < NST / 8; ++k) {
                { int stn = 8 * (k + 2) + w; stn = stn < NST ? stn : NST - 1;
                  __builtin_amdgcn_global_load_lds((const unsigned*)TOEP_SRC(stn), (LAS unsigned*)(lds + RING + ((8 * (k + 2) + w) & (NSL - 1)) * 1024), 16, 0, 0); }
                asm volatile("s_waitcnt vmcnt(2)" ::: "memory");
                __builtin_amdgcn_s_barrier();
                asm volatile("" ::: "memory");
                const LAS unsigned char* ab = lds + cbase + 256 * k;
                const LAS unsigned char* rk = lds + RING + ((8 * k) & (NSL - 1)) * 1024;
                const LAS unsigned char* r0 = lds + RING + ((8 * k - 1 + h) & (NSL - 1)) * 1024 + offL;
#pragma unroll
                for (int i = 0; i < 8; ++i) {
                    const u32x4 bq = *(const LAS u32x4*)(rk + i * 1024 + lane * 16);
                    const u32x2 lo = i == 0 ? *(const LAS u32x2*)r0 : *(const LAS u32x2*)(rk + (i - 1) * 1024 + h * 1024 + offL);
                    const bf16x8 bf = __builtin_bit_cast(bf16x8, bq), b3 = __builtin_bit_cast(bf16x8, (u32x4){lo.x, lo.y, bq.x, bq.y});
#pragma unroll
                    for (int m = 0; m < 4; ++m) {
                        const bf16x8 af = *(const LAS bf16x8*)(ab + m * 16384 + 32 * i);
                        acc[4 + m] = __builtin_amdgcn_mfma_f32_32x32x16_bf16(af, bf, acc[4 + m], 0, 0, 0);
                        acc[m] = __builtin_amdgcn_mfma_f32_32x32x16_bf16(af, b3, acc[m], 0, 0, 0);
                    }
                }
            }
            {
                const LAS unsigned char* ab = lds + cbase + 256 * (NST / 8);
                u32x2 lo = (u32x2){0u, 0u};
                if (h == 0) lo = *(const LAS u32x2*)(lds + RING + ((NST - 1) & (NSL - 1)) * 1024 + offL);
                const bf16x8 b3 = __builtin_bit_cast(bf16x8, (u32x4){lo.x, lo.y, 0u, 0u});
#pragma unroll
                for (int m = 0; m < 4; ++m) { const bf16x8 af = *(const LAS bf16x8*)(ab + m * 16384); acc[m] = __builtin_amdgcn_mfma_f32_32x32x16_bf16(af, b3, acc[m], 0, 0, 0); }
            }
            asm volatile("s_waitcnt vmcnt(0)" ::: "memory");
            __builtin_amdgcn_s_barrier();
            asm volatile("" ::: "memory");
            LAS unsigned char* wt = lds + w * 16640;
            { const int col = lane & 31, b = col & 15, a = col >> 4;
#pragma unroll
              for (int u = 0; u < 2; ++u)
#pragma unroll
                  for (int mp = 0; mp < 2; ++mp)
#pragma unroll
                      for (int e = 0; e < 16; ++e) { const int row = (e & 3) + 8 * (e >> 2) + 4 * h, tl = 4 * u + 2 * mp + 8 * row + 256 * a;
                          *(LAS unsigned*)(wt + (b * 520 + tl) * 2) = cvt_pk_bf16(acc[4 * u + 2 * mp][e], acc[4 * u + 2 * mp + 1][e]); } }
            asm volatile("s_waitcnt lgkmcnt(0)" ::: "memory");
            const float bias = hbias[c];
#pragma unroll 4
            for (int b = 0; b < 16; ++b) {
                const u32x4 y8 = *(const LAS u32x4*)(wt + (b * 520 + 8 * lane) * 2);
                const size_t go = ((size_t)b * 512 + c) * SEQ + 512 * w + 8 * lane, gi = ((size_t)c * NB + b) * SEQ + 512 * w + 8 * lane;
                const u32x4 g0 = *(const u32x4*)(X0T + gi), g1 = *(const u32x4*)(VXT + gi);
                const float x0v[8] = {bflo(g0.x), bfhi(g0.x), bflo(g0.y), bfhi(g0.y), bflo(g0.z), bfhi(g0.z), bflo(g0.w), bfhi(g0.w)};
                const float vxv[8] = {bflo(g1.x), bfhi(g1.x), bflo(g1.y), bfhi(g1.y), bflo(g1.z), bfhi(g1.z), bflo(g1.w), bfhi(g1.w)};
                const float yy[8] = {bflo(y8.x), bfhi(y8.x), bflo(y8.y), bfhi(y8.y), bflo(y8.z), bfhi(y8.z), bflo(y8.w), bfhi(y8.w)};
                float o[8];
#pragma unroll
                for (int i = 0; i < 8; ++i) o[i] = x0v[i] * (yy[i] + bias * vxv[i]);
                u32x4 ww; ww.x = cvt_pk_bf16(o[0], o[1]); ww.y = cvt_pk_bf16(o[2], o[3]); ww.z = cvt_pk_bf16(o[4], o[5]); ww.w = cvt_pk_bf16(o[6], o[7]);
                *(u32x4*)(HT + go) = ww;
            }
#undef TOEP_SRC
        }
    __syncthreads();
}

__device__ __forceinline__ void mix_transpose_phase(const bf16_t* __restrict__ AT, const bf16_t* __restrict__ HT, const bf16_t* __restrict__ HTc, bf16_t* __restrict__ MIX, LAS unsigned char* lds) {
    LAS bf16_t* T = (LAS bf16_t*)lds;
    const int tid = otid();
    for (int t = blockIdx.x; t < 16896; t += gridDim.x) {
        const bf16_t* src; int sld, row0, cb, coff;
        if (t < 16384) { const int t1 = t & 8191, b = t1 >> 9, tb = t1 & 63; cb = (t1 >> 6) & 7; src = (t < 8192 ? AT : HT) + ((size_t)(b * 512 + cb * 64)) * SEQ + tb * 64; sld = SEQ; row0 = b * SEQ + tb * 64; coff = t < 8192 ? 0 : 512; }
        else { const int t2 = t - 16384, b = t2 >> 5, tb = t2 & 3; cb = (t2 >> 2) & 7; src = HTc + ((size_t)(b * 512 + cb * 64)) * LCTX + tb * 64; sld = LCTX; row0 = NTOK + b * LCTX + tb * 64; coff = 512; }
        { const int r = tid >> 3, p = tid & 7; *(LAS u32x4*)(T + r * 72 + p * 8) = *(const u32x4*)(src + (size_t)r * sld + p * 8); }
        __syncthreads();
        { const int tt = tid >> 3, c8 = (tid & 7) * 8; unsigned w[4];
#pragma unroll
          for (int j = 0; j < 4; ++j) w[j] = (unsigned)T[(c8 + 2 * j) * 72 + tt] | ((unsigned)T[(c8 + 2 * j + 1) * 72 + tt] << 16);
          *(u32x4*)(MIX + (size_t)(row0 + tt) * D + coff + cb * 64 + c8) = (u32x4){w[0], w[1], w[2], w[3]}; }
        __syncthreads();
    }
}

__device__ __forceinline__ void attn_issue(LAS unsigned char* lds, int gc, const bf16_t* __restrict__ Kb, const bf16_t* __restrict__ VT, int item, int ci, int w, int lane) {
    LAS unsigned char* sl = lds + (gc & 3) * 32768;
    const int b = item >> 7, hkv = (item >> 5) & 3, qb = item & 31;
    const bool win = ci < 3;
    int kp0 = qb * 128 - 128 + 128 * ci; kp0 = kp0 < 0 ? 0 : (kp0 > SEQ - 128 ? SEQ - 128 : kp0);
    const char* kub = (const char*)Kb + ((size_t)(win ? b * SEQ + kp0 : NTOK + b * LCTX + 128 * (ci - 3)) * 256 + hkv * 64) * 2;
    const char* vub = (const char*)VT + (win ? ((size_t)(b * 256 + hkv * 64) * SEQ + kp0) * 2 : ((size_t)NB * 256 * SEQ + (size_t)(b * 256 + hkv * 64) * LCTX + 128 * (ci - 3)) * 2);
    const unsigned vrow = win ? SEQ * 2u : LCTX * 2u;
#pragma unroll
    for (int i = 0; i < 2; ++i) { const int q = 2 * w + i, key = 8 * q + (lane >> 3), ds = (lane & 7) ^ ((key >> 1) & 7);
        const unsigned lo = (unsigned)(key * 256 + ds * 8) * 2u;
        __builtin_amdgcn_global_load_lds((const unsigned*)(kub + lo), (LAS unsigned*)(sl + q * 1024), 16, 0, 0); }
#pragma unroll
    for (int i = 0; i < 2; ++i) { const int q = 2 * w + i, d = 4 * q + (lane >> 4), ss = (lane & 15) ^ (d & 15);
        const unsigned lo = (unsigned)d * vrow + (unsigned)ss * 16u;
        __builtin_amdgcn_global_load_lds((const unsigned*)(vub + lo), (LAS unsigned*)(sl + 16384 + q * 1024), 16, 0, 0); }
}

__device__ __forceinline__ void attn_softmax(f32x16& S, f32x16 (&O)[2][2], const int qt, float& mrun, float& lrun, bf16x8 (&P)[2], const bool need_mask, const int qp, const int kp0, const int h) {
    if (need_mask) {
#pragma unroll
        for (int e = 0; e < 16; ++e) { const int kp = kp0 + (e & 3) + 8 * (e >> 2) + 4 * h; const bool ok = (unsigned)(qp - kp + 128) <= 256u; S[e] = ok ? S[e] : -1.0e30f; }
    }
    float mx = S[0];
#pragma unroll
    for (int e = 1; e < 16; ++e) mx = fmaxf(mx, S[e]);
    mx = fmaxf(mx, __shfl_xor(mx, 32));
    const float mn = mx > mrun + 6.0f ? mx : mrun;
    if (__any(mn != mrun)) {
        const float alpha = __builtin_amdgcn_exp2f(mrun - mn);
        lrun *= alpha;
#pragma unroll
        for (int dt = 0; dt < 2; ++dt)
#pragma unroll
            for (int e = 0; e < 16; ++e) O[dt][qt][e] *= alpha;
        mrun = mn;
    }
    float ps = 0.f;
#pragma unroll
    for (int e = 0; e < 16; ++e) { S[e] = __builtin_amdgcn_exp2f(S[e] - mn); ps += S[e]; }
    lrun += ps;
#pragma unroll
    for (int s2 = 0; s2 < 2; ++s2) { u32x4 pk;
        pk.x = cvt_pk_bf16(S[8 * s2 + 0], S[8 * s2 + 1]); pk.y = cvt_pk_bf16(S[8 * s2 + 2], S[8 * s2 + 3]);
        pk.z = cvt_pk_bf16(S[8 * s2 + 4], S[8 * s2 + 5]); pk.w = cvt_pk_bf16(S[8 * s2 + 6], S[8 * s2 + 7]);
        P[s2] = __builtin_bit_cast(bf16x8, pk); }
}

__device__ __forceinline__ void attn_chunk(const bool WIN, const int ktlo, const int kthi, const LAS unsigned char* sl, const bf16x8 (&Qf)[2][4], f32x16 (&O)[2][2], float (&mrun)[2], float (&lrun)[2], int kpc, int q0w, int lane) {
    const int r = lane & 31, h = lane >> 5;
#pragma unroll 1
    for (int kt = ktlo; kt < kthi; ++kt) {
        const int kp0 = kpc + 32 * kt;
        f32x16 S0, S1;
        { bf16x8 kf[4];
          const int key = 32 * kt + r, sw = (key >> 1) & 7;
#pragma unroll
          for (int ks = 0; ks < 4; ++ks) kf[ks] = *(const LAS bf16x8*)(sl + key * 128 + (((2 * ks + h) ^ sw) << 4));
#pragma unroll
          for (int e = 0; e < 16; ++e) { S0[e] = 0.f; S1[e] = 0.f; }
#pragma unroll
          for (int ks = 0; ks < 4; ++ks) S0 = __builtin_amdgcn_mfma_f32_32x32x16_bf16(kf[ks], Qf[0][ks], S0, 0, 0, 0);
#pragma unroll
          for (int ks = 0; ks < 4; ++ks) S1 = __builtin_amdgcn_mfma_f32_32x32x16_bf16(kf[ks], Qf[1][ks], S1, 0, 0, 0); }
        bf16x8 vf[2][2];
#pragma unroll
        for (int dt = 0; dt < 2; ++dt)
#pragma unroll
            for (int s2 = 0; s2 < 2; ++s2) { const int d = 32 * dt + r; vf[dt][s2] = *(const LAS bf16x8*)(sl + 16384 + d * 256 + (((4 * kt + 2 * s2 + h) ^ (d & 15)) << 4)); }
        __builtin_amdgcn_sched_barrier(0);
        const int dq0 = kp0 - q0w, dq1 = kp0 - (q0w + 32);
        bf16x8 P0[2], P1[2];
        attn_softmax(S0, O, 0, mrun[0], lrun[0], P0, WIN && (dq0 < -96 || dq0 > 96), q0w + r, kp0, h);
#pragma unroll
        for (int dt = 0; dt < 2; ++dt)
#pragma unroll
            for (int s2 = 0; s2 < 2; ++s2) O[dt][0] = __builtin_amdgcn_mfma_f32_32x32x16_bf16(vf[dt][s2], P0[s2], O[dt][0], 0, 0, 0);
        __builtin_amdgcn_sched_barrier(0);
        attn_softmax(S1, O, 1, mrun[1], lrun[1], P1, WIN && (dq1 < -96 || dq1 > 96), q0w + 32 + r, kp0, h);
#pragma unroll
        for (int dt = 0; dt < 2; ++dt)
#pragma unroll
            for (int s2 = 0; s2 < 2; ++s2) O[dt][1] = __builtin_amdgcn_mfma_f32_32x32x16_bf16(vf[dt][s2], P1[s2], O[dt][1], 0, 0, 0);
        __builtin_amdgcn_sched_barrier(0);
    }
}

__device__ __forceinline__ void attn_phase(const bf16_t* __restrict__ Q, const bf16_t* __restrict__ Kb, const bf16_t* __restrict__ VT, bf16_t* __restrict__ AO, const float* __restrict__ sink, LAS unsigned char* lds) {
    int tid_ = threadIdx.x; asm volatile("" : "+v"(tid_));
    const int tid = tid_, lane = tid & 63, w = __builtin_amdgcn_readfirstlane(tid >> 6), r = lane & 31, h = lane >> 5;
    const int G = gridDim.x;
    int nitems = 0; for (int it = blockIdx.x; it < 2048; it += G) ++nitems;
    const int nch = nitems * 5;
    __syncthreads();
    if (nch > 0) { attn_issue(lds, 0, Kb, VT, blockIdx.x, 0, w, lane); attn_issue(lds, 1, Kb, VT, blockIdx.x, 1, w, lane); }
    int gc = 0;
    for (int item = blockIdx.x; item < 2048; item += G) {
        const int b = item >> 7, hkv = (item >> 5) & 3, qb = item & 31, head = hkv * 4 + (w >> 1), q0w = qb * 128 + (w & 1) * 64;
        bf16x8 Qf[2][4];
#pragma unroll
        for (int qt = 0; qt < 2; ++qt)
#pragma unroll
            for (int ks = 0; ks < 4; ++ks) Qf[qt][ks] = *(const bf16x8*)((const char*)Q + ((size_t)(b * SEQ + q0w) * D + head * 64) * 2 + (unsigned)((32 * qt + r) * D + 16 * ks + 8 * h) * 2u);
        f32x16 O[2][2];
#pragma unroll
        for (int dt = 0; dt < 2; ++dt)
#pragma unroll
            for (int qt = 0; qt < 2; ++qt)
#pragma unroll
                for (int e = 0; e < 16; ++e) O[dt][qt][e] = 0.f;
        const float sk = sink[head] * 1.4426950408889634f;
        float mrun[2] = {sk, sk}, lrun[2] = {h == 0 ? 1.0f : 0.0f, h == 0 ? 1.0f : 0.0f};
#pragma unroll 1
        for (int ci = 0; ci < 5; ++ci, ++gc) {
            { int g2 = gc + 2, it2 = item, c2 = ci + 2;
              if (c2 >= 5) { c2 -= 5; it2 += G; }
              if (g2 >= nch) { it2 = item; c2 = 0; }
              attn_issue(lds, g2, Kb, VT, it2, c2, w, lane); }
            asm volatile("s_waitcnt vmcnt(8)" ::: "memory");
            __builtin_amdgcn_s_barrier();
            asm volatile("" ::: "memory");
            const LAS unsigned char* sl = lds + (gc & 3) * 32768;
            { const bool win = ci < 3; const int kpc = qb * 128 - 128 + 128 * ci;
              int ktlo = 0, kthi = 4;
              if (win) { ktlo = (q0w - 128 - kpc) >> 5; ktlo = ktlo < 0 ? 0 : ktlo; kthi = ((q0w + 191 - kpc) >> 5) + 1; kthi = kthi > 4 ? 4 : kthi; if (kpc < 0 || kpc >= SEQ) kthi = 0; }
              attn_chunk(win, ktlo, kthi, sl, Qf, O, mrun, lrun, kpc, q0w, lane); }
        }
#pragma unroll
        for (int qt = 0; qt < 2; ++qt) {
            const float lt = lrun[qt] + __shfl_xor(lrun[qt], 32), inv = __builtin_amdgcn_rcpf(lt);
            bf16_t* op = (bf16_t*)((char*)AO + ((size_t)(b * SEQ + q0w) * D + head * 64) * 2 + (unsigned)((32 * qt + r) * D + 4 * h) * 2u);
#pragma unroll
            for (int dt = 0; dt < 2; ++dt)
#pragma unroll
                for (int eg = 0; eg < 4; ++eg) { u32x2 wv; wv.x = cvt_pk_bf16(O[dt][qt][4 * eg] * inv, O[dt][qt][4 * eg + 1] * inv); wv.y = cvt_pk_bf16(O[dt][qt][4 * eg + 2] * inv, O[dt][qt][4 * eg + 3] * inv);
                    *(u32x2*)(op + 32 * dt + 8 * eg) = wv; }
        }
    }
    asm volatile("s_waitcnt vmcnt(0)" ::: "memory");
    __syncthreads();
}

__device__ __forceinline__ void slots_phase(const unsigned* __restrict__ route, const int* __restrict__ hist, int* __restrict__ tok, float* __restrict__ gw, int* __restrict__ slotof, int* __restrict__ tile_e, LAS unsigned char* lds) {
    LAS int* hl = (LAS int*)lds;
    LAS int* cnt = hl + 2048;
    LAS int* base = cnt + 8;
    LAS int* pst = base + 8;
    LAS int* wcnt = pst + 16;
    const int tid = otid(), lane = tid & 63, wid = tid >> 6;
    __syncthreads();
    if (tid < 256) { const u32x4 a = *(const u32x4*)(hist + tid * 8), b = *(const u32x4*)(hist + tid * 8 + 4);
        *(LAS u32x4*)(hl + tid * 8) = a; *(LAS u32x4*)(hl + tid * 8 + 4) = b; }
    __syncthreads();
    if (tid < 8) { int tot = 0, bs = 0; for (int k = 0; k < 256; ++k) { const int h = hl[k * 8 + tid]; if (k < (int)blockIdx.x) bs += h; tot += h; } cnt[tid] = tot; base[tid] = bs; }
    __syncthreads();
    if (tid == 0) { int p = 0; for (int e = 0; e < 8; ++e) { pst[e] = p; p += (cnt[e] + 255) & ~255; } pst[8] = p; }
    __syncthreads();
    const int token = blockIdx.x * 256 + (tid >> 1), k = tid & 1;
    const int mye = (int)route[(size_t)token * 4 + k]; const float myg = __uint_as_float(route[(size_t)token * 4 + 2 + k]);
    int rk = 0;
#pragma unroll
    for (int e = 0; e < 8; ++e) { const unsigned long long mask = __ballot(mye == e);
        if (lane == 0) wcnt[e * 8 + wid] = __popcll(mask);
        if (mye == e) rk = __popcll(mask & ((1ull << lane) - 1ull)); }
    __syncthreads();
    int pre = 0;
    for (int w = 0; w < wid; ++w) pre += wcnt[mye * 8 + w];
    const int slot = pst[mye] + base[mye] + pre + rk;
    tok[slot] = token; gw[slot] = myg; slotof[token * 2 + k] = slot;
    if (blockIdx.x == 0) {
        for (int e = 0; e < 8; ++e) for (int s = pst[e] + cnt[e] + tid; s < pst[e + 1]; s += 512) { tok[s] = 0; gw[s] = 0.f; }
        for (int t = tid; t < MAXTILES; t += 512) { int e = 0;
#pragma unroll
            for (int q = 1; q < 8; ++q) if (t * 256 >= pst[q]) e = q;
            tile_e[t] = e; }
        if (tid == 0) tile_e[1023] = pst[8] >> 8;
    }
}

__device__ __forceinline__ void combine_phase(float* __restrict__ out, const bf16_t* __restrict__ XB, const bf16_t* __restrict__ Y, const int* __restrict__ slotof, const float* __restrict__ gate  ) {
    const int tid = otid(), lane = tid & 63, wid = tid >> 6, nwv = gridDim.x * 8, gw = blockIdx.x * 8 + wid, tpw = (NTOK + nwv - 1) / nwv;
    const int t0 = gw * tpw, t1 = (t0 + tpw) < NTOK ? (t0 + tpw) : NTOK;
    if (t0 >= t1) return;
    f32x4 gv[4]; int curb = -1;
#pragma unroll
    for (int i = 0; i < 4; ++i) gv[i] = (f32x4){0.f, 0.f, 0.f, 0.f};
    int sa = slotof[t0 * 2], sb = slotof[t0 * 2 + 1];
    int sa2 = 0, sb2 = 0;
    if (t0 + 1 < t1) { sa2 = slotof[(t0 + 1) * 2]; sb2 = slotof[(t0 + 1) * 2 + 1]; }
    u32x4 y1[2], y2[2], xw[2];
#pragma unroll
    for (int i = 0; i < 2; ++i) { const int o = i * 512 + lane * 8; y1[i] = *(const u32x4*)(Y + (size_t)sa * D + o); y2[i] = *(const u32x4*)(Y + (size_t)sb * D + o); xw[i] = *(const u32x4*)(XB + (size_t)t0 * D + o); }
    for (int t = t0; t < t1; ++t) {
        const int bidx = t >> 12;
        if (bidx != curb) { curb = bidx; const float* gp = gate + (size_t)bidx * NMOD;
#pragma unroll
            for (int i = 0; i < 2; ++i) { gv[2 * i] = *(const f32x4*)(gp + i * 512 + lane * 8); gv[2 * i + 1] = *(const f32x4*)(gp + i * 512 + lane * 8 + 4); } }
        u32x4 cy1[2], cy2[2], cx[2];
#pragma unroll
        for (int i = 0; i < 2; ++i) { cy1[i] = y1[i]; cy2[i] = y2[i]; cx[i] = xw[i]; }
        const int na = sa2, nb = sb2;
        if (t + 2 < t1) { sa2 = slotof[(t + 2) * 2]; sb2 = slotof[(t + 2) * 2 + 1]; }
        if (t + 1 < t1) {
#pragma unroll
            for (int i = 0; i < 2; ++i) { const int o = i * 512 + lane * 8; y1[i] = *(const u32x4*)(Y + (size_t)na * D + o); y2[i] = *(const u32x4*)(Y + (size_t)nb * D + o); xw[i] = *(const u32x4*)(XB + (size_t)(t + 1) * D + o); }
        }
#pragma unroll
        for (int i = 0; i < 2; ++i) { const int o = i * 512 + lane * 8;
            float* xp = out + (size_t)t * D + o;
            f32x4 xa = (f32x4){bflo(cx[i].x), bfhi(cx[i].x), bflo(cx[i].y), bfhi(cx[i].y)}, xb = (f32x4){bflo(cx[i].z), bfhi(cx[i].z), bflo(cx[i].w), bfhi(cx[i].w)};
            const f32x4 ga = gv[2 * i], gb = gv[2 * i + 1];
            xa[0] += ga[0] * (bflo(cy1[i].x) + bflo(cy2[i].x)); xa[1] += ga[1] * (bfhi(cy1[i].x) + bfhi(cy2[i].x)); xa[2] += ga[2] * (bflo(cy1[i].y) + bflo(cy2[i].y)); xa[3] += ga[3] * (bfhi(cy1[i].y) + bfhi(cy2[i].y));
            xb[0] += gb[0] * (bflo(cy1[i].z) + bflo(cy2[i].z)); xb[1] += gb[1] * (bfhi(cy1[i].z) + bfhi(cy2[i].z)); xb[2] += gb[2] * (bflo(cy1[i].w) + bflo(cy2[i].w)); xb[3] += gb[3] * (bfhi(cy1[i].w) + bfhi(cy2[i].w));
            *(f32x4*)xp = xa; *(f32x4*)(xp + 4) = xb; }
    }
}

#ifndef FFN_FP8
#define FFN_FP8 1
#endif
constexpr int MQ_G1 = 20, MQ_WO = 24, MQ_GU = 20, MQ_FD = (FFN_FP8 ? 32 : 48), MQ_QKV = 20;
constexpr int MB_G1 = 0, MB_WO = MB_G1 + 96 * MQ_G1, MB_GU = MB_WO + 192 * MQ_WO, MB_FD = MB_GU + 64 * MQ_GU, MB_QKV = MB_FD + 192 * MQ_FD, MB_REM = MB_QKV + 160 * MQ_QKV;
static_assert(MB_REM <= NE * 2688 && MQ_G1 % 4 == 0 && MQ_WO % 4 == 0 && MQ_GU % 4 == 0 && MQ_FD % 4 == 0 && MQ_QKV % 4 == 0, "moe conversion quotas");
#define MOE_CONV(first, count) do { sw_start(lds, 7, true); moe_conv_groups(INP(30), INP(31), INP(32), (fp8_t*)OUTP() + DO_MGU, (fp8_t*)OUTP() + DO_MD, lds, (first) / 4, ((first) + (count)) / 4, 1); sw_stop(lds, 7, true); } while (0)
#ifndef STAG_R1
#define STAG_R1 0
#endif
#ifndef STAG_R2
#define STAG_R2 0
#endif
#ifndef STAG_FFN
#define STAG_FFN 0
#endif
#ifndef STAG_MOE
#define STAG_MOE 0
#endif
#ifndef PROBE_MASK
#define PROBE_MASK 0u
#endif
#define REP(k) for (int rep_ = 0; rep_ < (((PROBE_MASK >> (k)) & 1u) ? 2 : 1); ++rep_)
#ifndef PHMASK
#define PHMASK 0xffffffffu
#endif
#define XBAR(n) do { sw_start(lds, 5, true); sw_start(lds, 6, SW_PHASE == (n)); xcd_barrier(bar, (unsigned*)WSP()); sw_stop(lds, 5, true); sw_stop(lds, 6, SW_PHASE == (n)); } while (0)
struct Args { const float* in[33]; float* out; unsigned char* ws; };

__device__ __forceinline__ unsigned long long ldq(volatile LAS unsigned* tab, int i) {
    unsigned lo = tab[2 * i], hi = tab[2 * i + 1];
    lo = __builtin_amdgcn_readfirstlane(lo); hi = __builtin_amdgcn_readfirstlane(hi);
    return ((unsigned long long)hi << 32) | (unsigned long long)lo;
}
#define GAS __attribute__((address_space(1)))
#define INP(i) ((const float*)(const GAS float*)ldq(tab, (i)))
#define OUTP() ((float*)(GAS float*)ldq(tab, 33))
#define WSP() ((unsigned char*)(GAS unsigned char*)ldq(tab, 34))
#define WSF(off) ((float*)(ws + (off)))
#define WSB(off) ((bf16_t*)(ws + (off)))
#define WSI(off) ((int*)(ws + (off)))

__global__ void __launch_bounds__(512, 2) fwd_kernel(Args a_unused) {
    extern __shared__ __attribute__((aligned(16))) unsigned char lds_raw[];
    LAS unsigned char* lds = (LAS unsigned char*)lds_raw;
    volatile LAS unsigned* misc = (volatile LAS unsigned*)(lds + LDS_MISC);
    volatile LAS unsigned* tab = misc + 16;
    const int tid = otid(), G = gridDim.x, bx = blockIdx.x;
    if (tid < 4) misc[tid] = 0u;
    if (SW_ID != 0 && tid < 8) misc[128 + tid] = 0u;
    if (tid < 70) { const unsigned* ka = (const unsigned*)__builtin_amdgcn_kernarg_segment_ptr(); tab[tid] = ka[tid]; }
    __syncthreads();
    XcdBarrier bar = xcd_barrier_post((unsigned*)WSP(), misc);

    if (PHMASK & (1u << 0)) REP(0) {
    { unsigned char* ws = WSP();
      REP(20) {
      tconv<RM_OFF>(INP(8), 1024, 2048, 512, 1536, WSB(OFF_WIN), 1024, lds, bx, G);
      tconv<RM_OFF>(INP(9), 1024, 1024, 0, 1024, WSB(OFF_WOUT), 0, lds, bx, G);
#if FFN_FP8 == 1
      tconv8<RM_GU_G>(INP(21), 1024, DFF, 0, DFF, (fp8_t*)(ws + OFF_WGU), 0, lds, bx, G);
      tconv8<RM_GU_U>(INP(22), 1024, DFF, 0, DFF, (fp8_t*)(ws + OFF_WGU), 0, lds, bx, G);
#else
      tconv<RM_GU_G>(INP(21), 1024, DFF, 0, DFF, WSB(OFF_WGU), 0, lds, bx, G);
      tconv<RM_GU_U>(INP(22), 1024, DFF, 0, DFF, WSB(OFF_WGU), 0, lds, bx, G);
#endif
#if FFN_FP8
      tconv8<RM_OFF>(INP(23), DFF, 1024, 0, 1024, (fp8_t*)(ws + OFF_WD), 0, lds, bx, G);
#else
      tconv<RM_OFF>(INP(23), DFF, 1024, 0, 1024, WSB(OFF_WD), 0, lds, bx, G);
#endif
      tconv<RM_QKV>(INP(24), 1024, 1536, 0, 1280, WSB(OFF_WQKV), 0, lds, bx, G);
      tconv<RM_OFF>(INP(24), 1024, 1536, 1280, 256, WSB(OFF_WQKV), 1280, lds, bx, G);
      tconv<RM_OFF>(INP(25), 1024, 1024, 0, 1024, WSB(OFF_WO2), 0, lds, bx, G);
      }
      REP(21) fold_job(INP(8), WSB(OFF_WIN), lds);
      dft_job(WSB(OFF_DFTC), WSF(OFF_TW), lds);
      REP(22) ada_job(INP(1), INP(3), INP(4), INP(5), WSF(OFF_MOD), lds);
      REP(23) h3_job(INP(13), INP(14), INP(15), INP(16), INP(17), INP(18), INP(20), WSF(OFF_H3));
      float* ROPEC = WSF(OFF_ROPE); float* ROPES = ROPEC + 1024;
      for (int idx = bx * 512 + tid; idx < 1024; idx += G * 512) { const int pp = idx >> 4, i = idx & 15; const float inv = powf(10000.0f, -(float)i / 16.0f), ang = (float)pp * inv; ROPEC[idx] = cosf(ang); ROPES[idx] = sinf(ang); }
      if (bx == 0 && tid < 128) ROPEC[2048 + tid] = tid < 64 ? INP(26)[tid] : INP(27)[tid - 64];
    }
    }
    XBAR(1);

    if (PHMASK & (1u << 1)) REP(1) {
    { unsigned char* ws = WSP();
      for (int cp = bx; cp < 256; cp += G) { filt_fin<SEQ>(WSF(OFF_H3), INP(19), WSF(OFF_RC), cp, lds); filt_fin<LCTX>(WSF(OFF_H3) + (size_t)SEQ * 64, INP(19), WSF(OFF_KFC), cp, lds); }
      norm_phase<false>(INP(0), INP(2), MROWS, INP(6), WSF(OFF_MOD), 0, WSB(OFF_HX), nullptr, nullptr, nullptr, lds);
    }
    }
    XBAR(2);

    if (PHMASK & (1u << 2)) REP(2) {
    { unsigned char* ws = WSP();
      PolU p; p.S.init(UCH / BM, MROWS / BM, G, bx); p.A = WSB(OFF_WIN); p.B = WSB(OFF_HX); p.UT = WSB(OFF_UT); p.UTc = WSB(OFF_UTC); gemm_phase<D>(lds, p, 0, KREP_G1, SW_PHASE == 2);
      if (bx >= 160) MOE_CONV(MB_G1 + (bx - 160) * MQ_G1, MQ_G1); }
    }
    XBAR(3);

    if (PHMASK & (1u << 3)) REP(3) {
    REP(17) { unsigned char* ws = WSP();
      fourier2_phase(WSB(OFF_UT), WSB(OFF_AT), WSF(OFF_TW), lds); }
    { unsigned char* ws = WSP();
      PolF p; p.S.init(NB, 2, G, bx); p.DFT = WSB(OFF_DFTC); p.ZT = WSB(OFF_UTC); p.MIX = WSB(OFF_MIX); p.K = 512; p.L = LCTX; p.tpb = 1; p.rowbase = NTOK; p.zstride = (unsigned)UCH * LCTX; p.scale = 0.005524271728019903f; gemm_phase<512>(lds, p); }
    REP(18) { unsigned char* ws = WSP();
      hyena_prep_phase(WSB(OFF_UT), WSB(OFF_UTC), WSB(OFF_VXT), WSB(OFF_X0T), WSB(OFF_HTC), WSF(OFF_KFC), INP(10), INP(11), INP(12), lds); }
    __syncthreads();
    REP(19) { unsigned char* ws = WSP();
      toep_phase(WSB(OFF_RC), WSB(OFF_VXT), WSB(OFF_X0T), (const char*)(ws + OFF_ZERO16), INP(12), WSB(OFF_HT), lds); }
    }
    XBAR(5);

    if (PHMASK & (1u << 4)) REP(4) {
    { unsigned char* ws = WSP(); mix_transpose_phase(WSB(OFF_AT), WSB(OFF_HT), WSB(OFF_HTC), WSB(OFF_MIX), lds); }
    }
    XBAR(6);

    if (PHMASK & (1u << 5)) REP(5) {
    { unsigned char* ws = WSP();
      PolR<false, false> p; p.S.init(MROWS / BM, 4, G, bx); p.A = WSB(OFF_MIX); p.B = WSB(OFF_WOUT); p.K = D; p.srcL = INP(0); p.XB = WSB(OFF_XB); p.srcC = INP(2); p.dstC = WSF(OFF_CTXR); p.gate = WSF(OFF_MOD) + 2 * D; gemm_phase<D>(lds, p, STAG_R1);
      if (bx >= 64) MOE_CONV(MB_WO + (bx - 64) * MQ_WO, MQ_WO); }
    }
    XBAR(7);

    if (PHMASK & (1u << 6)) REP(6) {
    { unsigned char* ws = WSP(); norm_phase<false, FFN_FP8 == 1, true>(WSB(OFF_XB), WSF(OFF_CTXR), MROWS, INP(7), WSF(OFF_MOD), 3, WSB(OFF_HX), nullptr, nullptr, nullptr, lds); }
    }
    XBAR(8);

    if (PHMASK & (1u << 7)) REP(7) {
    { unsigned char* ws = WSP();
      PolG<false, TileOrder, FFN_FP8 == 1, FFN_FP8 != 0> p; p.S.init(MROWS / BM, DFF / HALF, G, bx); p.A = WSB(OFF_HX); p.B = WSB(OFF_WGU); p.H = WSB(OFF_HID); p.tok = nullptr; p.tile_e = nullptr; p.tile0 = 0; gemm_phase<D>(lds, p, STAG_FFN, KREP_FFN, SW_PHASE == 7);
      if (bx >= 192) MOE_CONV(MB_GU + (bx - 192) * MQ_GU, MQ_GU); }
    }
    XBAR(9);

    if (PHMASK & (1u << 8)) REP(8) {
    { unsigned char* ws = WSP();
      PolR<FFN_FP8 != 0, true> p; p.S.init(MROWS / BM, 4, G, bx); p.A = WSB(OFF_HID); p.B = WSB(OFF_WD); p.K = DFF; p.srcL = nullptr; p.XB = WSB(OFF_XB); p.srcC = WSF(OFF_CTXR); p.dstC = WSF(OFF_CTXR); p.gate = WSF(OFF_MOD) + 5 * D; gemm_phase<DFF>(lds, p, STAG_R2);
      if (bx >= 64) MOE_CONV(MB_FD + (bx - 64) * MQ_FD, MQ_FD); }
    }
    XBAR(10);

    if (PHMASK & (1u << 9)) REP(9) {
    { unsigned char* ws = WSP();
      norm_phase<false, false, true>(WSB(OFF_XB), WSF(OFF_CTXR), MROWS, INP(6) + D, WSF(OFF_MOD) + 17 * NMOD, 0, WSB(OFF_HX), nullptr, nullptr, nullptr, lds);
      moe_conv_groups(INP(30), INP(31), INP(32), (fp8_t*)OUTP() + DO_MGU, (fp8_t*)OUTP() + DO_MD, lds, MB_REM / 4 + bx, MOE_CONV_TILES / 4, G);
    }
    }
    XBAR(11);

    if (PHMASK & (1u << 10)) REP(10) {
    { unsigned char* ws = WSP();
      PolQKV p; p.S.init(MROWS / BM, 5, G, bx); p.HX = WSB(OFF_HX); p.W = WSB(OFF_WQKV); p.ws = ws; p.qkg = WSF(OFF_ROPE) + 2048; p.ropec = WSF(OFF_ROPE); p.ropes = WSF(OFF_ROPE) + 1024; gemm_phase<D>(lds, p);
      if (bx >= 96) MOE_CONV(MB_QKV + (bx - 96) * MQ_QKV, MQ_QKV); }
    }
    XBAR(12);

    if (PHMASK & (1u << 11)) REP(11) {
    { unsigned char* ws = WSP(); attn_phase(WSB(OFF_Q), WSB(OFF_K), WSB(OFF_V), WSB(OFF_AO), INP(28), lds); }
    }
    XBAR(13);

    if (PHMASK & (1u << 12)) REP(12) {
    { unsigned char* ws = WSP();
      PolR<false, true> p; p.S.init(NTOK / BM, 4, G, bx); p.A = WSB(OFF_AO); p.B = WSB(OFF_WO2); p.K = D; p.srcL = nullptr; p.XB = WSB(OFF_XB); p.srcC = WSF(OFF_CTXR); p.dstC = WSF(OFF_CTXR); p.gate = WSF(OFF_MOD) + 17 * NMOD + 2 * D; gemm_phase<D>(lds, p, STAG_R1); }
    }
    XBAR(14);

    if (PHMASK & (1u << 13)) REP(13) {
    { unsigned char* ws = WSP();
      norm_phase<true, true, true>(WSB(OFF_XB), nullptr, NTOK, INP(7) + D, WSF(OFF_MOD) + 17 * NMOD, 3, (bf16_t*)((unsigned char*)OUTP() + DO_HX8), INP(29), (unsigned*)(ws + OFF_ROUTE), WSI(OFF_HIST), lds); }
    }
    XBAR(15);

    if (PHMASK & (1u << 14)) REP(14) {
    { unsigned char* ws = WSP(); slots_phase((const unsigned*)(ws + OFF_ROUTE), WSI(OFF_HIST), WSI(OFF_TOK), WSF(OFF_GW), WSI(OFF_SLOTOF), WSI(OFF_TILEE), lds); }
    }
    XBAR(16);

    if (PHMASK & (1u << 15)) REP(15) {
#pragma unroll
    for (int ch = 0; ch < NCHUNK; ++ch) {
        { unsigned char* ws = WSP();
          const int ntiles = WSI(OFF_TILEE)[1023], per = (ntiles + NCHUNK - 1) / NCHUNK, t0 = ch * per; int ntc = ntiles - t0; ntc = ntc > per ? per : ntc; if (ntc < 0) ntc = 0;
          PolG<true, LinOrder<DFF / HALF>, true> p; p.S.init(ntc, DFF / HALF, G, bx); p.A = (unsigned char*)OUTP() + DO_HX8; p.B = (unsigned char*)OUTP() + DO_MGU; p.H = ws + OFF_HIDM; p.tok = WSI(OFF_TOK); p.tile_e = WSI(OFF_TILEE); p.tile0 = t0; gemm_phase<D>(lds, p, STAG_MOE, KREP_MOE, SW_PHASE == 15); }
        XBAR(17);
        { unsigned char* ws = WSP();
          const int ntiles = WSI(OFF_TILEE)[1023], per = (ntiles + NCHUNK - 1) / NCHUNK, t0 = ch * per; int ntc = ntiles - t0; ntc = ntc > per ? per : ntc; if (ntc < 0) ntc = 0;
          PolD p; p.S.init(ntc, 4, G, bx); p.A = (const fp8_t*)(ws + OFF_HIDM); p.B = (const fp8_t*)OUTP() + DO_MD; p.Y = WSB(OFF_Y); p.gw = WSF(OFF_GW); p.tile_e = WSI(OFF_TILEE); p.tile0 = t0; gemm_phase<DFF>(lds, p); }
        XBAR(18);
    }
    }

    if (PHMASK & (1u << 16)) REP(16) {
    { unsigned char* ws = WSP(); combine_phase(OUTP(), WSB(OFF_XB), WSB(OFF_Y), WSI(OFF_SLOTOF), WSF(OFF_MOD) + 17 * NMOD + 5 * D); }
    }
    if (SW_ID != 0) { if (threadIdx.x == 0 && blockIdx.x == SW_BLOCK) { const unsigned long long dt = *(volatile LAS unsigned long long*)(lds + LDS_MISC + 512) * (unsigned long long)SW_AMP, t0 = __builtin_amdgcn_s_memrealtime();
        while (__builtin_amdgcn_s_memrealtime() - t0 < dt) __builtin_amdgcn_s_sleep(32); } }
}

extern "C" void kernel_launch(void* const* d_in, const int* in_sizes, int n_in, void* d_out, int out_size, void* d_ws, size_t ws_size, hipStream_t stream) {
    static int grid = 0;
    if (grid == 0) {
        if (n_in != 33 || in_sizes[0] != NTOK * D || out_size != NTOK * D || ws_size < WS_NEED) {
            fprintf(stderr, "kernel_launch: unexpected shapes: n_in %d in0 %d out %d ws %zu (need %zu)\n", n_in, n_in > 0 ? in_sizes[0] : -1, out_size, ws_size, (size_t)WS_NEED); grid = -1; return; }
        int dev = 0, cus = 0;
        if (hipGetDevice(&dev) != hipSuccess || hipDeviceGetAttribute(&cus, hipDeviceAttributeMultiprocessorCount, dev) != hipSuccess) { grid = -1; return; }
        if (hipFuncSetAttribute((const void*)fwd_kernel, hipFuncAttributeMaxDynamicSharedMemorySize, LDS_BYTES) != hipSuccess) { fprintf(stderr, "kernel_launch: hipFuncSetAttribute failed\n"); grid = -1; return; }
        int per_cu = 0;
        if (hipOccupancyMaxActiveBlocksPerMultiprocessor(&per_cu, (const void*)fwd_kernel, 512, LDS_BYTES) != hipSuccess || per_cu < 1) { fprintf(stderr, "kernel_launch: occupancy query says %d\n", per_cu); }
        (void)hipGetLastError();
        if (cus != 256) { fprintf(stderr, "kernel_launch: built for 256 CUs, device has %d\n", cus); grid = -1; return; }
        grid = 256;
    }
    if (grid < 0) return;
    if (hipMemsetAsync((char*)d_ws + OFF_CTL, 0, 65536, stream) != hipSuccess) return;
    Args a{};
    for (int i = 0; i < 33; ++i) a.in[i] = (const float*)d_in[i];
    a.out = (float*)d_out; a.ws = (unsigned char*)d_ws;
    hipLaunchKernelGGL(fwd_kernel, dim3(grid), dim3(512), LDS_BYTES, stream, a);
}
```

```cpp
#include <hip/hip_runtime.h>
#include <cstdio>
#include <cstdint>

#define LAS __attribute__((address_space(3)))
typedef unsigned short bf16_t;
typedef short bf16x8 __attribute__((ext_vector_type(8)));
typedef float f32x4 __attribute__((ext_vector_type(4)));
typedef float f32x2 __attribute__((ext_vector_type(2)));
typedef unsigned u32x4 __attribute__((ext_vector_type(4)));
typedef unsigned u32x2 __attribute__((ext_vector_type(2)));
typedef __bf16 bf16x2_t __attribute__((ext_vector_type(2)));
typedef float f32x16 __attribute__((ext_vector_type(16)));
typedef int i32x8 __attribute__((ext_vector_type(8)));
typedef unsigned char fp8_t;

#ifndef KREP_G1
#define KREP_G1 1
#endif
#ifndef KREP_FFN
#define KREP_FFN 1
#endif
#ifndef KREP_MOE
#define KREP_MOE 1
#endif
#ifndef KLOOP_REP
#define KLOOP_REP 1
#endif
#ifndef EREP_U
#define EREP_U 1
#endif
#ifndef EREP_G
#define EREP_G 1
#endif
#ifndef EREP_GM
#define EREP_GM 1
#endif
#ifndef EREP_QKV
#define EREP_QKV 1
#endif
#ifndef EREP_D
#define EREP_D 1
#endif
#ifndef GEMM_ALIGN
#define GEMM_ALIGN 1
#endif
constexpr int D = 1024, NB = 16, SEQ = 4096, NTOK = NB * SEQ, LCTX = 256, NCTX = NB * LCTX, MROWS = NTOK + NCTX;
constexpr int DFF = 3584, NE = 8, NMOD = 6 * D;
constexpr int UCH = 2560;
constexpr int MAXSLOT = 133120;
constexpr int MAXTILES = MAXSLOT / 256;
constexpr int NCHUNK = 1;
constexpr float EPS = 1e-6f;

constexpr size_t al4k(size_t x) { return (x + 4095) & ~(size_t)4095; }
constexpr size_t MiB = 1024 * 1024;
constexpr size_t OFF_CTL = 0;
constexpr size_t OFF_MOD = 65536;
constexpr size_t OFF_ROPE = OFF_MOD + al4k((size_t)2 * 17 * NMOD * 4);
constexpr size_t OFF_H3 = OFF_ROPE + al4k(2 * 64 * 16 * 4 + 512);
constexpr size_t OFF_KF = OFF_H3 + al4k((size_t)4352 * 64 * 4);
constexpr size_t OFF_KFC = OFF_KF + (size_t)512 * 8192 * 4;
constexpr size_t OFF_ROUTE = OFF_KFC + (size_t)512 * 512 * 4;
constexpr size_t OFF_HIST = OFF_ROUTE + (size_t)NTOK * 16;
constexpr size_t OFF_TOK = OFF_HIST + al4k(256 * 8 * 4);
constexpr size_t OFF_GW = OFF_TOK + al4k((size_t)MAXSLOT * 4);
constexpr size_t OFF_SLOTOF = OFF_GW + al4k((size_t)MAXSLOT * 4);
constexpr size_t OFF_TILEE = OFF_SLOTOF + (size_t)NTOK * 8;
constexpr size_t OFF_CTXR = OFF_TILEE + 4096;
constexpr size_t OFF_WIN = OFF_CTXR + (size_t)NCTX * D * 4;
constexpr size_t OFF_WOUT = OFF_WIN + (size_t)UCH * D * 2;
constexpr size_t OFF_WGU = OFF_WOUT + (size_t)D * D * 2;
constexpr size_t OFF_WD = OFF_WGU + (size_t)2 * DFF * D * 2;
constexpr size_t OFF_WQKV = OFF_WD + (size_t)D * DFF * 2;
constexpr size_t OFF_WO2 = OFF_WQKV + (size_t)1536 * D * 2;
constexpr size_t OFF_DFTC = OFF_WO2 + (size_t)D * D * 2;
constexpr size_t OFF_A_END = OFF_DFTC + (size_t)256 * 512 * 2;
static_assert(OFF_A_END <= 80 * MiB, "region A");
constexpr size_t OFF_HX = 80 * MiB;
constexpr size_t OFF_UT = 216 * MiB;
constexpr size_t OFF_UTC = 536 * MiB;
constexpr size_t OFF_MIX = 556 * MiB;
constexpr size_t OFF_HT = 692 * MiB;
constexpr size_t OFF_HTC = 756 * MiB;
constexpr size_t OFF_DFT = 760 * MiB;
constexpr size_t OFF_HID = 216 * MiB;
constexpr size_t OFF_Q = 216 * MiB;
constexpr size_t OFF_K = 344 * MiB;
constexpr size_t OFF_V = 378 * MiB;
constexpr size_t OFF_AO = 412 * MiB;
constexpr size_t OFF_HIDM = 144 * MiB;
constexpr size_t OFF_Y = 600 * MiB;
constexpr size_t OFF_XB = 896 * MiB;
static_assert(OFF_HIDM + (size_t)MAXSLOT * DFF <= OFF_Y && OFF_Y + (size_t)MAXSLOT * D * 2 <= OFF_XB, "moe map");
constexpr size_t DO_MGU = 0;
constexpr size_t DO_MD = 56 * MiB;
constexpr size_t DO_HX8 = 96 * MiB;
constexpr size_t OFF_AT = 760 * MiB;
constexpr size_t OFF_TW = OFF_KF;
constexpr size_t OFF_VXT = 824 * MiB;
constexpr size_t OFF_X0T = 888 * MiB;
constexpr size_t OFF_ZERO16 = 32768;
constexpr size_t OFF_RC = 952 * MiB;
constexpr size_t WS_NEED = 1024 * MiB;


constexpr int LDS_BYTES = 151552;
constexpr int LDS_MISC = LDS_BYTES - 1024;

__device__ __forceinline__ unsigned cvt_pk_bf16(float lo, float hi) { unsigned r; asm volatile("v_cvt_pk_bf16_f32 %0, %1, %2" : "=v"(r) : "v"(lo), "v"(hi)); return r; }
__device__ __forceinline__ bf16_t f2bf(float f) { unsigned u = __float_as_uint(f); u += 0x7FFFu + ((u >> 16) & 1u); return (bf16_t)(u >> 16); }
__device__ __forceinline__ float bf2f(bf16_t b) { return __uint_as_float(((unsigned)b) << 16); }
__device__ __forceinline__ float bflo(unsigned u) { return __uint_as_float(u << 16); }
__device__ __forceinline__ float bfhi(unsigned u) { return __uint_as_float(u & 0xffff0000u); }
__device__ __forceinline__ float dot2(unsigned a, unsigned b, float acc) { return __builtin_amdgcn_fdot2_f32_bf16(__builtin_bit_cast(bf16x2_t, a), __builtin_bit_cast(bf16x2_t, b), acc, false); }
__device__ __forceinline__ float wave_sum(float v) {
#pragma unroll
    for (int o = 32; o >= 1; o >>= 1) v += __shfl_xor(v, o);
    return v;
}
__device__ __forceinline__ unsigned pk4_fp8(float a, float b, float c, float d) { int w = __builtin_amdgcn_cvt_pk_fp8_f32(a, b, 0, false); w = __builtin_amdgcn_cvt_pk_fp8_f32(c, d, w, true); return (unsigned)w; }
constexpr float F8_ACT = 8.0f, F8_W = 64.0f, F8_HID = 4.0f;
__device__ __forceinline__ int otid() { int t = threadIdx.x; asm volatile("" : "+v"(t)); return t; }
__device__ __forceinline__ float silu_f(float x) { return x * __builtin_amdgcn_rcpf(1.0f + __builtin_amdgcn_exp2f(-1.4426950408889634f * x)); }

#ifndef SW_ID
#define SW_ID 0
#endif
#ifndef SW_AMP
#define SW_AMP 8
#endif
#ifndef SW_BLOCK
#define SW_BLOCK 0
#endif
#ifndef SW_PHASE
#define SW_PHASE 0
#endif
__device__ __forceinline__ void sw_start(LAS unsigned char* lds, int id, bool on) {
    if (SW_ID != 0 && SW_ID == id && on) { if (threadIdx.x == 0 && blockIdx.x == SW_BLOCK) *(volatile LAS unsigned long long*)(lds + (151552 - 1024) + 528) = __builtin_amdgcn_s_memrealtime(); }
}
__device__ __forceinline__ void sw_stop(LAS unsigned char* lds, int id, bool on) {
    if (SW_ID != 0 && SW_ID == id && on) { if (threadIdx.x == 0 && blockIdx.x == SW_BLOCK) { volatile LAS unsigned long long* q = (volatile LAS unsigned long long*)(lds + (151552 - 1024) + 512);
        q[0] = q[0] + (__builtin_amdgcn_s_memrealtime() - q[2]); } }
}

#define XB_TMO      128
#define XB_XCNT(j)  (256  + 64 * (j))
#define XB_XSUB(j)  (1280 + 64 * (j))
#define XB_XGEN(j)  (2304 + 64 * (j))
#define XB_TOP      3328
#define XB_TOPGEN   3392
#define XCD_BAR_WORDS 3456
#define XB_SPIN_CAP (1u << 22)

__device__ __forceinline__ unsigned xb_ld(unsigned* p)              { return __hip_atomic_load(p, __ATOMIC_RELAXED, __HIP_MEMORY_SCOPE_AGENT); }
__device__ __forceinline__ unsigned xb_add(unsigned* p, unsigned v) { return __hip_atomic_fetch_add(p, v, __ATOMIC_RELAXED, __HIP_MEMORY_SCOPE_AGENT); }
__device__ __forceinline__ unsigned xb_xcc_id() { return (unsigned)__builtin_amdgcn_s_getreg((3 << 11) | 20) & 0xFu; }
#define XB_SPIN(cond, bar) do { unsigned _sp = 0; while (cond) { __builtin_amdgcn_s_sleep(1); \
    if ((++_sp & 255u) == 0u) { if (xb_ld(&(bar)[XB_TMO])) break; if (_sp > XB_SPIN_CAP) { atomicAdd(&(bar)[XB_TMO], 1u); break; } } } } while (0)

struct XcdBarrier { volatile LAS unsigned* st; };

__device__ __forceinline__ XcdBarrier xcd_barrier_post(unsigned* bar, volatile LAS unsigned* st) {
    XcdBarrier b; b.st = st;
    if (threadIdx.x == 0) { const unsigned x = xb_xcc_id(); st[2] = x; (void)xb_add(&bar[XB_XCNT(x)], 1u); }
    return b;
}
__device__ __forceinline__ void xcd_barrier_complete(unsigned* bar, unsigned x, unsigned& nloc, unsigned& nx) {
    const unsigned G = gridDim.x * gridDim.y * gridDim.z;
    unsigned sum, cnt, mine, sp = 0u;
    for (;;) {
        sum = 0u; cnt = 0u;
#pragma unroll
        for (unsigned j = 0; j < 16; ++j) { const unsigned c = xb_ld(&bar[XB_XCNT(j)]); sum += c; cnt += (c > 0u) ? 1u : 0u; }
        mine = xb_ld(&bar[XB_XCNT(x)]);
        if (sum == G) break;
        __builtin_amdgcn_s_sleep(1);
        if ((++sp & 255u) == 0u) { if (xb_ld(&bar[XB_TMO])) break; if (sp > XB_SPIN_CAP) { atomicAdd(&bar[XB_TMO], 1u); break; } }
    }
    nloc = mine > 0u ? mine : 1u; nx = cnt > 0u ? cnt : 1u;
}
__device__ __forceinline__ void xcd_barrier(const XcdBarrier& b, unsigned* bar) {
    asm volatile("s_waitcnt vmcnt(0)" ::: "memory");
    __syncthreads();
    if (threadIdx.x == 0) {
        __builtin_amdgcn_s_waitcnt(0);
        unsigned nloc = b.st[0], nx = b.st[1]; const unsigned bx_ = b.st[2];
        if (nloc == 0u) { xcd_barrier_complete(bar, bx_, nloc, nx); b.st[0] = nloc; b.st[1] = nx; }
        const unsigned old = xb_add(&bar[XB_XSUB(bx_)], 1u);
        const unsigned gen = old / nloc;
        if (old + 1u == (gen + 1u) * nloc) {
            __builtin_amdgcn_fence(__ATOMIC_RELEASE, "agent");
            asm volatile("s_waitcnt vmcnt(0)" ::: "memory");
            const unsigned og = xb_add(&bar[XB_TOP], 1u);
            const unsigned tg = og / nx;
            if (og + 1u == (tg + 1u) * nx) xb_add(&bar[XB_TOPGEN], 1u);
            else XB_SPIN(xb_ld(&bar[XB_TOPGEN]) == tg, bar);
            __builtin_amdgcn_fence(__ATOMIC_ACQUIRE, "agent");
            xb_add(&bar[XB_XGEN(bx_)], 1u);
            asm volatile("s_waitcnt vmcnt(0)" ::: "memory");
        } else {
            XB_SPIN(xb_ld(&bar[XB_XGEN(bx_)]) == gen, bar);
            __builtin_amdgcn_fence(__ATOMIC_ACQUIRE, "agent");
            asm volatile("s_waitcnt vmcnt(0)" ::: "memory");
        }
    }
    __syncthreads();
}

constexpr int BM = 256, BK = 64, HALF = 128, HTB = HALF * BK * 2, NXCD = 8, WGM = 8;
__host__ __device__ __forceinline__ int lds_byte(int r, int c) { const int st = (r >> 4) * 2 + (c >> 5), rr = r & 15, cc = c & 31, ob = rr * 64 + cc * 2; return st * 1024 + (ob ^ (((ob >> 9) & 1) << 5)); }
__host__ __device__ __forceinline__ void stage_rc(int b, int& R, int& C) { const int st = b / 1024, sb = b % 1024, swz = sb ^ (((sb >> 9) & 1) << 5); R = (st >> 1) * 16 + swz / 64; C = (st & 1) * 32 + (swz % 64) / 2; }
__host__ __device__ __forceinline__ int perm32(int rho) { const int n = rho >> 4, i = rho & 15; return 8 * (i >> 2) + 4 * n + (i & 3); }

struct Unit { int pm, pn; };
struct TileOrder {
    int nM, nN, nwg, G, c;
    __device__ __forceinline__ void init(int nM_, int nN_, int G_, int c_) { nM = nM_; nN = nN_; nwg = nM * nN; G = G_; c = c_; }
    __device__ __forceinline__ bool next(int i, Unit& u) const {
        const long L = (long)i * G + c; if (L >= nwg) return false;
        int wgid = (int)L; { const int q = nwg / NXCD, r = nwg % NXCD, xcd = wgid % NXCD, off = wgid / NXCD; wgid = (xcd < r ? xcd * (q + 1) : r * (q + 1) + (xcd - r) * q) + off; }
        const int nig = WGM * nN, gid = wgid / nig, fm = gid * WGM, gsz = (nM - fm) < WGM ? (nM - fm) : WGM;
        u.pm = fm + ((wgid % nig) % gsz); u.pn = (wgid % nig) / gsz; return true;
    }
};

template <int NN> struct LinOrder {
    int nwg, G, c;
    __device__ __forceinline__ void init(int nM_, int, int G_, int c_) { nwg = nM_ * NN; G = G_; c = c_; }
    __device__ __forceinline__ bool next(int i, Unit& u) const { const int L = i * G + c; if (L >= nwg) return false; u.pm = L / NN; u.pn = L % NN; return true; }
};

typedef f32x4 AccT[2][2][4][2];
typedef unsigned u32x8 __attribute__((ext_vector_type(8)));
template <bool F8> struct Frag;
template <> struct Frag<false> { bf16x8 k[2]; };
template <> struct Frag<true> { u32x8 q; };

template <int K, class P>
__device__ __forceinline__ void gemm_phase(LAS unsigned char* lds, const P& p, const int stagger_ticks = 0, const int krep = 1, const bool sw = false) {
    int tid_ = threadIdx.x; asm volatile("" : "+v"(tid_));
    const int tid = tid_, wid = __builtin_amdgcn_readfirstlane(tid >> 6), lane = tid & 63, wr = wid >> 2, wc = wid & 3, fr = lane & 15, fq = lane >> 4;
    constexpr int RB = P::FP8 ? K : K * 2;
    constexpr int nt = RB / 128;
    constexpr unsigned hstep = (unsigned)HALF * RB;
    unsigned vA[2], vB[2], vG[2][2], vGn[2][2];
#pragma unroll
    for (int i = 0; i < 2; ++i) { int R, C; stage_rc(tid * 16 + i * 8192, R, C); const int Rb = P::PERM ? ((R & ~31) + perm32(R & 31)) : R;
        vA[i] = (unsigned)(R * RB + C * 2); vB[i] = (unsigned)(Rb * RB + C * 2); }
    constexpr size_t kstep = (size_t)(BK * 2);
    const unsigned ldsw = (unsigned)wid * 1024u;
    const int aoff = P::FP8 ? lds_byte(wr * 64 + fr, fq * 16) : lds_byte(wr * 64 + fr, fq * 8), boff = P::FP8 ? lds_byte(wc * 32 + fr, fq * 16) : lds_byte(wc * 32 + fr, fq * 8);
#define PG8_SA(b, h) (((b) * 2 + (h)) * HTB)
#define PG8_SB(b, h) ((4 + (b) * 2 + (h)) * HTB)
#define PG8_STAGE(bufoff, gbase, v0, v1) do { \
        __builtin_amdgcn_global_load_lds((const unsigned*)((const char*)(gbase) + (v0)), (LAS unsigned*)(lds + (bufoff) + ldsw), 16, 0, 0); \
        __builtin_amdgcn_global_load_lds((const unsigned*)((const char*)(gbase) + (v1)), (LAS unsigned*)(lds + (bufoff) + ldsw + 8192), 16, 0, 0); } while (0)
#define PG8_STB(bufoff, gbase, h) PG8_STAGE(bufoff, (gbase) + (h) * hstep, vB[0], vB[1])
#define PG8_STAX(bufoff, gbase, h, nx) do { if constexpr (P::GATHER) { PG8_STAGE(bufoff, gbase, ((nx) ? vGn[h][0] : vG[h][0]), ((nx) ? vGn[h][1] : vG[h][1])); } \
        else { PG8_STAGE(bufoff, (gbase) + (h) * hstep, vA[0], vA[1]); } } while (0)
#define PG8_STA(bufoff, gbase, h) PG8_STAX(bufoff, gbase, h, false)
#define PG8_LD8(addr) __builtin_shufflevector(*(const LAS u32x4*)((addr) + f8lo), *(const LAS u32x4*)((addr) + f8hi), 0, 1, 2, 3, 4, 5, 6, 7)
#define PG8_LDA(dst, b, h) do { if constexpr (P::FP8) { _Pragma("unroll") for (int m = 0; m < 4; ++m) dst[m].q = PG8_LD8(lds + PG8_SA(b, h) + aoff + m * 2048); } \
        else { _Pragma("unroll") for (int m = 0; m < 4; ++m) _Pragma("unroll") for (int k = 0; k < 2; ++k) dst[m].k[k] = *(const LAS bf16x8*)(lds + PG8_SA(b, h) + aoff + m * 2048 + k * 1024); } } while (0)
#define PG8_LDB(dst, b, h) do { if constexpr (P::FP8) { _Pragma("unroll") for (int n = 0; n < 2; ++n) dst[n].q = PG8_LD8(lds + PG8_SB(b, h) + boff + n * 2048); } \
        else { _Pragma("unroll") for (int n = 0; n < 2; ++n) _Pragma("unroll") for (int k = 0; k < 2; ++k) dst[n].k[k] = *(const LAS bf16x8*)(lds + PG8_SB(b, h) + boff + n * 2048 + k * 1024); } } while (0)
#define PG8_MMA(ai, bj, At, Bt) do { __builtin_amdgcn_s_setprio(1); if constexpr (P::FP8) { _Pragma("unroll") for (int m = 0; m < 4; ++m) _Pragma("unroll") for (int n = 0; n < 2; ++n) \
            asm volatile("v_mfma_scale_f32_16x16x128_f8f6f4 %0, %1, %2, %0, %3, %3 op_sel_hi:[0,0,0]" : "+v"(acc[ai][bj][m][n]) : "v"(Bt[n].q), "v"(At[m].q), "v"(f8scale)); } \
        else { _Pragma("unroll") for (int m = 0; m < 4; ++m) _Pragma("unroll") for (int n = 0; n < 2; ++n) _Pragma("unroll") for (int k = 0; k < 2; ++k) \
            acc[ai][bj][m][n] = __builtin_amdgcn_mfma_f32_16x16x32_bf16(Bt[n].k[k], At[m].k[k], acc[ai][bj][m][n], 0, 0, 0); } __builtin_amdgcn_s_setprio(0); } while (0)
#define PG8_WAIT_V(n) asm volatile("s_waitcnt vmcnt(" #n ")" ::: "memory")
#define PG8_WAIT_L(n) asm volatile("s_waitcnt lgkmcnt(" #n ")" ::: "memory")
#define PG8_BAR __builtin_amdgcn_s_barrier()
#define PG8_SCHED __builtin_amdgcn_sched_barrier(0)
#define PG8_GROWS(dst, u) do { if constexpr (P::GATHER) { _Pragma("unroll") for (int i = 0; i < 2; ++i) { int R, C; stage_rc(tid * 16 + i * 8192, R, C); \
        _Pragma("unroll") for (int h = 0; h < 2; ++h) dst[h][i] = (unsigned)(p.arow(u, h * HALF + R) * RB + C * 2); } } } while (0)
    Unit cur, nxt; int ui = 0;
    if (!p.next(0, cur)) return;
    sw_start(lds, 1, sw);
    if (stagger_ticks > 0) {
        const unsigned long long t0 = __builtin_amdgcn_s_memrealtime();
        const unsigned k = (blockIdx.x >> 3) & 31u;
        const unsigned long long dt = (unsigned long long)(k * (unsigned)stagger_ticks) >> 5;
        while (__builtin_amdgcn_s_memrealtime() - t0 < dt) __builtin_amdgcn_s_sleep(8);
    }
    AccT acc;
#pragma unroll
    for (int a = 0; a < 2; ++a)
#pragma unroll
        for (int b = 0; b < 2; ++b)
#pragma unroll
            for (int m = 0; m < 4; ++m)
#pragma unroll
                for (int n = 0; n < 2; ++n) acc[a][b][m][n] = (f32x4){0.f, 0.f, 0.f, 0.f};
    Frag<P::FP8> At[4], B0[2], B1[2];
    const int f8lo = (fq & 1) * 16, f8hi = 16 - f8lo;
    unsigned f8scale = 0x7f7f7f7fu; asm volatile("" : "+v"(f8scale));
    const char* cA = p.abase(cur); const char* cB = p.bbase(cur);
    PG8_GROWS(vG, cur);
    PG8_GROWS(vGn, cur);
    PG8_STB(PG8_SB(0, 0), cB, 0); PG8_STB(PG8_SB(0, 1), cB, 1); PG8_STA(PG8_SA(0, 0), cA, 0); PG8_STA(PG8_SA(0, 1), cA, 1);
    if (wr == 1) PG8_BAR;
    PG8_WAIT_V(2); PG8_BAR;
    PG8_STB(PG8_SB(1, 0), cB + kstep, 0); PG8_STA(PG8_SA(1, 0), cA + kstep, 0); PG8_STB(PG8_SB(1, 1), cB + kstep, 1);
    PG8_WAIT_V(6); PG8_BAR;
    for (;;) {
        const bool has_next = p.next(ui + 1, nxt);
        const char* nA = cA; const char* nB = cB;
        if (has_next) { nA = p.abase(nxt); nB = p.bbase(nxt); PG8_GROWS(vGn, nxt); }
        sw_stop(lds, 4, sw && ui > 0); sw_start(lds, 2, sw);
#pragma unroll 1
        for (int krep_ = 0; krep_ < KLOOP_REP * krep; ++krep_) {
        const bool realnext_ = (krep_ == KLOOP_REP * krep - 1);
        if (krep_ > 0) {
#pragma unroll
            for (int a = 0; a < 2; ++a)
#pragma unroll
                for (int b = 0; b < 2; ++b)
#pragma unroll
                    for (int m = 0; m < 4; ++m)
#pragma unroll
                        for (int n = 0; n < 2; ++n) acc[a][b][m][n] = (f32x4){0.f, 0.f, 0.f, 0.f};
        }
#pragma unroll 1
        for (int t = 0; t < nt; t += 2) {
            const bool lastt_ = (t == nt - 2);
            const bool last = lastt_ && realnext_;
            const char* a1 = cA + (size_t)(t + 1) * kstep;
            const char* a2 = lastt_ ? (realnext_ ? nA : cA) : cA + (size_t)(t + 2) * kstep; const char* b2 = lastt_ ? (realnext_ ? nB : cB) : cB + (size_t)(t + 2) * kstep;
            const char* a3 = a2 + kstep; const char* b3 = b2 + kstep;
            PG8_LDB(B0, 0, 0); PG8_LDB(B1, 0, 1); PG8_SCHED; PG8_LDA(At, 0, 0); PG8_STA(PG8_SA(1, 1), a1, 1);
            PG8_WAIT_V(8); PG8_WAIT_L(0); PG8_BAR; PG8_MMA(0, 0, At, B0); PG8_MMA(0, 1, At, B1); PG8_BAR; PG8_SCHED;
            PG8_LDA(At, 0, 1); PG8_STB(PG8_SB(0, 0), b2, 0); PG8_STB(PG8_SB(0, 1), b2, 1); PG8_STAX(PG8_SA(0, 0), a2, 0, last);
            PG8_WAIT_V(8); PG8_WAIT_L(0); PG8_BAR; PG8_MMA(1, 0, At, B0); PG8_MMA(1, 1, At, B1); PG8_BAR; PG8_SCHED;
            PG8_LDB(B0, 1, 0); PG8_LDB(B1, 1, 1); PG8_SCHED; PG8_LDA(At, 1, 0); PG8_STAX(PG8_SA(0, 1), a2, 1, last);
            PG8_WAIT_V(8); PG8_WAIT_L(0); PG8_BAR; PG8_MMA(0, 0, At, B0); PG8_MMA(0, 1, At, B1); PG8_BAR; PG8_SCHED;
            PG8_LDA(At, 1, 1); PG8_STB(PG8_SB(1, 0), b3, 0); PG8_STB(PG8_SB(1, 1), b3, 1); PG8_STAX(PG8_SA(1, 0), a3, 0, last);
            PG8_WAIT_V(8); PG8_WAIT_L(0); PG8_BAR; PG8_MMA(1, 0, At, B0); PG8_MMA(1, 1, At, B1); PG8_BAR; PG8_SCHED;
        }
        }
        sw_stop(lds, 2, sw); sw_start(lds, 3, sw);
        if (GEMM_ALIGN && wr == 0) PG8_BAR;
        if constexpr (P::FP8) asm volatile("s_nop 15\n\ts_nop 15" ::: "memory");
        if constexpr (P::EREP > 1) { int er_ = P::EREP; asm volatile("" : "+s"(er_));
#pragma unroll 1
            for (; er_ > 0; --er_) p.epi(acc, cur, wr, wc, fr, fq); }
        else p.epi(acc, cur, wr, wc, fr, fq);
        sw_stop(lds, 3, sw); sw_start(lds, 4, sw);
        if (!has_next) break;
#pragma unroll
        for (int a = 0; a < 2; ++a)
#pragma unroll
            for (int b = 0; b < 2; ++b)
#pragma unroll
                for (int m = 0; m < 4; ++m)
#pragma unroll
                    for (int n = 0; n < 2; ++n) acc[a][b][m][n] = (f32x4){0.f, 0.f, 0.f, 0.f};
        cur = nxt; cA = nA; cB = nB; ++ui;
        if constexpr (P::GATHER) {
#pragma unroll
            for (int h = 0; h < 2; ++h)
#pragma unroll
                for (int i = 0; i < 2; ++i) vG[h][i] = vGn[h][i];
        }
        if (GEMM_ALIGN && wr == 1) PG8_BAR;
    }
    PG8_WAIT_V(0);
    if (!GEMM_ALIGN && wr == 0) PG8_BAR;
    PG8_BAR;
    sw_stop(lds, 1, sw);
#undef PG8_SA
#undef PG8_SB
#undef PG8_STAGE
#undef PG8_STB
#undef PG8_STA
#undef PG8_STAX
#undef PG8_LDA
#undef PG8_LDB
#undef PG8_MMA
#undef PG8_WAIT_V
#undef PG8_WAIT_L
#undef PG8_BAR
#undef PG8_SCHED
#undef PG8_GROWS
#undef PG8_LD8
}


struct PolU {
    static constexpr bool PERM = true, GATHER = false, FP8 = false; static constexpr int EREP = EREP_U;
    TileOrder S; const bf16_t* A; const bf16_t* B; bf16_t* UT; bf16_t* UTc;
    __device__ __forceinline__ bool next(int i, Unit& u) const { return S.next(i, u); }
    __device__ __forceinline__ const char* abase(const Unit& u) const { return (const char*)A + (unsigned)u.pm * (unsigned)(BM * D * 2); }
    __device__ __forceinline__ const char* bbase(const Unit& u) const { return (const char*)B + (unsigned)u.pn * (unsigned)(BM * D * 2); }
    __device__ __forceinline__ int arow(const Unit&, int) const { return 0; }
    __device__ __forceinline__ void epi(const AccT& acc, const Unit& u, int wr, int wc, int fr, int fq) const {
        bf16_t* base; int Lrow;
        if (u.pn < 256) { const int b = u.pn >> 4; base = UT + (size_t)b * UCH * SEQ + (u.pn & 15) * 256; Lrow = SEQ; }
        else { const int b = u.pn - 256; base = UTc + (size_t)b * UCH * LCTX; Lrow = LCTX; }
        const int ch0 = u.pm * BM + wr * 64 + fr, c0 = wc * 32 + 8 * fq;
#pragma unroll
        for (int ai = 0; ai < 2; ++ai)
#pragma unroll
            for (int m = 0; m < 4; ++m) { bf16_t* rowp = base + (size_t)(ch0 + ai * HALF + m * 16) * Lrow + c0;
#pragma unroll
                for (int bj = 0; bj < 2; ++bj) { const f32x4 v0 = acc[ai][bj][m][0], v1 = acc[ai][bj][m][1];
                    u32x4 w; w.x = cvt_pk_bf16(v0[0], v0[1]); w.y = cvt_pk_bf16(v0[2], v0[3]); w.z = cvt_pk_bf16(v1[0], v1[1]); w.w = cvt_pk_bf16(v1[2], v1[3]);
                    *(u32x4*)(rowp + bj * HALF) = w; } }
    }
};

struct PolF {
    static constexpr bool PERM = true, GATHER = false, FP8 = false; static constexpr int EREP = 1;
    TileOrder S; const bf16_t* DFT; const bf16_t* ZT; bf16_t* MIX; int K, L, tpb  , rowbase; unsigned zstride  ; float scale;
    __device__ __forceinline__ bool next(int i, Unit& u) const { return S.next(i, u); }
    __device__ __forceinline__ const char* abase(const Unit& u) const { return (const char*)DFT + (unsigned)(u.pm % tpb) * (unsigned)(BM * K * 2); }
    __device__ __forceinline__ const char* bbase(const Unit& u) const { return (const char*)ZT + ((unsigned)(u.pm / tpb) * zstride + (unsigned)u.pn * (unsigned)(BM * K)) * 2u; }
    __device__ __forceinline__ int arow(const Unit&, int) const { return 0; }
    __device__ __forceinline__ void epi(const AccT& acc, const Unit& u, int wr, int wc, int fr, int fq) const {
        const int b = u.pm / tpb, kt = u.pm % tpb;
        const int row0 = rowbase + b * L + kt * BM + wr * 64 + fr, c0 = u.pn * BM + wc * 32 + 8 * fq;
#pragma unroll
        for (int ai = 0; ai < 2; ++ai)
#pragma unroll
            for (int m = 0; m < 4; ++m) { bf16_t* rowp = MIX + (size_t)(row0 + ai * HALF + m * 16) * D + c0;
#pragma unroll
                for (int bj = 0; bj < 2; ++bj) { const f32x4 v0 = acc[ai][bj][m][0] * scale, v1 = acc[ai][bj][m][1] * scale;
                    u32x4 w; w.x = cvt_pk_bf16(v0[0], v0[1]); w.y = cvt_pk_bf16(v0[2], v0[3]); w.z = cvt_pk_bf16(v1[0], v1[1]); w.w = cvt_pk_bf16(v1[2], v1[3]);
                    *(u32x4*)(rowp + bj * HALF) = w; } }
    }
};

template <bool F8, bool X16IN>
struct PolR {
    static constexpr bool PERM = true, GATHER = false, FP8 = F8; static constexpr int EREP = 1;
    static constexpr int ES = F8 ? 1 : 2;
    TileOrder S; const void* A; const void* B; int K; const float* srcL; bf16_t* XB; const float* srcC; float* dstC; const float* gate  ;
    __device__ __forceinline__ bool next(int i, Unit& u) const { return S.next(i, u); }
    __device__ __forceinline__ const char* abase(const Unit& u) const { return (const char*)A + (size_t)((unsigned)u.pm * (unsigned)(BM * ES)) * (unsigned)K; }
    __device__ __forceinline__ const char* bbase(const Unit& u) const { return (const char*)B + (unsigned)u.pn * (unsigned)(BM * K * ES); }
    __device__ __forceinline__ int arow(const Unit&, int) const { return 0; }
    __device__ __forceinline__ void epi(const AccT& acc, const Unit& u, int wr, int wc, int fr, int fq) const {
        const bool lat = u.pm < 256;
        const float* gp = gate + (size_t)(lat ? (u.pm >> 4) : 16) * NMOD;
        const int row0 = wr * 64 + fr, col0 = u.pn * BM + wc * 32 + 8 * fq;
        constexpr float gs = F8 ? 1.0f / (F8_HID * F8_W) : 1.0f;
        f32x4 gv[2][2];
#pragma unroll
        for (int bj = 0; bj < 2; ++bj)
#pragma unroll
            for (int n = 0; n < 2; ++n) gv[bj][n] = *(const f32x4*)(gp + col0 + bj * HALF + n * 4) * gs;
        if (lat) {
            bf16_t* xbt = XB + (size_t)u.pm * BM * D; const float* srt = X16IN ? nullptr : srcL + (size_t)u.pm * BM * D;
#pragma unroll
            for (int ai = 0; ai < 2; ++ai)
#pragma unroll
                for (int m = 0; m < 4; ++m) { const unsigned ro = (unsigned)((row0 + ai * HALF + m * 16) * D + col0);
#pragma unroll
                    for (int bj = 0; bj < 2; ++bj) { f32x4 x0, x1;
                        if constexpr (X16IN) { const u32x4 w = *(const u32x4*)(xbt + ro + bj * HALF); x0 = (f32x4){bflo(w.x), bfhi(w.x), bflo(w.y), bfhi(w.y)}; x1 = (f32x4){bflo(w.z), bfhi(w.z), bflo(w.w), bfhi(w.w)}; }
                        else { x0 = *(const f32x4*)(srt + ro + bj * HALF); x1 = *(const f32x4*)(srt + ro + bj * HALF + 4); }
                        x0 += gv[bj][0] * acc[ai][bj][m][0]; x1 += gv[bj][1] * acc[ai][bj][m][1];
                        u32x4 o; o.x = cvt_pk_bf16(x0[0], x0[1]); o.y = cvt_pk_bf16(x0[2], x0[3]); o.z = cvt_pk_bf16(x1[0], x1[1]); o.w = cvt_pk_bf16(x1[2], x1[3]);
                        *(u32x4*)(xbt + ro + bj * HALF) = o; } }
        } else {
            const size_t t0 = (size_t)(u.pm - 256) * BM * D;
#pragma unroll
            for (int ai = 0; ai < 2; ++ai)
#pragma unroll
                for (int m = 0; m < 4; ++m) { const unsigned ro = (unsigned)t0 + (unsigned)((row0 + ai * HALF + m * 16) * D + col0);
#pragma unroll
                    for (int bj = 0; bj < 2; ++bj)
#pragma unroll
                        for (int n = 0; n < 2; ++n) { const f32x4 x = *(const f32x4*)(srcC + ro + bj * HALF + n * 4);
                            *(f32x4*)(dstC + ro + bj * HALF + n * 4) = x + gv[bj][n] * acc[ai][bj][m][n]; } }
        }
    }
};

template <bool GATH, class ORD, bool F8, bool O8 = F8>
struct PolG {
    static constexpr bool PERM = true, GATHER = GATH, FP8 = F8; static constexpr int EREP = GATH ? EREP_GM : EREP_G;
    static constexpr int ES = F8 ? 1 : 2;
    ORD S; const void* A; const void* B; void* H; const int* tok; const int* tile_e; int tile0;
    __device__ __forceinline__ bool next(int i, Unit& u) const { return S.next(i, u); }
    __device__ __forceinline__ const char* abase(const Unit& u) const { return GATH ? (const char*)A : (const char*)A + (unsigned)u.pm * (unsigned)(BM * D * ES); }
    __device__ __forceinline__ const char* bbase(const Unit& u) const { const unsigned e = GATH ? (unsigned)tile_e[tile0 + u.pm] : 0u; return (const char*)B + (e * (unsigned)(2 * DFF) + (unsigned)u.pn * BM) * (unsigned)(D * ES); }
    __device__ __forceinline__ int arow(const Unit& u, int r) const { return tok[(tile0 + u.pm) * BM + r]; }
    __device__ __forceinline__ void epi(const AccT& acc, const Unit& u, int wr, int wc, int fr, int fq) const {
        const int row0 = u.pm * BM + wr * 64 + fr, c0 = u.pn * HALF + wc * 32 + 8 * fq;
        constexpr float isc = F8 ? 1.0f / (F8_ACT * F8_W) : 1.0f;
#pragma unroll
        for (int ai = 0; ai < 2; ++ai)
#pragma unroll
            for (int m = 0; m < 4; ++m) {
                float h[8];
#pragma unroll
                for (int n = 0; n < 2; ++n)
#pragma unroll
                    for (int j = 0; j < 4; ++j) { const float g = acc[ai][0][m][n][j] * isc, up = acc[ai][1][m][n][j] * isc; h[n * 4 + j] = silu_f(g) * up; }
                const size_t ro = (size_t)(row0 + ai * HALF + m * 16) * DFF + c0;
                if constexpr (O8) { u32x2 w; w.x = pk4_fp8(h[0] * F8_HID, h[1] * F8_HID, h[2] * F8_HID, h[3] * F8_HID); w.y = pk4_fp8(h[4] * F8_HID, h[5] * F8_HID, h[6] * F8_HID, h[7] * F8_HID);
                    *(u32x2*)((fp8_t*)H + ro) = w; }
                else { u32x4 w; w.x = cvt_pk_bf16(h[0], h[1]); w.y = cvt_pk_bf16(h[2], h[3]); w.z = cvt_pk_bf16(h[4], h[5]); w.w = cvt_pk_bf16(h[6], h[7]);
                    *(u32x4*)((bf16_t*)H + ro) = w; } }
    }
};

constexpr int NQK_UNITS = (MROWS / BM) * 5;
constexpr float QSCALE = 0.18033688011112042f;
struct PolQKV {
    static constexpr bool PERM = false, GATHER = false, FP8 = false; static constexpr int EREP = EREP_QKV;
    TileOrder S; const bf16_t* HX; const bf16_t* W; unsigned char* ws; const float* qkg  ; const float* ropec; const float* ropes;
    __device__ __forceinline__ bool next(int i, Unit& u) const {
        const int L = i * S.G + S.c;
        if (L < NQK_UNITS) return S.next(i, u);
        if (L < NQK_UNITS + MROWS / BM) { u.pm = L - NQK_UNITS; u.pn = 5; return true; }
        return false;
    }
    __device__ __forceinline__ const char* abase(const Unit& u) const { return u.pn == 5 ? (const char*)W + (unsigned)(1280 * D * 2) : (const char*)HX + (unsigned)u.pm * (unsigned)(BM * D * 2); }
    __device__ __forceinline__ const char* bbase(const Unit& u) const { return u.pn == 5 ? (const char*)HX + (unsigned)u.pm * (unsigned)(BM * D * 2) : (const char*)W + (unsigned)u.pn * (unsigned)(BM * D * 2); }
    __device__ __forceinline__ int arow(const Unit&, int) const { return 0; }
    __device__ __forceinline__ void epi(const AccT& acc, const Unit& u, int wr, int wc, int fr, int fq) const {
        if (u.pn == 5) {
            const bool lat = u.pm < 256;
            bf16_t* base = (bf16_t*)(ws + OFF_V) + (lat ? (size_t)(u.pm >> 4) * 256 * SEQ + (u.pm & 15) * 256 : (size_t)NB * 256 * SEQ + (size_t)(u.pm - 256) * 256 * LCTX);
            const int Lrow = lat ? SEQ : LCTX;
            const int f0 = wr * 64 + fr, p0 = wc * 32 + 8 * (fq & 1) + 4 * (fq >> 1);
#pragma unroll
            for (int ai = 0; ai < 2; ++ai)
#pragma unroll
                for (int m = 0; m < 4; ++m) { bf16_t* rowp = base + (size_t)(f0 + ai * HALF + m * 16) * Lrow + p0;
#pragma unroll
                    for (int bj = 0; bj < 2; ++bj)
#pragma unroll
                        for (int n = 0; n < 2; ++n) { const f32x4 v = acc[ai][bj][m][n]; u32x2 w; w.x = cvt_pk_bf16(v[0], v[1]); w.y = cvt_pk_bf16(v[2], v[3]);
                            *(u32x2*)(rowp + bj * HALF + n * 16) = w; } }
            return;
        }
        const int tile = u.pn; const bool ctxrow = u.pm >= 256;
        if (tile < 4 && ctxrow) return;
        const float* gsrc = qkg + (tile < 4 ? 0 : 64);
        const float osc = tile < 4 ? QSCALE : 1.0f;
        f32x4 gv[2][2];
#pragma unroll
        for (int bj = 0; bj < 2; ++bj)
#pragma unroll
            for (int n = 0; n < 2; ++n) gv[bj][n] = *(const f32x4*)(gsrc + 32 * bj + 16 * n + 4 * fq);
#pragma unroll
        for (int ai = 0; ai < 2; ++ai)
#pragma unroll
            for (int m = 0; m < 4; ++m) {
                const int r = u.pm * BM + ai * HALF + wr * 64 + m * 16 + fr;
                f32x4 v[2][2];
#pragma unroll
                for (int bj = 0; bj < 2; ++bj)
#pragma unroll
                    for (int n = 0; n < 2; ++n) v[bj][n] = acc[ai][bj][m][n];
                float ss = 0.f;
#pragma unroll
                for (int bj = 0; bj < 2; ++bj)
#pragma unroll
                    for (int n = 0; n < 2; ++n) ss += v[bj][n][0] * v[bj][n][0] + v[bj][n][1] * v[bj][n][1] + v[bj][n][2] * v[bj][n][2] + v[bj][n][3] * v[bj][n][3];
                ss += __shfl_xor(ss, 16); ss += __shfl_xor(ss, 32);
                const float rs = rsqrtf(ss * (1.0f / 64.0f) + EPS) * osc;
#pragma unroll
                for (int bj = 0; bj < 2; ++bj)
#pragma unroll
                    for (int n = 0; n < 2; ++n) v[bj][n] = v[bj][n] * rs * gv[bj][n];
                if (!ctxrow) {
                    const int l = r & (SEQ - 1), prow = l >> 6, pcol = l & 63;
#pragma unroll
                    for (int bj = 0; bj < 2; ++bj) { const int pp = bj ? pcol : prow;
                        const f32x4 cs = *(const f32x4*)(ropec + pp * 16 + 4 * fq), sn = *(const f32x4*)(ropes + pp * 16 + 4 * fq);
                        const f32x4 s1 = v[bj][0], s2 = v[bj][1];
                        v[bj][0] = s1 * cs - s2 * sn; v[bj][1] = s1 * sn + s2 * cs; }
                }
                const size_t doff = tile < 4 ? OFF_Q + ((size_t)r * D + (tile * 4 + wc) * 64) * 2 : OFF_K + ((size_t)r * 256 + wc * 64) * 2;
                bf16_t* dst = (bf16_t*)(ws + doff);
#pragma unroll
                for (int bj = 0; bj < 2; ++bj)
#pragma unroll
                    for (int n = 0; n < 2; ++n) { u32x2 w; w.x = cvt_pk_bf16(v[bj][n][0], v[bj][n][1]); w.y = cvt_pk_bf16(v[bj][n][2], v[bj][n][3]);
                        *(u32x2*)(dst + 32 * bj + 16 * n + 4 * fq) = w; }
            }
    }
};

struct PolD {
    static constexpr bool PERM = true, GATHER = false, FP8 = true; static constexpr int EREP = EREP_D;
    LinOrder<4> S; const fp8_t* A; const fp8_t* B; bf16_t* Y; const float* gw; const int* tile_e; int tile0;
    __device__ __forceinline__ bool next(int i, Unit& u) const { return S.next(i, u); }
    __device__ __forceinline__ const char* abase(const Unit& u) const { return (const char*)A + (size_t)(unsigned)u.pm * (size_t)(BM * DFF); }
    __device__ __forceinline__ const char* bbase(const Unit& u) const { const unsigned e = (unsigned)tile_e[tile0 + u.pm]; return (const char*)B + (e * (unsigned)D + (unsigned)u.pn * BM) * (unsigned)DFF; }
    __device__ __forceinline__ int arow(const Unit&, int) const { return 0; }
    __device__ __forceinline__ void epi(const AccT& acc, const Unit& u, int wr, int wc, int fr, int fq) const {
        const int slot0 = (tile0 + u.pm) * BM + wr * 64 + fr, c0 = u.pn * BM + wc * 32 + 8 * fq;
#pragma unroll
        for (int ai = 0; ai < 2; ++ai)
#pragma unroll
            for (int m = 0; m < 4; ++m) { const int slot = slot0 + ai * HALF + m * 16; const float g = gw[slot] * (1.0f / (F8_HID * F8_W)); bf16_t* rowp = Y + (size_t)slot * D + c0;
#pragma unroll
                for (int bj = 0; bj < 2; ++bj) { const f32x4 v0 = acc[ai][bj][m][0] * g, v1 = acc[ai][bj][m][1] * g;
                    u32x4 w; w.x = cvt_pk_bf16(v0[0], v0[1]); w.y = cvt_pk_bf16(v0[2], v0[3]); w.z = cvt_pk_bf16(v1[0], v1[1]); w.w = cvt_pk_bf16(v1[2], v1[3]);
                    *(u32x4*)(rowp + bj * HALF) = w; } }
    }
};

enum { RM_OFF = 0, RM_GU_G = 1, RM_GU_U = 2, RM_QKV = 3 };
template <int RM> __device__ __forceinline__ int rowmap(int n, int off) {
    if (RM == RM_GU_G) return (n >> 7) * 256 + (n & 127);
    if (RM == RM_GU_U) return (n >> 7) * 256 + 128 + (n & 127);
    if (RM == RM_QKV) { const int tile = n >> 8, f = n & 255, hh = f >> 6, d = f & 63, bj = d >> 5, q = d & 31; return tile * 256 + 128 * bj + 32 * hh + q; }
    return n + off;
}
template <int RM, bool F8>
__device__ __forceinline__ void tconv_g(const float* __restrict__ src, int Ks, int ldn, int c0, int ncols, void* __restrict__ dst_, int off, LAS unsigned char* lds, int start, int stride) {
    const int tid = otid(), kk = tid >> 4, n4 = (tid & 15) * 4;
    const int nkg = Ks >> 8, ngrp = nkg * (ncols >> 6);
    if (start >= ngrp) return;
    f32x4 v[8], vn[8];
    { const int kg = start % nkg, ntl = start / nkg; const float* p = src + (size_t)(kg * 256 + 8 * kk) * ldn + c0 + ntl * 64 + n4;
#pragma unroll
      for (int i = 0; i < 8; ++i) v[i] = *(const f32x4*)(p + (size_t)i * ldn); }
    for (int g = start; g < ngrp; g += stride) {
        const bool more = g + stride < ngrp;
        if (more) { const int kg = (g + stride) % nkg, ntl = (g + stride) / nkg; const float* p = src + (size_t)(kg * 256 + 8 * kk) * ldn + c0 + ntl * 64 + n4;
#pragma unroll
            for (int i = 0; i < 8; ++i) vn[i] = *(const f32x4*)(p + (size_t)i * ldn); }
        const int kg = g % nkg, ntl = g / nkg, k0 = kg * 256, n0 = ntl * 64;
        if constexpr (F8) {
#pragma unroll
            for (int j = 0; j < 4; ++j) { u32x2 w; w.x = pk4_fp8(v[0][j] * F8_W, v[1][j] * F8_W, v[2][j] * F8_W, v[3][j] * F8_W); w.y = pk4_fp8(v[4][j] * F8_W, v[5][j] * F8_W, v[6][j] * F8_W, v[7][j] * F8_W);
                *(LAS u32x2*)(lds + (n4 + j) * 272 + 8 * kk) = w; }
            __syncthreads();
#pragma unroll
            for (int i2 = 0; i2 < 2; ++i2) { const int n = (tid >> 4) + 32 * i2, k16 = (tid & 15) * 16;
                const u32x4 w = *(const LAS u32x4*)(lds + n * 272 + k16);
                *(u32x4*)((fp8_t*)dst_ + (size_t)rowmap<RM>(n0 + n, off) * Ks + k0 + k16) = w; }
        } else {
#pragma unroll
            for (int j = 0; j < 4; ++j) { u32x4 w; w.x = cvt_pk_bf16(v[0][j], v[1][j]); w.y = cvt_pk_bf16(v[2][j], v[3][j]); w.z = cvt_pk_bf16(v[4][j], v[5][j]); w.w = cvt_pk_bf16(v[6][j], v[7][j]);
                *(LAS u32x4*)(lds + (n4 + j) * 528 + 16 * kk) = w; }
            __syncthreads();
#pragma unroll
            for (int i2 = 0; i2 < 4; ++i2) { const int q = tid + 512 * i2, n = q >> 5, kq = q & 31;
                const u32x4 w = *(const LAS u32x4*)(lds + n * 528 + kq * 16);
                *(u32x4*)((bf16_t*)dst_ + (size_t)rowmap<RM>(n0 + n, off) * Ks + k0 + kq * 8) = w; }
        }
        __syncthreads();
        if (more) {
#pragma unroll
            for (int i = 0; i < 8; ++i) v[i] = vn[i]; }
    }
}

constexpr int MOE_CONV_TILES = NE * 2688;
struct CvJob { const float* src; fp8_t* dst; int ldn, Ks, rm, n0; };
__device__ __forceinline__ CvJob cv_decode(int q, const float* __restrict__ wg, const float* __restrict__ wu, const float* __restrict__ wd, fp8_t* __restrict__ MGU, fp8_t* __restrict__ MD) {
    CvJob j; const int e = q / 2688, r = q - e * 2688; int kt, ntl;
    if (r < 1792) { const int up = r >= 896, t = r - (up ? 896 : 0); j.src = (up ? wu : wg) + (size_t)e * D * DFF; j.dst = MGU + (size_t)e * 2 * DFF * D; j.ldn = DFF; j.Ks = 1024; j.rm = 1 + up; kt = t & 15; ntl = t >> 4; }
    else { const int t = r - 1792; j.src = wd + (size_t)e * DFF * D; j.dst = MD + (size_t)e * D * DFF; j.ldn = 1024; j.Ks = DFF; j.rm = 0; kt = t % 56; ntl = t / 56; }
    j.n0 = ntl * 64; j.src += (size_t)(kt * 64) * j.ldn + j.n0; j.dst += kt * 64;
    return j;
}
__device__ __forceinline__ void moe_conv_groups(const float* __restrict__ wg, const float* __restrict__ wu, const float* __restrict__ wd, fp8_t* __restrict__ MGU, fp8_t* __restrict__ MD,
                                                LAS unsigned char* lds, int gb, int ge, int gs) {
    if (gb >= ge) return;
    const int tid = otid(), kk = tid >> 4, n4 = (tid & 15) * 4;
    f32x4 v[8], vn[8];
    CvJob cj = cv_decode(4 * gb, wg, wu, wd, MGU, MD), nj = cj;
    { const float* p = cj.src + (size_t)(8 * kk) * cj.ldn + n4;
#pragma unroll
      for (int i = 0; i < 8; ++i) v[i] = *(const f32x4*)(p + (size_t)i * cj.ldn); }
    for (int g = gb; g < ge; g += gs) {
        const bool more = g + gs < ge;
        if (more) { nj = cv_decode(4 * (g + gs), wg, wu, wd, MGU, MD); const float* p = nj.src + (size_t)(8 * kk) * nj.ldn + n4;
#pragma unroll
            for (int i = 0; i < 8; ++i) vn[i] = *(const f32x4*)(p + (size_t)i * nj.ldn); }
#pragma unroll
        for (int j = 0; j < 4; ++j) { u32x2 w; w.x = pk4_fp8(v[0][j] * F8_W, v[1][j] * F8_W, v[2][j] * F8_W, v[3][j] * F8_W); w.y = pk4_fp8(v[4][j] * F8_W, v[5][j] * F8_W, v[6][j] * F8_W, v[7][j] * F8_W);
            *(LAS u32x2*)(lds + (n4 + j) * 272 + 8 * kk) = w; }
        __syncthreads();
#pragma unroll
        for (int i2 = 0; i2 < 2; ++i2) { const int n = (tid >> 4) + 32 * i2, k16 = (tid & 15) * 16, nn = cj.n0 + n;
            const u32x4 w = *(const LAS u32x4*)(lds + n * 272 + k16);
            const int orow = cj.rm == 0 ? nn : ((nn >> 7) * 256 + (nn & 127) + (cj.rm == 2 ? 128 : 0));
            *(u32x4*)(cj.dst + (size_t)orow * cj.Ks + k16) = w; }
        __syncthreads();
        if (more) { cj = nj;
#pragma unroll
            for (int i = 0; i < 8; ++i) v[i] = vn[i]; }
    }
}

__device__ __forceinline__ void fold_job(const float* __restrict__ w_in, bf16_t* __restrict__ WinT, LAS unsigned char* lds) {
    LAS float* W = (LAS float*)lds;
    LAS float* cs = W + 1024; LAS float* sn = cs + 128;
    const int tid = otid();
    if (tid < 128) { cs[tid] = cospif((float)tid / 64.0f); sn[tid] = sinpif((float)tid / 64.0f); }
    for (int it = blockIdx.x; it < 512; it += gridDim.x) {
        const int kb = it >> 2, g = it & 3;
        __syncthreads();
        { const int r = tid >> 6, c2 = (tid & 63) * 2; const f32x2 v = *(const f32x2*)(w_in + (size_t)(kb * 8 + r) * 2048 + g * 128 + c2); W[r * 128 + c2] = v.x; W[r * 128 + c2 + 1] = v.y; }
        __syncthreads();
        const int m = tid & 127, part = (tid >> 7) & 1, rh = tid >> 8;
        float a0 = 0.f, a1 = 0.f, a2 = 0.f, a3 = 0.f;
        for (int d = 0; d < 128; ++d) { const int idx = (m * d) & 127; const float tw = part ? sn[idx] : cs[idx];
            a0 += W[(rh * 4 + 0) * 128 + d] * tw; a1 += W[(rh * 4 + 1) * 128 + d] * tw; a2 += W[(rh * 4 + 2) * 128 + d] * tw; a3 += W[(rh * 4 + 3) * 128 + d] * tw; }
        u32x2 w; w.x = cvt_pk_bf16(a0, a1); w.y = cvt_pk_bf16(a2, a3);
        *(u32x2*)(WinT + (size_t)(2 * (g * 128 + m) + part) * D + kb * 8 + rh * 4) = w;
    }
    __syncthreads();
}

__device__ __forceinline__ void dft_job(bf16_t* __restrict__ DFTc, float* __restrict__ TW, LAS unsigned char* lds) {
    const int tid = otid();
    for (int idx = blockIdx.x * 512 + tid; idx < 256 * 512; idx += gridDim.x * 512) {
        const int k = idx >> 9, lp = idx & 511, kl = (k * (lp & 255)) & 255;
        const float v = lp < 256 ? cospif((float)kl / 128.0f) : -sinpif((float)kl / 128.0f);
        DFTc[idx] = f2bf(v);
    }
    for (int idx = blockIdx.x * 512 + tid; idx < 4096; idx += gridDim.x * 512) {
        const int l2 = idx >> 6, k1 = idx & 63; const float a = (float)(k1 * l2) / 2048.0f;
        TW[idx] = cospif(a); TW[4096 + idx] = sinpif(a);
    }
}

__device__ __forceinline__ void ada_job(const float* __restrict__ c, const float* __restrict__ c_ctx, const float* __restrict__ ada_w, const float* __restrict__ ada_b, float* __restrict__ MOD, LAS unsigned char* lds) {
    LAS float* sc = (LAS float*)lds;
    LAS float* red = sc + 17 * 1024;
    const int tid = otid();
    for (int i = tid; i < 17 * 1024; i += 512) { const float x = i < 16 * 1024 ? c[i] : c_ctx[i - 16 * 1024]; sc[i] = silu_f(x); }
    __syncthreads();
    for (int chunk = blockIdx.x; chunk < 256; chunk += gridDim.x) {
        const int layer = chunk >> 7, n0 = (chunk & 127) * 48;
        const float* wp = ada_w + (size_t)layer * D * NMOD + n0;
        const int c4 = tid % 12, kg = tid / 12;
        if (kg < 20) {
            f32x4 a[17];
#pragma unroll
            for (int r = 0; r < 17; ++r) a[r] = (f32x4){0.f, 0.f, 0.f, 0.f};
            for (int k = kg; k < D; k += 260) { f32x4 w[13];
#pragma unroll
                for (int u = 0; u < 13; ++u) { const int kk = k + 20 * u; w[u] = kk < D ? *(const f32x4*)(wp + (size_t)kk * NMOD + c4 * 4) : (f32x4){0.f, 0.f, 0.f, 0.f}; }
#pragma unroll
                for (int u = 0; u < 13; ++u) { const int kk = k + 20 * u; if (kk < D) {
#pragma unroll
                    for (int r = 0; r < 17; ++r) a[r] += sc[r * 1024 + kk] * w[u]; } } }
#pragma unroll
            for (int r = 0; r < 17; ++r) *(LAS f32x4*)(red + (kg * 17 + r) * 48 + c4 * 4) = a[r];
        }
        __syncthreads();
        for (int o = tid; o < 17 * 48; o += 512) { const int r = o / 48, cc = o % 48; float s = ada_b[layer * NMOD + n0 + cc];
#pragma unroll
            for (int g = 0; g < 20; ++g) s += red[(g * 17 + r) * 48 + cc];
            MOD[((size_t)layer * 17 + r) * NMOD + n0 + cc] = s; }
        __syncthreads();
    }
}

__device__ __forceinline__ void h3_job(const float* __restrict__ w0, const float* __restrict__ b0, const float* __restrict__ w1, const float* __restrict__ b1,
                                       const float* __restrict__ w2, const float* __restrict__ b2, const float* __restrict__ freq, float* __restrict__ H3) {
    const int tid = otid(), lane = tid & 63, wv = blockIdx.x * 8 + (tid >> 6), nw = gridDim.x * 8;
    const float fr = freq[lane];
    for (int p = wv; p < 4352; p += nw) {
        const int L = p < 4096 ? 4096 : 256, pos = p < 4096 ? p : p - 4096;
        const float t = (float)pos / (float)(L - 1);
        const float w = (float)(2.0 * 3.14159265358979323846 / (double)L) * (float)pos;
        const float band = 1e-4f + (float)(lane & 15) * ((15.0f - 1e-4f) / 15.0f);
        const float ang = w * band;
        const float cz = cosf(ang), sz = -sinf(ang);
        float a = t * w0[lane] + b0[lane];
#pragma unroll
        for (int b = 0; b < 16; ++b) a += __shfl(cz, b) * w0[(1 + b) * 64 + lane] + __shfl(sz, b) * w0[(17 + b) * 64 + lane];
        const float h1 = sinf(fr * a);
        float a2 = b1[lane];
#pragma unroll 8
        for (int i = 0; i < 64; ++i) a2 += __shfl(h1, i) * w1[i * 64 + lane];
        const float h2 = sinf(fr * a2);
        float a3 = b2[lane];
#pragma unroll 8
        for (int i = 0; i < 64; ++i) a3 += __shfl(h2, i) * w2[i * 64 + lane];
        H3[(size_t)lane * 4352 + p] = sinf(fr * a3);
    }
}

template <int L>
__device__ __forceinline__ void filt_fin(const float* __restrict__ H3, const float* __restrict__ w3, float* __restrict__ KFo, int cp, LAS unsigned char* lds) {
    LAS float* F = (LAS float*)lds;
    LAS float* Bk = F + 2 * L;
    LAS float* w3c = Bk + 2 * L;
    LAS float* red = w3c + 256;
    const int tid = otid(), lane = tid & 63, wid = tid >> 6;
    const int c0 = cp * 2;
    __syncthreads();
    if (tid < 256) { const int which = tid & 3, j = tid >> 2; w3c[tid] = w3[(size_t)j * 1024 + (which >> 1) * 512 + c0 + (which & 1)]; }
    __syncthreads();
    const float la = -3.0701134573253945f, lb = -15.350567286626973f;
    float dl[2];
#pragma unroll
    for (int cc = 0; cc < 2; ++cc) dl[cc] = fabsf(la + (float)(c0 + cc) * ((lb - la) / 511.0f));
    float ss0 = 0.f, ss1 = 0.f;
    for (int pos = tid; pos < L; pos += 512) {
        const float* hp = H3 + pos;
        asm volatile("" ::: "memory");
        f32x4 sv = (f32x4){0.f, 0.f, 0.f, 0.f};
        float hv[64];
#pragma unroll
        for (int j = 0; j < 64; ++j) hv[j] = hp[(size_t)j * 4352];
#pragma unroll
        for (int j = 0; j < 64; ++j) sv += hv[j] * *(const LAS f32x4*)(w3c + j * 4);
        const float s[4] = {sv[0], sv[1], sv[2], sv[3]};
        const float t = (float)pos / (float)(L - 1);
        const float d0 = __expf(-t * dl[0]), d1 = __expf(-t * dl[1]);
        const float f0 = s[0] * d0, f1 = s[1] * d1, g0 = s[2] * d0, g1 = s[3] * d1;
        F[pos] = f0; F[L + pos] = f1; Bk[pos] = g0; Bk[L + pos] = g1;
        ss0 += f0 * f0 + (pos >= 1 ? g0 * g0 : 0.f); ss1 += f1 * f1 + (pos >= 1 ? g1 * g1 : 0.f);
    }
    ss0 = wave_sum(ss0); ss1 = wave_sum(ss1);
    if (lane == 0) { red[wid] = ss0; red[8 + wid] = ss1; }
    __syncthreads();
    float n0 = 0.f, n1 = 0.f;
#pragma unroll
    for (int i = 0; i < 8; ++i) { n0 += red[i]; n1 += red[8 + i]; }
    const float nr[2] = {rsqrtf(n0 + EPS), rsqrtf(n1 + EPS)};
    if constexpr (L == SEQ) {
        bf16_t* RC = (bf16_t*)KFo;
#pragma unroll
        for (int cc = 0; cc < 2; ++cc)
            for (int i2 = tid; i2 < 4 * 1024; i2 += 512) { const int m = i2 >> 10, idx = (i2 & 1023) * 8; float v[8];
#pragma unroll
                for (int e = 0; e < 8; ++e) { const int d = L + m + 4 - (idx + e);
                    v[e] = (d >= L || d <= -L) ? 0.f : (d >= 0 ? F[cc * L + d] : Bk[cc * L - d]) * nr[cc]; }
                u32x4 w; w.x = cvt_pk_bf16(v[0], v[1]); w.y = cvt_pk_bf16(v[2], v[3]); w.z = cvt_pk_bf16(v[4], v[5]); w.w = cvt_pk_bf16(v[6], v[7]);
                *(u32x4*)(RC + ((size_t)(c0 + cc) * 4 + m) * 8192 + idx) = w; }
    } else {
#pragma unroll
        for (int cc = 0; cc < 2; ++cc)
            for (int idx = tid; idx < 2 * L; idx += 512) { const int d = idx - L;
                const float v = d >= 0 ? F[cc * L + d] : (d > -L ? Bk[cc * L - d] : 0.f);
                KFo[(size_t)(c0 + cc) * (2 * L) + idx] = v * nr[cc]; }
    }
    __syncthreads();
}

template <bool ROUTE, bool OUT8 = ROUTE, bool SRC16 = false>
__device__ __forceinline__ void norm_phase(const void* __restrict__ srcL_, const float* __restrict__ srcC, int nrows, const float* __restrict__ g, const float* __restrict__ modl  ,
                                           int shift_idx, bf16_t* __restrict__ HX, const float* __restrict__ wrt, unsigned* __restrict__ route, int* __restrict__ hist, LAS unsigned char* lds) {
    const int tid = otid(), lane = tid & 63, wid = tid >> 6;
    LAS int* lh = (LAS int*)lds;
    if (ROUTE) { if (tid < 8) lh[tid] = 0; __syncthreads(); }
    f32x4 rw[ROUTE ? 16 : 1][2];
    if constexpr (ROUTE) {
#pragma unroll
        for (int i = 0; i < 2; ++i)
#pragma unroll
            for (int q = 0; q < 2; ++q)
#pragma unroll
                for (int j = 0; j < 4; ++j) { const int k = i * 512 + lane * 8 + q * 4 + j; rw[(i * 2 + q) * 4 + j][0] = *(const f32x4*)(wrt + (size_t)k * 8); rw[(i * 2 + q) * 4 + j][1] = *(const f32x4*)(wrt + (size_t)k * 8 + 4); }
    }
    const int nwv = gridDim.x * 8, gw = blockIdx.x * 8 + wid, rpw = (nrows + nwv - 1) / nwv;
    const int r0 = gw * rpw, r1 = (r0 + rpw) < nrows ? (r0 + rpw) : nrows;
    f32x4 Am[4], Sh[4]; int curb = -1;
#pragma unroll
    for (int i = 0; i < 4; ++i) { Am[i] = (f32x4){0.f, 0.f, 0.f, 0.f}; Sh[i] = Am[i]; }
    f32x4 nraw[4];
#define NORM_LOAD(rr) do { if (SRC16 && (rr) < NTOK) { const bf16_t* xq_ = (const bf16_t*)srcL_ + (size_t)(rr) * D; \
            nraw[0] = __builtin_bit_cast(f32x4, *(const u32x4*)(xq_ + lane * 8)); nraw[1] = __builtin_bit_cast(f32x4, *(const u32x4*)(xq_ + 512 + lane * 8)); } \
        else { const float* xp_ = (rr) < NTOK ? (const float*)srcL_ + (size_t)(rr) * D : srcC + (size_t)((rr) - NTOK) * D; \
            nraw[0] = *(const f32x4*)(xp_ + lane * 8); nraw[1] = *(const f32x4*)(xp_ + lane * 8 + 4); nraw[2] = *(const f32x4*)(xp_ + 512 + lane * 8); nraw[3] = *(const f32x4*)(xp_ + 512 + lane * 8 + 4); } } while (0)
    if (r0 < r1) NORM_LOAD(r0);
    for (int r = r0; r < r1; ++r) {
        f32x4 x[4];
        if (SRC16 && r < NTOK) {
#pragma unroll
            for (int i = 0; i < 2; ++i) { const u32x4 w = __builtin_bit_cast(u32x4, nraw[i]);
                x[2 * i] = (f32x4){bflo(w.x), bfhi(w.x), bflo(w.y), bfhi(w.y)}; x[2 * i + 1] = (f32x4){bflo(w.z), bfhi(w.z), bflo(w.w), bfhi(w.w)}; }
        } else {
#pragma unroll
            for (int i = 0; i < 4; ++i) x[i] = nraw[i];
        }
        const int bidx = r < NTOK ? (r >> 12) : 16;
        if (bidx != curb) {
            curb = bidx; const float* mp = modl + (size_t)bidx * NMOD + shift_idx * D;
#pragma unroll
            for (int i = 0; i < 2; ++i)
#pragma unroll
                for (int q = 0; q < 2; ++q) { const int o = i * 512 + lane * 8 + q * 4;
                    Sh[2 * i + q] = *(const f32x4*)(mp + o); Am[2 * i + q] = *(const f32x4*)(g + o) * (1.0f + *(const f32x4*)(mp + D + o)); }
        }
        if (r + 1 < r1) NORM_LOAD(r + 1);
        float ss = 0.f;
#pragma unroll
        for (int i = 0; i < 4; ++i) ss += x[i][0] * x[i][0] + x[i][1] * x[i][1] + x[i][2] * x[i][2] + x[i][3] * x[i][3];
        ss = wave_sum(ss);
        const float rs = rsqrtf(ss * (1.0f / 1024.0f) + EPS);
        f32x4 h[4];
#pragma unroll
        for (int i = 0; i < 4; ++i) h[i] = (x[i] * rs) * Am[i] + Sh[i];
        if constexpr (OUT8) {
#pragma unroll
            for (int i = 0; i < 2; ++i) { u32x2 w; w.x = pk4_fp8(h[2 * i][0] * F8_ACT, h[2 * i][1] * F8_ACT, h[2 * i][2] * F8_ACT, h[2 * i][3] * F8_ACT);
                w.y = pk4_fp8(h[2 * i + 1][0] * F8_ACT, h[2 * i + 1][1] * F8_ACT, h[2 * i + 1][2] * F8_ACT, h[2 * i + 1][3] * F8_ACT);
                *(u32x2*)((fp8_t*)HX + (size_t)r * D + i * 512 + lane * 8) = w; }
        } else {
#pragma unroll
        for (int i = 0; i < 2; ++i) { u32x4 w; w.x = cvt_pk_bf16(h[2 * i][0], h[2 * i][1]); w.y = cvt_pk_bf16(h[2 * i][2], h[2 * i][3]); w.z = cvt_pk_bf16(h[2 * i + 1][0], h[2 * i + 1][1]); w.w = cvt_pk_bf16(h[2 * i + 1][2], h[2 * i + 1][3]);
            *(u32x4*)(HX + (size_t)r * D + i * 512 + lane * 8) = w; }
        }
        if (ROUTE) {
            float lg[8];
#pragma unroll
            for (int e = 0; e < 8; ++e) lg[e] = 0.f;
#pragma unroll
            for (int i = 0; i < 2; ++i)
#pragma unroll
                for (int q = 0; q < 2; ++q)
#pragma unroll
                    for (int j = 0; j < 4; ++j) { const float hv = h[2 * i + q][j];
                        const f32x4 wa = rw[(i * 2 + q) * 4 + j][0], wb = rw[(i * 2 + q) * 4 + j][1];
                        lg[0] += hv * wa[0]; lg[1] += hv * wa[1]; lg[2] += hv * wa[2]; lg[3] += hv * wa[3]; lg[4] += hv * wb[0]; lg[5] += hv * wb[1]; lg[6] += hv * wb[2]; lg[7] += hv * wb[3]; }
            { const bool b5 = lane & 32, b4 = lane & 16, b3 = lane & 8;
              float k4[4], k2[2], k1;
#pragma unroll
              for (int j = 0; j < 4; ++j) { const float snd = b5 ? lg[j] : lg[4 + j], kp = b5 ? lg[4 + j] : lg[j]; k4[j] = kp + __shfl_xor(snd, 32); }
#pragma unroll
              for (int j = 0; j < 2; ++j) { const float snd = b4 ? k4[j] : k4[2 + j], kp = b4 ? k4[2 + j] : k4[j]; k2[j] = kp + __shfl_xor(snd, 16); }
              { const float snd = b3 ? k2[0] : k2[1], kp = b3 ? k2[1] : k2[0]; k1 = kp + __shfl_xor(snd, 8); }
              k1 += __shfl_xor(k1, 4); k1 += __shfl_xor(k1, 2); k1 += __shfl_xor(k1, 1);
#pragma unroll
              for (int e = 0; e < 8; ++e) lg[e] = __shfl(k1, 8 * e); }
            int e1 = 0; float v1 = lg[0];
#pragma unroll
            for (int e = 1; e < 8; ++e) if (lg[e] > v1) { v1 = lg[e]; e1 = e; }
            int e2 = -1; float v2 = -3.0e38f;
#pragma unroll
            for (int e = 0; e < 8; ++e) if (e != e1 && lg[e] > v2) { v2 = lg[e]; e2 = e; }
            const float g1 = 1.0f / (1.0f + __expf(v2 - v1)), g2 = 1.0f - g1;
            if (lane == 0) { u32x4 w; w.x = (unsigned)e1; w.y = (unsigned)e2; w.z = __float_as_uint(g1); w.w = __float_as_uint(g2); *(u32x4*)(route + (size_t)r * 4) = w;
                atomicAdd((int*)&lh[e1], 1); atomicAdd((int*)&lh[e2], 1); }
        }
    }
#undef NORM_LOAD
    if (ROUTE) { __syncthreads(); if (tid < 8) hist[blockIdx.x * 8 + tid] = lh[tid]; }
}

template <int L, int NBP>
__device__ __forceinline__ void hyena_pass(const bf16_t* __restrict__ UTb, bf16_t* __restrict__ HTb, int c, const float (&cw)[3][3], const float (&cb)[3], float bias,
                                           const LAS float* kf, LAS float* raw, LAS float* vx, LAS float* x0s) {
    const int tid = otid(), e0 = tid * 8, bb = e0 / L, t0 = e0 % L;
    constexpr int RS = L + 8;
#pragma unroll
    for (int j = 0; j < 3; ++j) {
        const u32x4 w = *(const u32x4*)(UTb + ((size_t)bb * UCH + 1024 + j * 512 + c) * L + t0);
        LAS float* rp = raw + (j * NBP + bb) * RS + 4 + t0;
        *(LAS f32x4*)rp = (f32x4){bflo(w.x), bfhi(w.x), bflo(w.y), bfhi(w.y)};
        *(LAS f32x4*)(rp + 4) = (f32x4){bflo(w.z), bfhi(w.z), bflo(w.w), bfhi(w.w)};
        if (t0 == 0) rp[-1] = 0.f;
        if (t0 == L - 8) rp[8] = 0.f;
    }
    __syncthreads();
    {
        float z[3][8];
#pragma unroll
        for (int j = 0; j < 3; ++j) { const LAS float* rp = raw + (j * NBP + bb) * RS + 4 + t0;
            float r[10];
#pragma unroll
            for (int i = 0; i < 10; ++i) r[i] = rp[i - 1];
#pragma unroll
            for (int i = 0; i < 8; ++i) z[j][i] = r[i] * cw[j][0] + r[i + 1] * cw[j][1] + r[i + 2] * cw[j][2] + cb[j]; }
#pragma unroll
        for (int i = 0; i < 8; ++i) { vx[bb * L + t0 + i] = z[0][i] * z[1][i]; x0s[bb * L + t0 + i] = z[2][i]; }
    }
    __syncthreads();
    float acc[8];
#pragma unroll
    for (int i = 0; i < 8; ++i) acc[i] = 0.f;
    for (int s0 = 0; s0 < L; s0 += 8) {
        const f32x4 va = *(const LAS f32x4*)(vx + bb * L + s0), vb = *(const LAS f32x4*)(vx + bb * L + s0 + 4);
        const float v[8] = {va[0], va[1], va[2], va[3], vb[0], vb[1], vb[2], vb[3]};
        const LAS float* kp = kf + (L + t0 - s0 - 8);
        float w[16];
#pragma unroll
        for (int q4 = 0; q4 < 4; ++q4) { const f32x4 t = *(const LAS f32x4*)(kp + q4 * 4); w[q4 * 4] = t[0]; w[q4 * 4 + 1] = t[1]; w[q4 * 4 + 2] = t[2]; w[q4 * 4 + 3] = t[3]; }
#pragma unroll
        for (int j = 0; j < 8; ++j)
#pragma unroll
            for (int i = 0; i < 8; ++i) acc[i] += w[8 + i - j] * v[j];
    }
    {
        float o[8];
#pragma unroll
        for (int i = 0; i < 8; ++i) o[i] = x0s[bb * L + t0 + i] * (acc[i] + bias * vx[bb * L + t0 + i]);
        u32x4 w; w.x = cvt_pk_bf16(o[0], o[1]); w.y = cvt_pk_bf16(o[2], o[3]); w.z = cvt_pk_bf16(o[4], o[5]); w.w = cvt_pk_bf16(o[6], o[7]);
        *(u32x4*)(HTb + ((size_t)bb * 512 + c) * L + t0) = w;
    }
    __syncthreads();
}

__device__ __forceinline__ unsigned f2_cs_byte(int r, int c) { return (unsigned)(r * 128 + ((((c >> 3) ^ ((r >> 1) & 7))) << 4) + (c & 7) * 2); }
__device__ __forceinline__ void f2_tr8(u32x2 (&o)[8], unsigned a0, unsigned a1, unsigned a2, unsigned a3, unsigned a4, unsigned a5, unsigned a6, unsigned a7) {
    asm volatile("ds_read_b64_tr_b16 %0, %8\n\tds_read_b64_tr_b16 %1, %9\n\tds_read_b64_tr_b16 %2, %10\n\tds_read_b64_tr_b16 %3, %11\n\t"
                 "ds_read_b64_tr_b16 %4, %12\n\tds_read_b64_tr_b16 %5, %13\n\tds_read_b64_tr_b16 %6, %14\n\tds_read_b64_tr_b16 %7, %15\n\ts_waitcnt lgkmcnt(0)"
                 : "=&v"(o[0]), "=&v"(o[1]), "=&v"(o[2]), "=&v"(o[3]), "=&v"(o[4]), "=&v"(o[5]), "=&v"(o[6]), "=&v"(o[7])
                 : "v"(a0), "v"(a1), "v"(a2), "v"(a3), "v"(a4), "v"(a5), "v"(a6), "v"(a7) : "memory");
}
__device__ __forceinline__ bf16x8 f2_frag(const u32x2& lo, const u32x2& hi) { return __builtin_bit_cast(bf16x8, (u32x4){lo.x, lo.y, hi.x, hi.y}); }
__device__ __forceinline__ bf16x8 f2_neg(const bf16x8& v) { u32x4 u = __builtin_bit_cast(u32x4, v); u.x ^= 0x80008000u; u.y ^= 0x80008000u; u.z ^= 0x80008000u; u.w ^= 0x80008000u; return __builtin_bit_cast(bf16x8, u); }

__device__ __forceinline__ void fourier2_phase(const bf16_t* __restrict__ UT, bf16_t* __restrict__ AT, const float* __restrict__ TW, LAS unsigned char* lds) {
    const int tid = otid(), lane = tid & 63, w = __builtin_amdgcn_readfirstlane(tid >> 6), r = lane & 31, h = lane >> 5;
    __syncthreads();
    for (int i = tid; i < 4096; i += 512) { const int rr = i >> 6, cc = i & 63; const float a = (float)((rr * cc) & 63) / 32.0f;
        *(LAS bf16_t*)(lds + f2_cs_byte(rr, cc)) = f2bf(cospif(a)); *(LAS bf16_t*)(lds + 8192 + f2_cs_byte(rr, cc)) = f2bf(sinpif(a)); }
    __syncthreads();
    LAS unsigned char* xr = lds + 16384 + w * 16384;
    const unsigned xb = (unsigned)(unsigned long)xr;
    const int q = (lane & 15) >> 2, pp = lane & 3, blk = (lane >> 4) & 1, qb = (q >> 1) & 1;
    const unsigned L0 = (unsigned)((8 * h + q) * 128 + (16 * blk + 4 * pp) * 2);
    const unsigned tb0 = xb + L0 + qb * 64, tb1 = xb + L0 + (1 - qb) * 64;
    const int nwv = gridDim.x * 8;
    for (int it = blockIdx.x * 8 + w; it < NB * 512; it += nwv) {
        const int b = it >> 9, m = it & 511;
        { const char* src = (const char*)(UT + ((size_t)b * UCH + 2 * m) * SEQ);
#pragma unroll
          for (int i = 0; i < 16; ++i) { const int row = (i & 7) * 8 + (lane >> 3), s2 = (lane & 7) ^ (4 * ((row >> 1) & 1));
              __builtin_amdgcn_global_load_lds((const unsigned*)(src + (i >> 3) * 8192 + (row * 64 + s2 * 8) * 2), (LAS unsigned*)(xr + i * 1024), 16, 0, 2); } }
        asm volatile("s_waitcnt vmcnt(0)" ::: "memory");
        f32x16 Yr[2][2], Yi[2][2];
#pragma unroll
        for (int a = 0; a < 2; ++a)
#pragma unroll
            for (int c = 0; c < 2; ++c)
#pragma unroll
                for (int e = 0; e < 16; ++e) { Yr[a][c][e] = 0.f; Yi[a][c][e] = 0.f; }
#pragma unroll
        for (int ks = 0; ks < 4; ++ks) {
            bf16x8 Cf[2], Sf[2];
#pragma unroll
            for (int kt = 0; kt < 2; ++kt) { const unsigned o = f2_cs_byte(32 * kt + r, 16 * ks + 8 * h); Cf[kt] = *(const LAS bf16x8*)(lds + o); Sf[kt] = *(const LAS bf16x8*)(lds + 8192 + o); }
            u32x2 t[8]; const unsigned ko = ks * 2048;
            f2_tr8(t, tb0 + ko, tb0 + ko + 512, tb1 + ko, tb1 + ko + 512, tb0 + ko + 8192, tb0 + ko + 8192 + 512, tb1 + ko + 8192, tb1 + ko + 8192 + 512);
            const bf16x8 Pf[2] = {f2_frag(t[0], t[1]), f2_frag(t[2], t[3])}, Qf[2] = {f2_frag(t[4], t[5]), f2_frag(t[6], t[7])};
            const bf16x8 Qn[2] = {f2_neg(Qf[0]), f2_neg(Qf[1])};
#pragma unroll
            for (int kt = 0; kt < 2; ++kt)
#pragma unroll
                for (int nt = 0; nt < 2; ++nt) {
                    Yr[kt][nt] = __builtin_amdgcn_mfma_f32_32x32x16_bf16(Cf[kt], Pf[nt], Yr[kt][nt], 0, 0, 0);
                    Yr[kt][nt] = __builtin_amdgcn_mfma_f32_32x32x16_bf16(Sf[kt], Qn[nt], Yr[kt][nt], 0, 0, 0);
                    Yi[kt][nt] = __builtin_amdgcn_mfma_f32_32x32x16_bf16(Sf[kt], Pf[nt], Yi[kt][nt], 0, 0, 0);
                    Yi[kt][nt] = __builtin_amdgcn_mfma_f32_32x32x16_bf16(Cf[kt], Qf[nt], Yi[kt][nt], 0, 0, 0);
                }
        }
#pragma unroll
        for (int nt = 0; nt < 2; ++nt) { const int l2 = 32 * nt + r;
#pragma unroll
            for (int kt = 0; kt < 2; ++kt)
#pragma unroll
                for (int eg = 0; eg < 4; ++eg) { const int k1 = 32 * kt + 8 * eg + 4 * h;
                    const f32x4 tc = *(const f32x4*)(TW + l2 * 64 + k1), ts = *(const f32x4*)(TW + 4096 + l2 * 64 + k1);
                    float yr[4], yi[4];
#pragma unroll
                    for (int j = 0; j < 4; ++j) { const float a = Yr[kt][nt][4 * eg + j], bneg = Yi[kt][nt][4 * eg + j];
                        yr[j] = a * tc[j] - bneg * ts[j]; yi[j] = -(a * ts[j] + bneg * tc[j]); }
                    const unsigned o = (unsigned)(l2 * 128 + ((kt ^ ((l2 >> 1) & 1)) * 64) + (8 * eg + 4 * h) * 2);
                    u32x2 wr_; wr_.x = cvt_pk_bf16(yr[0], yr[1]); wr_.y = cvt_pk_bf16(yr[2], yr[3]); *(LAS u32x2*)(xr + o) = wr_;
                    u32x2 wi_; wi_.x = cvt_pk_bf16(yi[0], yi[1]); wi_.y = cvt_pk_bf16(yi[2], yi[3]); *(LAS u32x2*)(xr + 8192 + o) = wi_; } }
        asm volatile("s_waitcnt lgkmcnt(0)" ::: "memory");
        f32x16 O[2][2];
#pragma unroll
        for (int a = 0; a < 2; ++a)
#pragma unroll
            for (int c = 0; c < 2; ++c)
#pragma unroll
                for (int e = 0; e < 16; ++e) O[a][c][e] = 0.f;
#pragma unroll 1
        for (int ks = 0; ks < 4; ++ks) {
            bf16x8 Cf[2], Sf[2];
#pragma unroll
            for (int kt = 0; kt < 2; ++kt) { const unsigned o = f2_cs_byte(32 * kt + r, 16 * ks + 8 * h); Cf[kt] = *(const LAS bf16x8*)(lds + o); Sf[kt] = *(const LAS bf16x8*)(lds + 8192 + o); }
            u32x2 t[8]; const unsigned ko = ks * 2048;
            f2_tr8(t, tb0 + ko, tb0 + ko + 512, tb1 + ko, tb1 + ko + 512, tb0 + ko + 8192, tb0 + ko + 8192 + 512, tb1 + ko + 8192, tb1 + ko + 8192 + 512);
            const bf16x8 Rf[2] = {f2_frag(t[0], t[1]), f2_frag(t[2], t[3])}, If[2] = {f2_frag(t[4], t[5]), f2_frag(t[6], t[7])};
#pragma unroll
            for (int kt = 0; kt < 2; ++kt)
#pragma unroll
                for (int nt = 0; nt < 2; ++nt) {
                    O[kt][nt] = __builtin_amdgcn_mfma_f32_32x32x16_bf16(Cf[kt], Rf[nt], O[kt][nt], 0, 0, 0);
                    O[kt][nt] = __builtin_amdgcn_mfma_f32_32x32x16_bf16(Sf[kt], If[nt], O[kt][nt], 0, 0, 0);
                }
        }
        { const float sc = 0.001381067932004974f;
#pragma unroll
          for (int kt = 0; kt < 2; ++kt)
#pragma unroll
              for (int nt = 0; nt < 2; ++nt)
#pragma unroll
                  for (int e = 0; e < 16; ++e) { const int k2 = 32 * kt + (e & 3) + 8 * (e >> 2) + 4 * h, k1 = 32 * nt + r;
                      *(LAS bf16_t*)(xr + (64 * k2 + k1) * 2) = f2bf(O[kt][nt][e] * sc); }
          asm volatile("s_waitcnt lgkmcnt(0)" ::: "memory");
          bf16_t* dst = AT + ((size_t)b * 512 + m) * SEQ;
#pragma unroll
          for (int i = 0; i < 8; ++i) *(u32x4*)(dst + (i * 64 + lane) * 8) = *(const LAS u32x4*)(xr + (i * 64 + lane) * 16);
          asm volatile("s_waitcnt lgkmcnt(0)" ::: "memory"); }
    }
    __syncthreads();
}

__device__ __forceinline__ void hyena_prep_phase(const bf16_t* __restrict__ UT, const bf16_t* __restrict__ UTc, bf16_t* __restrict__ VXT, bf16_t* __restrict__ X0T, bf16_t* __restrict__ HTc,
                                                 const float* __restrict__ KFc, const float* __restrict__ conv_w, const float* __restrict__ conv_b, const float* __restrict__ hbias,
                                                 LAS unsigned char* lds) {
    LAS float* kf = (LAS float*)lds;
    LAS float* raw = kf + 8192;
    LAS float* vx = raw + 3 * 4224;
    LAS float* x0s = vx + 4096;
    const int tid = otid(), lane = tid & 63;
    for (int cp = blockIdx.x; cp < 256; cp += gridDim.x)
        for (int cc = 0; cc < 2; ++cc) {
            const int c = cp * 2 + cc;
            float cw[3][3], cb[3];
#pragma unroll
            for (int j = 0; j < 3; ++j) { cb[j] = conv_b[j * 512 + c];
#pragma unroll
                for (int tp = 0; tp < 3; ++tp) cw[j][tp] = conv_w[tp * 1536 + j * 512 + c]; }
            const float bias = hbias[c];
            const int t0 = tid * 8;
#pragma unroll 2
            for (int b = 0; b < NB; ++b) {
                const bf16_t* UTb = UT + (size_t)b * UCH * SEQ;
                float z[3][8];
#pragma unroll
                for (int j = 0; j < 3; ++j) {
                    const bf16_t* rowp = UTb + ((size_t)1024 + j * 512 + c) * SEQ;
                    const u32x4 w = __builtin_nontemporal_load((const u32x4*)(rowp + t0));
                    float r[10];
                    r[1] = bflo(w.x); r[2] = bfhi(w.x); r[3] = bflo(w.y); r[4] = bfhi(w.y); r[5] = bflo(w.z); r[6] = bfhi(w.z); r[7] = bflo(w.w); r[8] = bfhi(w.w);
                    const int te = lane == 63 ? t0 + 8 : t0 - 8 * lane - 1;
                    const float ev_ = bf2f(rowp[te < 0 ? 0 : (te < SEQ ? te : SEQ - 1)]), ev = (te >= 0 && te < SEQ) ? ev_ : 0.f;
                    const float pl_ = bfhi((unsigned)__shfl_up((int)w.w, 1)), nl_ = bflo((unsigned)__shfl_down((int)w.x, 1));
                    r[0] = lane == 0 ? ev : pl_; r[9] = lane == 63 ? ev : nl_;
#pragma unroll
                    for (int i = 0; i < 8; ++i) z[j][i] = r[i] * cw[j][0] + r[i + 1] * cw[j][1] + r[i + 2] * cw[j][2] + cb[j];
                }
                float pv[8];
#pragma unroll
                for (int i = 0; i < 8; ++i) pv[i] = z[0][i] * z[1][i];
                u32x4 v8; v8.x = cvt_pk_bf16(pv[0], pv[1]); v8.y = cvt_pk_bf16(pv[2], pv[3]); v8.z = cvt_pk_bf16(pv[4], pv[5]); v8.w = cvt_pk_bf16(pv[6], pv[7]);
                { u32x4 x8; x8.x = cvt_pk_bf16(z[2][0], z[2][1]); x8.y = cvt_pk_bf16(z[2][2], z[2][3]); x8.z = cvt_pk_bf16(z[2][4], z[2][5]); x8.w = cvt_pk_bf16(z[2][6], z[2][7]);
                  const size_t o = ((size_t)c * NB + b) * SEQ + t0;
                  *(u32x4*)(VXT + o) = v8; *(u32x4*)(X0T + o) = x8; }
            }
            __syncthreads();
            if (tid < 128) *(LAS f32x4*)(kf + tid * 4) = *(const f32x4*)(KFc + (size_t)c * 512 + tid * 4);
            __syncthreads();
            hyena_pass<LCTX, 16>(UTc, HTc, c, cw, cb, bias, kf, raw, vx, x0s);
        }
}

__device__ __forceinline__ void toep_phase(const bf16_t* __restrict__ RC, const bf16_t* __restrict__ VXT, const bf16_t* __restrict__ X0T, const char* __restrict__ zero16, const float* __restrict__ hbias, bf16_t* __restrict__ HT,
                                           LAS unsigned char* lds) {
    int tid_ = threadIdx.x; asm volatile("" : "+v"(tid_));
    const int tid = tid_, lane = tid & 63, w = __builtin_amdgcn_readfirstlane(tid >> 6), r = lane & 31, h = lane >> 5;
    constexpr int RING = 65536, NST = 272, NSL = 64;
    const int cbase = (4096 - 512 * w + 8 * (h - r) - 256) * 2;
    const int offL = (h ? (lane - 32) : (lane + 32)) * 16 + 8;
    for (int cp = blockIdx.x; cp < 256; cp += gridDim.x)
        for (int cc = 0; cc < 2; ++cc) {
            const int c = cp * 2 + cc;
            const char* rc = (const char*)(RC + (size_t)c * 4 * 8192);
            const char* vxc = (const char*)(VXT + (size_t)c * NB * SEQ) + ((lane & 15) * SEQ + 256 * ((lane >> 4) & 1) + 8 * h - 256) * 2;
#define TOEP_SRC(st_) ({ const int s_ = 16 * (st_) - 256 + 256 * ((lane >> 4) & 1) + 8 * h; (s_ >= 0 && s_ < SEQ) ? vxc + 32 * (st_) : zero16; })
            __syncthreads();
#pragma unroll
            for (int i = 0; i < 8; ++i)
                __builtin_amdgcn_global_load_lds((const unsigned*)(rc + (w * 8 + i) * 1024 + lane * 16), (LAS unsigned*)(lds + (w * 8 + i) * 1024), 16, 0, 0);
            __builtin_amdgcn_global_load_lds((const unsigned*)TOEP_SRC(w), (LAS unsigned*)(lds + RING + w * 1024), 16, 0, 0);
            __builtin_amdgcn_global_load_lds((const unsigned*)TOEP_SRC(8 + w), (LAS unsigned*)(lds + RING + (8 + w) * 1024), 16, 0, 0);
            if (w == 0) { *(LAS u32x4*)(lds + RING + 63 * 1024 + lane * 16) = (u32x4){0u, 0u, 0u, 0u}; asm volatile("s_waitcnt lgkmcnt(0)" ::: "memory"); }
            f32x16 acc[8];
#pragma unroll
            for (int j = 0; j < 8; ++j)
#pragma unroll
                for (int e = 0; e < 16; ++e) acc[j][e] = 0.f;
            for (int k = 0; k < NST / 8; ++k) {
                { int stn = 8 * (k + 2) + w; stn = stn < NST ? stn : NST - 1;
                  __builtin_amdgcn_global_load_lds((const unsigned*)TOEP_SRC(stn), (LAS unsigned*)(lds + RING + ((8 * (k + 2) + w) & (NSL - 1)) * 1024), 16, 0, 0); }
                asm volatile("s_waitcnt vmcnt(2)" ::: "memory");
                __builtin_amdgcn_s_barrier();
                asm volatile("" ::: "memory");
                const LAS unsigned char* ab = lds + cbase + 256 * k;
                const LAS unsigned char* rk = lds + RING + ((8 * k) & (NSL - 1)) * 1024;
                const LAS unsigned char* r0 = lds + RING + ((8 * k - 1 + h) & (NSL - 1)) * 1024 + offL;
#pragma unroll
                for (int i = 0; i < 8; ++i) {
                    const u32x4 bq = *(const LAS u32x4*)(rk + i * 1024 + lane * 16);
                    const u32x2 lo = i == 0 ? *(const LAS u32x2*)r0 : *(const LAS u32x2*)(rk + (i - 1) * 1024 + h * 1024 + offL);
                    const bf16x8 bf = __builtin_bit_cast(bf16x8, bq), b3 = __builtin_bit_cast(bf16x8, (u32x4){lo.x, lo.y, bq.x, bq.y});
#pragma unroll
                    for (int m = 0; m < 4; ++m) {
                        const bf16x8 af = *(const LAS bf16x8*)(ab + m * 16384 + 32 * i);
                        acc[4 + m] = __builtin_amdgcn_mfma_f32_32x32x16_bf16(af, bf, acc[4 + m], 0, 0, 0);
                        acc[m] = __builtin_amdgcn_mfma_f32_32x32x16_bf16(af, b3, acc[m], 0, 0, 0);
                    }
                }
            }
            {
                const LAS unsigned char* ab = lds + cbase + 256 * (NST / 8);
                u32x2 lo = (u32x2){0u, 0u};
                if (h == 0) lo = *(const LAS u32x2*)(lds + RING + ((NST - 1) & (NSL - 1)) * 1024 + offL);
                const bf16x8 b3 = __builtin_bit_cast(bf16x8, (u32x4){lo.x, lo.y, 0u, 0u});
#pragma unroll
                for (int m = 0; m < 4; ++m) { const bf16x8 af = *(const LAS bf16x8*)(ab + m * 16384); acc[m] = __builtin_amdgcn_mfma_f32_32x32x16_bf16(af, b3, acc[m], 0, 0, 0); }
            }
            asm volatile("s_waitcnt vmcnt(0)" ::: "memory");
            __builtin_amdgcn_s_barrier();
            asm volatile("" ::: "memory");
            LAS unsigned char* wt = lds + w * 16640;
            { const int col = lane & 31, b = col & 15, a = col >> 4;
#pragma unroll
              for (int u = 0; u < 2; ++u)
#pragma unroll
                  for (int mp = 0; mp < 2; ++mp)
#pragma unroll
                      for (int e = 0; e < 16; ++e) { const int row = (e & 3) + 8 * (e >> 2) + 4 * h, tl = 4 * u + 2 * mp + 8 * row + 256 * a;
                          *(LAS unsigned*)(wt + (b * 520 + tl) * 2) = cvt_pk_bf16(acc[4 * u + 2 * mp][e], acc[4 * u + 2 * mp + 1][e]); } }
            asm volatile("s_waitcnt lgkmcnt(0)" ::: "memory");
            const float bias = hbias[c];
#pragma unroll 4
            for (int b = 0; b < 16; ++b) {
                const u32x4 y8 = *(const LAS u32x4*)(wt + (b * 520 + 8 * lane) * 2);
                const size_t go = ((size_t)b * 512 + c) * SEQ + 512 * w + 8 * lane, gi = ((size_t)c * NB + b) * SEQ + 512 * w + 8 * lane;
                const u32x4 g0 = *(const u32x4*)(X0T + gi), g1 = *(const u32x4*)(VXT + gi);
                const float x0v[8] = {bflo(g0.x), bfhi(g0.x), bflo(g0.y), bfhi(g0.y), bflo(g0.z), bfhi(g0.z), bflo(g0.w), bfhi(g0.w)};
                const float vxv[8] = {bflo(g1.x), bfhi(g1.x), bflo(g1.y), bfhi(g1.y), bflo(g1.z), bfhi(g1.z), bflo(g1.w), bfhi(g1.w)};
                const float yy[8] = {bflo(y8.x), bfhi(y8.x), bflo(y8.y), bfhi(y8.y), bflo(y8.z), bfhi(y8.z), bflo(y8.w), bfhi(y8.w)};
                float o[8];
#pragma unroll
                for (int i = 0; i < 8; ++i) o[i] = x0v[i] * (yy[i] + bias * vxv[i]);
                u32x4 ww; ww.x = cvt_pk_bf16(o[0], o[1]); ww.y = cvt_pk_bf16(o[2], o[3]); ww.z = cvt_pk_bf16(o[4], o[5]); ww.w = cvt_pk_bf16(o[6], o[7]);
                *(u32x4*)(HT + go) = ww;
            }
#undef TOEP_SRC
        }
    __syncthreads();
}

__device__ __forceinline__ void mix_transpose_phase(const bf16_t* __restrict__ AT, const bf16_t* __restrict__ HT, const bf16_t* __restrict__ HTc, bf16_t* __restrict__ MIX, LAS unsigned char* lds) {
    LAS bf16_t* T = (LAS bf16_t*)lds;
    const int tid = otid();
    for (int t = blockIdx.x; t < 16896; t += gridDim.x) {
        const bf16_t* src; int sld, row0, cb, coff;
        if (t < 16384) { const int t1 = t & 8191, b = t1 >> 9, tb = t1 & 63; cb = (t1 >> 6) & 7; src = (t < 8192 ? AT : HT) + ((size_t)(b * 512 + cb * 64)) * SEQ + tb * 64; sld = SEQ; row0 = b * SEQ + tb * 64; coff = t < 8192 ? 0 : 512; }
        else { const int t2 = t - 16384, b = t2 >> 5, tb = t2 & 3; cb = (t2 >> 2) & 7; src = HTc + ((size_t)(b * 512 + cb * 64)) * LCTX + tb * 64; sld = LCTX; row0 = NTOK + b * LCTX + tb * 64; coff = 512; }
        { const int r = tid >> 3, p = tid & 7; *(LAS u32x4*)(T + r * 72 + p * 8) = *(const u32x4*)(src + (size_t)r * sld + p * 8); }
        __syncthreads();
        { const int tt = tid >> 3, c8 = (tid & 7) * 8; unsigned w[4];
#pragma unroll
          for (int j = 0; j < 4; ++j) w[j] = (unsigned)T[(c8 + 2 * j) * 72 + tt] | ((unsigned)T[(c8 + 2 * j + 1) * 72 + tt] << 16);
          *(u32x4*)(MIX + (size_t)(row0 + tt) * D + coff + cb * 64 + c8) = (u32x4){w[0], w[1], w[2], w[3]}; }
        __syncthreads();
    }
}

__device__ __forceinline__ void attn_issue(LAS unsigned char* lds, int gc, const bf16_t* __restrict__ Kb, const bf16_t* __restrict__ VT, int item, int ci, int w, int lane) {
    LAS unsigned char* sl = lds + (gc & 3) * 32768;
    const int b = item >> 7, hkv = (item >> 5) & 3, qb = item & 31;
    const bool win = ci < 3;
    int kp0 = qb * 128 - 128 + 128 * ci; kp0 = kp0 < 0 ? 0 : (kp0 > SEQ - 128 ? SEQ - 128 : kp0);
    const char* kub = (const char*)Kb + ((size_t)(win ? b * SEQ + kp0 : NTOK + b * LCTX + 128 * (ci - 3)) * 256 + hkv * 64) * 2;
    const char* vub = (const char*)VT + (win ? ((size_t)(b * 256 + hkv * 64) * SEQ + kp0) * 2 : ((size_t)NB * 256 * SEQ + (size_t)(b * 256 + hkv * 64) * LCTX + 128 * (ci - 3)) * 2);
    const unsigned vrow = win ? SEQ * 2u : LCTX * 2u;
#pragma unroll
    for (int i = 0; i < 2; ++i) { const int q = 2 * w + i, key = 8 * q + (lane >> 3), ds = (lane & 7) ^ ((key >> 1) & 7);
        const unsigned lo = (unsigned)(key * 256 + ds * 8) * 2u;
        __builtin_amdgcn_global_load_lds((const unsigned*)(kub + lo), (LAS unsigned*)(sl + q * 1024), 16, 0, 0); }
#pragma unroll
    for (int i = 0; i < 2; ++i) { const int q = 2 * w + i, d = 4 * q + (lane >> 4), ss = (lane & 15) ^ (d & 15);
        const unsigned lo = (unsigned)d * vrow + (unsigned)ss * 16u;
        __builtin_amdgcn_global_load_lds((const unsigned*)(vub + lo), (LAS unsigned*)(sl + 16384 + q * 1024), 16, 0, 0); }
}

template <bool FAST>
__device__ __forceinline__ void attn_softmax(f32x16& S, f32x16 (&O)[2][2], const int qt, float& mrun, float& lrun, bf16x8 (&P)[2], const bool need_mask, const int qp, const int kp0, const int h) {
    if (need_mask) {
#pragma unroll
        for (int e = 0; e < 16; ++e) { const int kp = kp0 + (e & 3) + 8 * (e >> 2) + 4 * h; const bool ok = (unsigned)(qp - kp + 128) <= 256u; S[e] = ok ? S[e] : -1.0e30f; }
    }
    if constexpr (FAST) {
#pragma unroll
        for (int e = 0; e < 16; ++e) S[e] = __builtin_amdgcn_exp2f(S[e] - mrun);
        float ps = 0.f;
#pragma unroll
        for (int e = 0; e < 16; ++e) ps += S[e];
        lrun += ps;
#pragma unroll
        for (int s2 = 0; s2 < 2; ++s2) { u32x4 pk;
            pk.x = cvt_pk_bf16(S[8 * s2 + 0], S[8 * s2 + 1]); pk.y = cvt_pk_bf16(S[8 * s2 + 2], S[8 * s2 + 3]);
            pk.z = cvt_pk_bf16(S[8 * s2 + 4], S[8 * s2 + 5]); pk.w = cvt_pk_bf16(S[8 * s2 + 6], S[8 * s2 + 7]);
            P[s2] = __builtin_bit_cast(bf16x8, pk); }
        return;
    }
    float mx = S[0];
#pragma unroll
    for (int e = 1; e < 16; ++e) mx = fmaxf(mx, S[e]);
    mx = fmaxf(mx, __shfl_xor(mx, 32));
    const float mn = mx > mrun + 6.0f ? mx : mrun;
    if (__any(mn != mrun)) {
        const float alpha = __builtin_amdgcn_exp2f(mrun - mn);
        lrun *= alpha;
#pragma unroll
        for (int dt = 0; dt < 2; ++dt)
#pragma unroll
            for (int e = 0; e < 16; ++e) O[dt][qt][e] *= alpha;
        mrun = mn;
    }
    float ps = 0.f;
#pragma unroll
    for (int e = 0; e < 16; ++e) { S[e] = __builtin_amdgcn_exp2f(S[e] - mn); ps += S[e]; }
    lrun += ps;
#pragma unroll
    for (int s2 = 0; s2 < 2; ++s2) { u32x4 pk;
        pk.x = cvt_pk_bf16(S[8 * s2 + 0], S[8 * s2 + 1]); pk.y = cvt_pk_bf16(S[8 * s2 + 2], S[8 * s2 + 3]);
        pk.z = cvt_pk_bf16(S[8 * s2 + 4], S[8 * s2 + 5]); pk.w = cvt_pk_bf16(S[8 * s2 + 6], S[8 * s2 + 7]);
        P[s2] = __builtin_bit_cast(bf16x8, pk); }
}

template <bool FAST>
__device__ __forceinline__ void attn_chunk(const bool WIN, const int ktlo, const int kthi, const LAS unsigned char* sl, const bf16x8 (&Qf)[2][4], f32x16 (&O)[2][2], float (&mrun)[2], float (&lrun)[2], int kpc, int q0w, int lane) {
    const int r = lane & 31, h = lane >> 5;
#pragma unroll 1
    for (int kt = ktlo; kt < kthi; ++kt) {
        const int kp0 = kpc + 32 * kt;
        f32x16 S0, S1;
        { bf16x8 kf[4];
          const int key = 32 * kt + r, sw = (key >> 1) & 7;
#pragma unroll
          for (int ks = 0; ks < 4; ++ks) kf[ks] = *(const LAS bf16x8*)(sl + key * 128 + (((2 * ks + h) ^ sw) << 4));
#pragma unroll
          for (int e = 0; e < 16; ++e) { S0[e] = 0.f; S1[e] = 0.f; }
#pragma unroll
          for (int ks = 0; ks < 4; ++ks) S0 = __builtin_amdgcn_mfma_f32_32x32x16_bf16(kf[ks], Qf[0][ks], S0, 0, 0, 0);
#pragma unroll
          for (int ks = 0; ks < 4; ++ks) S1 = __builtin_amdgcn_mfma_f32_32x32x16_bf16(kf[ks], Qf[1][ks], S1, 0, 0, 0); }
        bf16x8 vf[2][2];
#pragma unroll
        for (int dt = 0; dt < 2; ++dt)
#pragma unroll
            for (int s2 = 0; s2 < 2; ++s2) { const int d = 32 * dt + r; vf[dt][s2] = *(const LAS bf16x8*)(sl + 16384 + d * 256 + (((4 * kt + 2 * s2 + h) ^ (d & 15)) << 4)); }
        __builtin_amdgcn_sched_barrier(0);
        const int dq0 = kp0 - q0w, dq1 = kp0 - (q0w + 32);
        bf16x8 P0[2], P1[2];
        attn_softmax<FAST>(S0, O, 0, mrun[0], lrun[0], P0, WIN && (dq0 < -96 || dq0 > 96), q0w + r, kp0, h);
#pragma unroll
        for (int dt = 0; dt < 2; ++dt)
#pragma unroll
            for (int s2 = 0; s2 < 2; ++s2) O[dt][0] = __builtin_amdgcn_mfma_f32_32x32x16_bf16(vf[dt][s2], P0[s2], O[dt][0], 0, 0, 0);
        __builtin_amdgcn_sched_barrier(0);
        attn_softmax<FAST>(S1, O, 1, mrun[1], lrun[1], P1, WIN && (dq1 < -96 || dq1 > 96), q0w + 32 + r, kp0, h);
#pragma unroll
        for (int dt = 0; dt < 2; ++dt)
#pragma unroll
            for (int s2 = 0; s2 < 2; ++s2) O[dt][1] = __builtin_amdgcn_mfma_f32_32x32x16_bf16(vf[dt][s2], P1[s2], O[dt][1], 0, 0, 0);
        __builtin_amdgcn_sched_barrier(0);
    }
}

template <bool FAST>
__device__ __forceinline__ void attn_items(const bf16_t* __restrict__ Q, const bf16_t* __restrict__ Kb, const bf16_t* __restrict__ VT, bf16_t* __restrict__ AO, const float* __restrict__ sink, LAS unsigned char* lds) {
    int tid_ = threadIdx.x; asm volatile("" : "+v"(tid_));
    const int tid = tid_, lane = tid & 63, w = __builtin_amdgcn_readfirstlane(tid >> 6), r = lane & 31, h = lane >> 5;
    const int G = gridDim.x;
    int nitems = 0; for (int it = blockIdx.x; it < 2048; it += G) ++nitems;
    const int nch = nitems * 5;
    __syncthreads();
    if (nch > 0) { attn_issue(lds, 0, Kb, VT, blockIdx.x, 0, w, lane); attn_issue(lds, 1, Kb, VT, blockIdx.x, 1, w, lane); }
    int gc = 0;
    const float sk0 = sink[(w >> 1)] * 1.4426950408889634f, sk1 = sink[4 + (w >> 1)] * 1.4426950408889634f, sk2 = sink[8 + (w >> 1)] * 1.4426950408889634f, sk3 = sink[12 + (w >> 1)] * 1.4426950408889634f;
#define ATTN_QLOAD(dst, it_) do { const int b_ = (it_) >> 7, hkv_ = ((it_) >> 5) & 3, qb_ = (it_) & 31, head_ = hkv_ * 4 + (w >> 1), q0_ = qb_ * 128 + (w & 1) * 64; \
        _Pragma("unroll") for (int qt = 0; qt < 2; ++qt) _Pragma("unroll") for (int ks = 0; ks < 4; ++ks) \
            dst[qt][ks] = *(const bf16x8*)((const char*)Q + ((size_t)(b_ * SEQ + q0_) * D + head_ * 64) * 2 + (unsigned)((32 * qt + r) * D + 16 * ks + 8 * h) * 2u); } while (0)
    bf16x8 Qn[2][4];
    if (nch > 0) ATTN_QLOAD(Qn, (int)blockIdx.x);
    for (int item = blockIdx.x; item < 2048; item += G) {
        const int b = item >> 7, hkv = (item >> 5) & 3, qb = item & 31, head = hkv * 4 + (w >> 1), q0w = qb * 128 + (w & 1) * 64;
        bf16x8 Qf[2][4];
#pragma unroll
        for (int qt = 0; qt < 2; ++qt)
#pragma unroll
            for (int ks = 0; ks < 4; ++ks) Qf[qt][ks] = Qn[qt][ks];
        f32x16 O[2][2];
#pragma unroll
        for (int dt = 0; dt < 2; ++dt)
#pragma unroll
            for (int qt = 0; qt < 2; ++qt)
#pragma unroll
                for (int e = 0; e < 16; ++e) O[dt][qt][e] = 0.f;
        const float sk = hkv == 0 ? sk0 : (hkv == 1 ? sk1 : (hkv == 2 ? sk2 : sk3));
        const float l0 = h == 0 ? 1.0f : 0.0f;
        float mrun[2] = {sk, sk}, lrun[2] = {l0, l0};
#pragma unroll 1
        for (int ci = 0; ci < 5; ++ci, ++gc) {
            { int g2 = gc + 2, it2 = item, c2 = ci + 2;
              if (c2 >= 5) { c2 -= 5; it2 += G; }
              if (g2 >= nch) { it2 = item; c2 = 0; }
              attn_issue(lds, g2, Kb, VT, it2, c2, w, lane); }
            asm volatile("s_waitcnt vmcnt(8)" ::: "memory");
            __builtin_amdgcn_s_barrier();
            asm volatile("" ::: "memory");
            const LAS unsigned char* sl = lds + (gc & 3) * 32768;
            { const bool win = ci < 3; const int kpc = qb * 128 - 128 + 128 * ci;
              int ktlo = 0, kthi = 4;
              if (win) { ktlo = (q0w - 128 - kpc) >> 5; ktlo = ktlo < 0 ? 0 : ktlo; kthi = ((q0w + 191 - kpc) >> 5) + 1; kthi = kthi > 4 ? 4 : kthi; if (kpc < 0 || kpc >= SEQ) kthi = 0; }
              attn_chunk<FAST>(win, ktlo, kthi, sl, Qf, O, mrun, lrun, kpc, q0w, lane); }
        }
        if (item + G < 2048) ATTN_QLOAD(Qn, item + G);
#pragma unroll
        for (int qt = 0; qt < 2; ++qt) {
            const float lt = lrun[qt] + __shfl_xor(lrun[qt], 32), inv = __builtin_amdgcn_rcpf(lt);
            bf16_t* op = (bf16_t*)((char*)AO + ((size_t)(b * SEQ + q0w) * D + head * 64) * 2 + (unsigned)((32 * qt + r) * D + 4 * h) * 2u);
#pragma unroll
            for (int dt = 0; dt < 2; ++dt)
#pragma unroll
                for (int eg = 0; eg < 4; ++eg) { u32x2 wv; wv.x = cvt_pk_bf16(O[dt][qt][4 * eg] * inv, O[dt][qt][4 * eg + 1] * inv); wv.y = cvt_pk_bf16(O[dt][qt][4 * eg + 2] * inv, O[dt][qt][4 * eg + 3] * inv);
                    *(u32x2*)(op + 32 * dt + 8 * eg) = wv; }
        }
    }
#undef ATTN_QLOAD
    asm volatile("s_waitcnt vmcnt(0)" ::: "memory");
    __syncthreads();
}

__device__ __forceinline__ void attn_phase(const bf16_t* __restrict__ Q, const bf16_t* __restrict__ Kb, const bf16_t* __restrict__ VT, bf16_t* __restrict__ AO, const float* __restrict__ sink, const float* __restrict__ qkg, LAS unsigned char* lds) {
    const int lane = otid() & 63;
    float gq = fabsf(qkg[lane]), gk = fabsf(qkg[64 + lane]);
#pragma unroll
    for (int o = 32; o >= 1; o >>= 1) { gq = fmaxf(gq, __shfl_xor(gq, o)); gk = fmaxf(gk, __shfl_xor(gk, o)); }
    float sm = fabsf(sink[lane & 15]) * 1.4426950408889634f;
#pragma unroll
    for (int o = 8; o >= 1; o >>= 1) sm = fmaxf(sm, __shfl_xor(sm, o));
    const float bound = 11.541560327111707f * gq * gk + sm;
    const bool fast = __builtin_amdgcn_readfirstlane((int)(bound <= 100.0f)) != 0;
    if (fast) attn_items<true>(Q, Kb, VT, AO, sink, lds); else attn_items<false>(Q, Kb, VT, AO, sink, lds);
}

__device__ __forceinline__ void slots_phase(const unsigned* __restrict__ route, const int* __restrict__ hist, int* __restrict__ tok, float* __restrict__ gw, int* __restrict__ slotof, int* __restrict__ tile_e, LAS unsigned char* lds) {
    LAS int* hl = (LAS int*)lds;
    LAS int* cnt = hl + 2048;
    LAS int* base = cnt + 8;
    LAS int* pst = base + 8;
    LAS int* wcnt = pst + 16;
    const int tid = otid(), lane = tid & 63, wid = tid >> 6;
    __syncthreads();
    if (tid < 256) { const u32x4 a = *(const u32x4*)(hist + tid * 8), b = *(const u32x4*)(hist + tid * 8 + 4);
        *(LAS u32x4*)(hl + tid * 8) = a; *(LAS u32x4*)(hl + tid * 8 + 4) = b; }
    __syncthreads();
    if (tid < 8) { int tot = 0, bs = 0; for (int k = 0; k < 256; ++k) { const int h = hl[k * 8 + tid]; if (k < (int)blockIdx.x) bs += h; tot += h; } cnt[tid] = tot; base[tid] = bs; }
    __syncthreads();
    if (tid == 0) { int p = 0; for (int e = 0; e < 8; ++e) { pst[e] = p; p += (cnt[e] + 255) & ~255; } pst[8] = p; }
    __syncthreads();
    const int token = blockIdx.x * 256 + (tid >> 1), k = tid & 1;
    const int mye = (int)route[(size_t)token * 4 + k]; const float myg = __uint_as_float(route[(size_t)token * 4 + 2 + k]);
    int rk = 0;
#pragma unroll
    for (int e = 0; e < 8; ++e) { const unsigned long long mask = __ballot(mye == e);
        if (lane == 0) wcnt[e * 8 + wid] = __popcll(mask);
        if (mye == e) rk = __popcll(mask & ((1ull << lane) - 1ull)); }
    __syncthreads();
    int pre = 0;
    for (int w = 0; w < wid; ++w) pre += wcnt[mye * 8 + w];
    const int slot = pst[mye] + base[mye] + pre + rk;
    tok[slot] = token; gw[slot] = myg; slotof[token * 2 + k] = slot;
    if (blockIdx.x == 0) {
        for (int e = 0; e < 8; ++e) for (int s = pst[e] + cnt[e] + tid; s < pst[e + 1]; s += 512) { tok[s] = 0; gw[s] = 0.f; }
        for (int t = tid; t < MAXTILES; t += 512) { int e = 0;
#pragma unroll
            for (int q = 1; q < 8; ++q) if (t * 256 >= pst[q]) e = q;
            tile_e[t] = e; }
        if (tid == 0) tile_e[1023] = pst[8] >> 8;
    }
}

__device__ __forceinline__ void combine_phase(float* __restrict__ out, const bf16_t* __restrict__ XB, const bf16_t* __restrict__ Y, const int* __restrict__ slotof, const float* __restrict__ gate  ) {
    const int tid = otid(), lane = tid & 63, wid = tid >> 6, nwv = gridDim.x * 8, gw = blockIdx.x * 8 + wid, tpw = (NTOK + nwv - 1) / nwv;
    const int t0 = gw * tpw, t1 = (t0 + tpw) < NTOK ? (t0 + tpw) : NTOK;
    if (t0 >= t1) return;
    f32x4 gv[4]; int curb = -1;
#pragma unroll
    for (int i = 0; i < 4; ++i) gv[i] = (f32x4){0.f, 0.f, 0.f, 0.f};
    int sa = slotof[t0 * 2], sb = slotof[t0 * 2 + 1];
    int sa2 = 0, sb2 = 0;
    if (t0 + 1 < t1) { sa2 = slotof[(t0 + 1) * 2]; sb2 = slotof[(t0 + 1) * 2 + 1]; }
    u32x4 y1[2], y2[2], xw[2];
#pragma unroll
    for (int i = 0; i < 2; ++i) { const int o = i * 512 + lane * 8; y1[i] = *(const u32x4*)(Y + (size_t)sa * D + o); y2[i] = *(const u32x4*)(Y + (size_t)sb * D + o); xw[i] = *(const u32x4*)(XB + (size_t)t0 * D + o); }
    for (int t = t0; t < t1; ++t) {
        const int bidx = t >> 12;
        if (bidx != curb) { curb = bidx; const float* gp = gate + (size_t)bidx * NMOD;
#pragma unroll
            for (int i = 0; i < 2; ++i) { gv[2 * i] = *(const f32x4*)(gp + i * 512 + lane * 8); gv[2 * i + 1] = *(const f32x4*)(gp + i * 512 + lane * 8 + 4); } }
        u32x4 cy1[2], cy2[2], cx[2];
#pragma unroll
        for (int i = 0; i < 2; ++i) { cy1[i] = y1[i]; cy2[i] = y2[i]; cx[i] = xw[i]; }
        const int na = sa2, nb = sb2;
        if (t + 2 < t1) { sa2 = slotof[(t + 2) * 2]; sb2 = slotof[(t + 2) * 2 + 1]; }
        if (t + 1 < t1) {
#pragma unroll
            for (int i = 0; i < 2; ++i) { const int o = i * 512 + lane * 8; y1[i] = *(const u32x4*)(Y + (size_t)na * D + o); y2[i] = *(const u32x4*)(Y + (size_t)nb * D + o); xw[i] = *(const u32x4*)(XB + (size_t)(t + 1) * D + o); }
        }
#pragma unroll
        for (int i = 0; i < 2; ++i) { const int o = i * 512 + lane * 8;
            float* xp = out + (size_t)t * D + o;
            f32x4 xa = (f32x4){bflo(cx[i].x), bfhi(cx[i].x), bflo(cx[i].y), bfhi(cx[i].y)}, xb = (f32x4){bflo(cx[i].z), bfhi(cx[i].z), bflo(cx[i].w), bfhi(cx[i].w)};
            const f32x4 ga = gv[2 * i], gb = gv[2 * i + 1];
            xa[0] += ga[0] * (bflo(cy1[i].x) + bflo(cy2[i].x)); xa[1] += ga[1] * (bfhi(cy1[i].x) + bfhi(cy2[i].x)); xa[2] += ga[2] * (bflo(cy1[i].y) + bflo(cy2[i].y)); xa[3] += ga[3] * (bfhi(cy1[i].y) + bfhi(cy2[i].y));
            xb[0] += gb[0] * (bflo(cy1[i].z) + bflo(cy2[i].z)); xb[1] += gb[1] * (bfhi(cy1[i].z) + bfhi(cy2[i].z)); xb[2] += gb[2] * (bflo(cy1[i].w) + bflo(cy2[i].w)); xb[3] += gb[3] * (bfhi(cy1[i].w) + bfhi(cy2[i].w));
            *(f32x4*)xp = xa; *(f32x4*)(xp + 4) = xb; }
    }
}

#ifndef FFN_FP8
#define FFN_FP8 1
#endif
constexpr int MQ_G1 = (FFN_FP8 ? 32 : 20), MQ_WO = 24, MQ_GU = 20, MQ_FD = (FFN_FP8 ? 32 : 48), MQ_QKV = (FFN_FP8 ? 40 : 20);
constexpr int MB_G1 = 0, MB_WO = MB_G1 + 96 * MQ_G1, MB_GU = MB_WO + 192 * MQ_WO, MB_FD = MB_GU + 64 * MQ_GU, MB_QKV = MB_FD + 192 * MQ_FD, MB_REM = MB_QKV + 160 * MQ_QKV;
static_assert(MB_REM <= NE * 2688 && MQ_G1 % 4 == 0 && MQ_WO % 4 == 0 && MQ_GU % 4 == 0 && MQ_FD % 4 == 0 && MQ_QKV % 4 == 0, "moe conversion quotas");
#ifndef MOE_ORDER
#define MOE_ORDER LinOrder<DFF / HALF>
#endif
#define MOE_CONV(first, count) do { sw_start(lds, 7, true); moe_conv_groups(INP(30), INP(31), INP(32), (fp8_t*)OUTP() + DO_MGU, (fp8_t*)OUTP() + DO_MD, lds, (first) / 4, ((first) + (count)) / 4, 1); sw_stop(lds, 7, true); } while (0)
#ifndef STAG_R1
#define STAG_R1 0
#endif
#ifndef STAG_R2
#define STAG_R2 0
#endif
#ifndef STAG_FFN
#define STAG_FFN 0
#endif
#ifndef STAG_MOE
#define STAG_MOE 0
#endif
#ifndef PROBE_MASK
#define PROBE_MASK 0u
#endif
#define REP(k) for (int rep_ = 0; rep_ < (((PROBE_MASK >> (k)) & 1u) ? 2 : 1); ++rep_)
#ifndef PHMASK
#define PHMASK 0xffffffffu
#endif
#define XBAR(n) do { sw_stop(lds, 9, SW_PHASE == (n)); sw_start(lds, 5, true); sw_start(lds, 6, SW_PHASE == (n)); xcd_barrier(bar, (unsigned*)WSP()); sw_stop(lds, 5, true); sw_stop(lds, 6, SW_PHASE == (n)); sw_start(lds, 9, SW_PHASE == (n) + 1 || (SW_PHASE == 5 && (n) == 3)); } while (0)
struct Args { const float* in[33]; float* out; unsigned char* ws; };

__device__ __forceinline__ unsigned long long ldq(volatile LAS unsigned* tab, int i) {
    unsigned lo = tab[2 * i], hi = tab[2 * i + 1];
    lo = __builtin_amdgcn_readfirstlane(lo); hi = __builtin_amdgcn_readfirstlane(hi);
    return ((unsigned long long)hi << 32) | (unsigned long long)lo;
}
#define GAS __attribute__((address_space(1)))
#define INP(i) ((const float*)(const GAS float*)ldq(tab, (i)))
#define OUTP() ((float*)(GAS float*)ldq(tab, 33))
#define WSP() ((unsigned char*)(GAS unsigned char*)ldq(tab, 34))
#define WSF(off) ((float*)(ws + (off)))
#define WSB(off) ((bf16_t*)(ws + (off)))
#define WSI(off) ((int*)(ws + (off)))

__global__ void __launch_bounds__(512, 2) fwd_kernel(Args a_unused) {
    extern __shared__ __attribute__((aligned(16))) unsigned char lds_raw[];
    LAS unsigned char* lds = (LAS unsigned char*)lds_raw;
    volatile LAS unsigned* misc = (volatile LAS unsigned*)(lds + LDS_MISC);
    volatile LAS unsigned* tab = misc + 16;
    const int tid = otid(), G = gridDim.x, bx = blockIdx.x;
    if (tid < 4) misc[tid] = 0u;
    if (SW_ID != 0 && tid < 8) misc[128 + tid] = 0u;
    if (tid < 70) { const unsigned* ka = (const unsigned*)__builtin_amdgcn_kernarg_segment_ptr(); tab[tid] = ka[tid]; }
    __syncthreads();
    XcdBarrier bar = xcd_barrier_post((unsigned*)WSP(), misc);
    sw_start(lds, 9, SW_PHASE == 1);

    if (PHMASK & (1u << 0)) REP(0) {
    { unsigned char* ws = WSP();
      REP(20) {
#define P0_START(cum) ((bx + 256 - ((cum) & 255)) & 255)
      sw_start(lds, 15, true);
      tconv_g<RM_OFF, false>(INP(8), 1024, 2048, 512, 1536, WSB(OFF_WIN), 1024, lds, P0_START(0), G);
      tconv_g<RM_OFF, false>(INP(9), 1024, 1024, 0, 1024, WSB(OFF_WOUT), 0, lds, P0_START(96), G);
      tconv_g<RM_GU_G, FFN_FP8 == 1>(INP(21), 1024, DFF, 0, DFF, ws + OFF_WGU, 0, lds, P0_START(160), G);
      tconv_g<RM_GU_U, FFN_FP8 == 1>(INP(22), 1024, DFF, 0, DFF, ws + OFF_WGU, 0, lds, P0_START(384), G);
      tconv_g<RM_OFF, FFN_FP8 != 0>(INP(23), DFF, 1024, 0, 1024, ws + OFF_WD, 0, lds, P0_START(608), G);
      tconv_g<RM_QKV, false>(INP(24), 1024, 1536, 0, 1280, WSB(OFF_WQKV), 0, lds, P0_START(832), G);
      tconv_g<RM_OFF, false>(INP(24), 1024, 1536, 1280, 256, WSB(OFF_WQKV), 1280, lds, P0_START(912), G);
      tconv_g<RM_OFF, false>(INP(25), 1024, 1024, 0, 1024, WSB(OFF_WO2), 0, lds, P0_START(928), G);
#undef P0_START
      sw_stop(lds, 15, true);
      }
      sw_start(lds, 16, true);
      REP(21) fold_job(INP(8), WSB(OFF_WIN), lds);
      sw_stop(lds, 16, true);
      dft_job(WSB(OFF_DFTC), WSF(OFF_TW), lds);
      sw_start(lds, 17, true);
      REP(22) ada_job(INP(1), INP(3), INP(4), INP(5), WSF(OFF_MOD), lds);
      sw_stop(lds, 17, true);
      sw_start(lds, 18, true);
      REP(23) h3_job(INP(13), INP(14), INP(15), INP(16), INP(17), INP(18), INP(20), WSF(OFF_H3));
      sw_stop(lds, 18, true);
      float* ROPEC = WSF(OFF_ROPE); float* ROPES = ROPEC + 1024;
      for (int idx = bx * 512 + tid; idx < 1024; idx += G * 512) { const int pp = idx >> 4, i = idx & 15; const float inv = powf(10000.0f, -(float)i / 16.0f), ang = (float)pp * inv; ROPEC[idx] = cosf(ang); ROPES[idx] = sinf(ang); }
      if (bx == 0 && tid < 128) ROPEC[2048 + tid] = tid < 64 ? INP(26)[tid] : INP(27)[tid - 64];
    }
    }
    XBAR(1);

    if (PHMASK & (1u << 1)) REP(1) {
    { unsigned char* ws = WSP();
      sw_start(lds, 14, true);
      for (int cp = bx; cp < 256; cp += G) { filt_fin<SEQ>(WSF(OFF_H3), INP(19), WSF(OFF_RC), cp, lds); filt_fin<LCTX>(WSF(OFF_H3) + SEQ, INP(19), WSF(OFF_KFC), cp, lds); }
      sw_stop(lds, 14, true);
      norm_phase<false>(INP(0), INP(2), MROWS, INP(6), WSF(OFF_MOD), 0, WSB(OFF_HX), nullptr, nullptr, nullptr, lds);
    }
    }
    XBAR(2);

    if (PHMASK & (1u << 2)) REP(2) {
    { unsigned char* ws = WSP();
      PolU p; p.S.init(UCH / BM, MROWS / BM, G, bx); p.A = WSB(OFF_WIN); p.B = WSB(OFF_HX); p.UT = WSB(OFF_UT); p.UTc = WSB(OFF_UTC); gemm_phase<D>(lds, p, 0, KREP_G1, SW_PHASE == 2);
      if (bx >= 160) MOE_CONV(MB_G1 + (bx - 160) * MQ_G1, MQ_G1); }
    }
    XBAR(3);

    if (PHMASK & (1u << 3)) REP(3) {
    REP(17) { unsigned char* ws = WSP();
      fourier2_phase(WSB(OFF_UT), WSB(OFF_AT), WSF(OFF_TW), lds); }
    { unsigned char* ws = WSP();
      PolF p; p.S.init(NB, 2, G, bx); p.DFT = WSB(OFF_DFTC); p.ZT = WSB(OFF_UTC); p.MIX = WSB(OFF_MIX); p.K = 512; p.L = LCTX; p.tpb = 1; p.rowbase = NTOK; p.zstride = (unsigned)UCH * LCTX; p.scale = 0.005524271728019903f; gemm_phase<512>(lds, p); }
    REP(18) { unsigned char* ws = WSP();
      sw_start(lds, 11, true); hyena_prep_phase(WSB(OFF_UT), WSB(OFF_UTC), WSB(OFF_VXT), WSB(OFF_X0T), WSB(OFF_HTC), WSF(OFF_KFC), INP(10), INP(11), INP(12), lds); sw_stop(lds, 11, true); }
    XBAR(4);
    REP(19) { unsigned char* ws = WSP();
      toep_phase(WSB(OFF_RC), WSB(OFF_VXT), WSB(OFF_X0T), (const char*)(ws + OFF_ZERO16), INP(12), WSB(OFF_HT), lds); }
    }
    XBAR(5);

    if (PHMASK & (1u << 4)) REP(4) {
    { unsigned char* ws = WSP(); mix_transpose_phase(WSB(OFF_AT), WSB(OFF_HT), WSB(OFF_HTC), WSB(OFF_MIX), lds); }
    }
    XBAR(6);

    if (PHMASK & (1u << 5)) REP(5) {
    { unsigned char* ws = WSP();
      PolR<false, false> p; p.S.init(MROWS / BM, 4, G, bx); p.A = WSB(OFF_MIX); p.B = WSB(OFF_WOUT); p.K = D; p.srcL = INP(0); p.XB = WSB(OFF_XB); p.srcC = INP(2); p.dstC = WSF(OFF_CTXR); p.gate = WSF(OFF_MOD) + 2 * D; gemm_phase<D>(lds, p, STAG_R1);
      if (bx >= 64) MOE_CONV(MB_WO + (bx - 64) * MQ_WO, MQ_WO); }
    }
    XBAR(7);

    if (PHMASK & (1u << 6)) REP(6) {
    { unsigned char* ws = WSP(); norm_phase<false, FFN_FP8 == 1, true>(WSB(OFF_XB), WSF(OFF_CTXR), MROWS, INP(7), WSF(OFF_MOD), 3, WSB(OFF_HX), nullptr, nullptr, nullptr, lds); }
    }
    XBAR(8);

    if (PHMASK & (1u << 7)) REP(7) {
    { unsigned char* ws = WSP();
      PolG<false, TileOrder, FFN_FP8 == 1, FFN_FP8 != 0> p; p.S.init(MROWS / BM, DFF / HALF, G, bx); p.A = WSB(OFF_HX); p.B = WSB(OFF_WGU); p.H = WSB(OFF_HID); p.tok = nullptr; p.tile_e = nullptr; p.tile0 = 0; gemm_phase<D>(lds, p, STAG_FFN, KREP_FFN, SW_PHASE == 7);
      if (bx >= 192) MOE_CONV(MB_GU + (bx - 192) * MQ_GU, MQ_GU); }
    }
    XBAR(9);

    if (PHMASK & (1u << 8)) REP(8) {
    { unsigned char* ws = WSP();
      PolR<FFN_FP8 != 0, true> p; p.S.init(MROWS / BM, 4, G, bx); p.A = WSB(OFF_HID); p.B = WSB(OFF_WD); p.K = DFF; p.srcL = nullptr; p.XB = WSB(OFF_XB); p.srcC = WSF(OFF_CTXR); p.dstC = WSF(OFF_CTXR); p.gate = WSF(OFF_MOD) + 5 * D; gemm_phase<DFF>(lds, p, STAG_R2);
      if (bx >= 64) MOE_CONV(MB_FD + (bx - 64) * MQ_FD, MQ_FD); }
    }
    XBAR(10);

    if (PHMASK & (1u << 9)) REP(9) {
    { unsigned char* ws = WSP();
      norm_phase<false, false, true>(WSB(OFF_XB), WSF(OFF_CTXR), MROWS, INP(6) + D, WSF(OFF_MOD) + 17 * NMOD, 0, WSB(OFF_HX), nullptr, nullptr, nullptr, lds);
      moe_conv_groups(INP(30), INP(31), INP(32), (fp8_t*)OUTP() + DO_MGU, (fp8_t*)OUTP() + DO_MD, lds, MB_REM / 4 + bx, MOE_CONV_TILES / 4, G);
    }
    }
    XBAR(11);

    if (PHMASK & (1u << 10)) REP(10) {
    { unsigned char* ws = WSP();
      PolQKV p; p.S.init(MROWS / BM, 5, G, bx); p.HX = WSB(OFF_HX); p.W = WSB(OFF_WQKV); p.ws = ws; p.qkg = WSF(OFF_ROPE) + 2048; p.ropec = WSF(OFF_ROPE); p.ropes = WSF(OFF_ROPE) + 1024; gemm_phase<D>(lds, p);
      if (bx >= 96) MOE_CONV(MB_QKV + (bx - 96) * MQ_QKV, MQ_QKV); }
    }
    XBAR(12);

    if (PHMASK & (1u << 11)) REP(11) {
    { unsigned char* ws = WSP(); sw_start(lds, 13, true); attn_phase(WSB(OFF_Q), WSB(OFF_K), WSB(OFF_V), WSB(OFF_AO), INP(28), WSF(OFF_ROPE) + 2048, lds); sw_stop(lds, 13, true); }
    }
    XBAR(13);

    if (PHMASK & (1u << 12)) REP(12) {
    { unsigned char* ws = WSP();
      PolR<false, true> p; p.S.init(NTOK / BM, 4, G, bx); p.A = WSB(OFF_AO); p.B = WSB(OFF_WO2); p.K = D; p.srcL = nullptr; p.XB = WSB(OFF_XB); p.srcC = WSF(OFF_CTXR); p.dstC = WSF(OFF_CTXR); p.gate = WSF(OFF_MOD) + 17 * NMOD + 2 * D; gemm_phase<D>(lds, p, STAG_R1); }
    }
    XBAR(14);

    if (PHMASK & (1u << 13)) REP(13) {
    { unsigned char* ws = WSP();
      norm_phase<true, true, true>(WSB(OFF_XB), nullptr, NTOK, INP(7) + D, WSF(OFF_MOD) + 17 * NMOD, 3, (bf16_t*)((unsigned char*)OUTP() + DO_HX8), INP(29), (unsigned*)(ws + OFF_ROUTE), WSI(OFF_HIST), lds); }
    }
    XBAR(15);

    if (PHMASK & (1u << 14)) REP(14) {
    { unsigned char* ws = WSP(); slots_phase((const unsigned*)(ws + OFF_ROUTE), WSI(OFF_HIST), WSI(OFF_TOK), WSF(OFF_GW), WSI(OFF_SLOTOF), WSI(OFF_TILEE), lds); }
    }
    XBAR(16);

    if (PHMASK & (1u << 15)) REP(15) {
#pragma unroll
    for (int ch = 0; ch < NCHUNK; ++ch) {
        { unsigned char* ws = WSP();
          const int ntiles = WSI(OFF_TILEE)[1023], per = (ntiles + NCHUNK - 1) / NCHUNK, t0 = ch * per; int ntc = ntiles - t0; ntc = ntc > per ? per : ntc; if (ntc < 0) ntc = 0;
          PolG<true, MOE_ORDER, true> p; p.S.init(ntc, DFF / HALF, G, bx); p.A = (unsigned char*)OUTP() + DO_HX8; p.B = (unsigned char*)OUTP() + DO_MGU; p.H = ws + OFF_HIDM; p.tok = WSI(OFF_TOK); p.tile_e = WSI(OFF_TILEE); p.tile0 = t0; gemm_phase<D>(lds, p, STAG_MOE, KREP_MOE, SW_PHASE == 15); }
        XBAR(17);
        { unsigned char* ws = WSP();
          const int ntiles = WSI(OFF_TILEE)[1023], per = (ntiles + NCHUNK - 1) / NCHUNK, t0 = ch * per; int ntc = ntiles - t0; ntc = ntc > per ? per : ntc; if (ntc < 0) ntc = 0;
          PolD p; p.S.init(ntc, 4, G, bx); p.A = (const fp8_t*)(ws + OFF_HIDM); p.B = (const fp8_t*)OUTP() + DO_MD; p.Y = WSB(OFF_Y); p.gw = WSF(OFF_GW); p.tile_e = WSI(OFF_TILEE); p.tile0 = t0; gemm_phase<DFF>(lds, p); }
        XBAR(18);
    }
    }

    if (PHMASK & (1u << 16)) REP(16) {
    { unsigned char* ws = WSP(); combine_phase(OUTP(), WSB(OFF_XB), WSB(OFF_Y), WSI(OFF_SLOTOF), WSF(OFF_MOD) + 17 * NMOD + 5 * D); }
    }
    if (SW_ID != 0) { if (threadIdx.x == 0 && blockIdx.x == SW_BLOCK) { const unsigned long long dt = *(volatile LAS unsigned long long*)(lds + LDS_MISC + 512) * (unsigned long long)SW_AMP, t0 = __builtin_amdgcn_s_memrealtime();
        while (__builtin_amdgcn_s_memrealtime() - t0 < dt) __builtin_amdgcn_s_sleep(32); } }
}

extern "C" void kernel_launch(void* const* d_in, const int* in_sizes, int n_in, void* d_out, int out_size, void* d_ws, size_t ws_size, hipStream_t stream) {
    static int grid = 0;
    if (grid == 0) {
        if (n_in != 33 || in_sizes[0] != NTOK * D || out_size != NTOK * D || ws_size < WS_NEED) {
            fprintf(stderr, "kernel_launch: unexpected shapes: n_in %d in0 %d out %d ws %zu (need %zu)\n", n_in, n_in > 0 ? in_sizes[0] : -1, out_size, ws_size, (size_t)WS_NEED); grid = -1; return; }
        int dev = 0, cus = 0;
        if (hipGetDevice(&dev) != hipSuccess || hipDeviceGetAttribute(&cus, hipDeviceAttributeMultiprocessorCount, dev) != hipSuccess) { grid = -1; return; }
        if (hipFuncSetAttribute((const void*)fwd_kernel, hipFuncAttributeMaxDynamicSharedMemorySize, LDS_BYTES) != hipSuccess) { fprintf(stderr, "kernel_launch: hipFuncSetAttribute failed\n"); grid = -1; return; }
        int per_cu = 0;
        if (hipOccupancyMaxActiveBlocksPerMultiprocessor(&per_cu, (const void*)fwd_kernel, 512, LDS_BYTES) != hipSuccess || per_cu < 1) { fprintf(stderr, "kernel_launch: occupancy query says %d\n", per_cu); }
        (void)hipGetLastError();
        if (cus != 256) { fprintf(stderr, "kernel_launch: built for 256 CUs, device has %d\n", cus); grid = -1; return; }
        grid = 256;
    }
    if (grid < 0) return;
    if (hipMemsetAsync((char*)d_ws + OFF_CTL, 0, 65536, stream) != hipSuccess) return;
    Args a{};
    for (int i = 0; i < 33; ++i) a.in[i] = (const float*)d_in[i];
    a.out = (float*)d_out; a.ws = (unsigned char*)d_ws;
    hipLaunchKernelGGL(fwd_kernel, dim3(grid), dim3(512), LDS_BYTES, stream, a);
}
```
